# Optimizing an MI355X kernel written in HIP

```python
import jax, jax.numpy as jnp
from jax import lax
import numpy as np

D_MODEL = 1024
BATCH = 2
SEQ = 16384
DEPTH = 4

CHUNK = 64
Q_BLOCK = 128
RMS_EPS = 1e-6
D_FF = 2816
POOL_WINDOWS = (2, 4, 8, 16)
POOL_GROUP = D_MODEL // 8
POOL_WIDTH = POOL_GROUP * len(POOL_WINDOWS)
FOX_HEADS = 8
FOX_HEAD_DIM = D_MODEL // (2 * FOX_HEADS)
FOX_WIDTH = FOX_HEADS * FOX_HEAD_DIM
AB_IN = POOL_WIDTH + 3 * FOX_WIDTH + FOX_HEADS
AB_MIX = POOL_WIDTH + FOX_WIDTH
MLA_HEADS = 16
MLA_NOPE = 64
MLA_ROPE = 32
MLA_V = 64
MLA_Q_LORA = 256
MLA_KV_LORA = 128
MLA_IN = MLA_Q_LORA + MLA_KV_LORA + MLA_ROPE
ROPE_THETA = 10000.0
N_EVEN = (DEPTH + 1) // 2
N_ODD = DEPTH // 2

kernel_name = 'hybrid_pool_fox_mla_macaron_encoder'


def rms_norm(x, g):
    xf = x.astype(jnp.float32)
    y = xf * lax.rsqrt(jnp.mean(xf * xf, axis=-1, keepdims=True) + RMS_EPS)
    return (y * g.astype(jnp.float32)).astype(x.dtype)


def swiglu(x, w_gate, w_up, w_down):
    return (jax.nn.silu(x @ w_gate) * (x @ w_up)) @ w_down


def rope_tables(positions):
    inv_freq = ROPE_THETA ** (-jnp.arange(0, MLA_ROPE, 2, dtype=jnp.float32) / MLA_ROPE)
    ang = positions.astype(jnp.float32)[..., None] * inv_freq
    return jnp.cos(ang), jnp.sin(ang)


def apply_rope(x, cos, sin):
    xf = x.astype(jnp.float32)
    half = xf.shape[-1] // 2
    x1, x2 = xf[..., :half], xf[..., half:]
    return jnp.concatenate([x1 * cos - x2 * sin, x2 * cos + x1 * sin], axis=-1).astype(x.dtype)


def blocked_attention(q, k, v, scale, chunk, log_decay=None):
    b, s, h, dk = q.shape
    dv = v.shape[-1]
    nb = s // Q_BLOCK
    q = q * scale
    qb = q.reshape(b, nb, Q_BLOCK, h, dk).transpose(1, 0, 2, 3, 4)
    k_chunk = jnp.arange(s) // chunk
    xs = (qb, jnp.arange(nb))
    if log_decay is not None:
        fk = log_decay.transpose(0, 2, 1)
        fqb = log_decay.reshape(b, nb, Q_BLOCK, h).transpose(1, 0, 3, 2)
        xs = xs + (fqb,)

    def attend(args):
        q_blk, blk = args[0], args[1]
        logits = jnp.einsum('bqhd,bkhd->bhqk', q_blk, k).astype(jnp.float32)
        if log_decay is not None:
            logits = logits + (args[2][..., None] - fk[:, :, None, :])
        t_pos = blk * Q_BLOCK + jnp.arange(Q_BLOCK)
        allowed = k_chunk[None, :] <= (t_pos // chunk)[:, None]
        logits = jnp.where(allowed, logits, -jnp.inf)
        p = jax.nn.softmax(logits, axis=-1)
        return jnp.einsum('bhqk,bkhd->bqhd', p.astype(v.dtype), v)

    out = lax.map(attend, xs)
    return out.transpose(1, 0, 2, 3, 4).reshape(b, s, h, dv)


def pool_mixer(u, w_pool, pool_scale):
    s = u.shape[1]
    cs = jnp.cumsum(u.astype(jnp.float32), axis=1)
    t_count = jnp.arange(s) + 1
    outs = []
    for g, w in enumerate(POOL_WINDOWS):
        lo, hi = g * POOL_GROUP, (g + 1) * POOL_GROUP
        cs_g = cs[..., lo:hi]
        lagged = jnp.pad(cs_g, ((0, 0), (w, 0), (0, 0)))[:, :s]
        count = jnp.minimum(t_count, w).astype(jnp.float32)[None, :, None]
        diff = (cs_g - lagged) / count - u[..., lo:hi].astype(jnp.float32)
        outs.append(diff.astype(u.dtype) @ w_pool[g])
    return jnp.concatenate(outs, axis=-1) * pool_scale


def pool_fox_mixer(h, w_in, b_forget, w_pool, pool_scale, w_out):
    b, s, _ = h.shape
    proj = h @ w_in
    o1 = POOL_WIDTH
    o2 = o1 + FOX_WIDTH
    o3 = o2 + FOX_WIDTH
    o4 = o3 + FOX_WIDTH
    u = proj[..., :o1]
    q = proj[..., o1:o2].reshape(b, s, FOX_HEADS, FOX_HEAD_DIM)
    k = proj[..., o2:o3].reshape(b, s, FOX_HEADS, FOX_HEAD_DIM)
    v = proj[..., o3:o4].reshape(b, s, FOX_HEADS, FOX_HEAD_DIM)
    f_logit = proj[..., o4:] + b_forget
    y_pool = pool_mixer(u, w_pool, pool_scale)
    log_f = jax.nn.log_sigmoid(f_logit.astype(jnp.float32))
    cum_log_f = jnp.cumsum(log_f, axis=1)
    y_fox = blocked_attention(q, k, v, FOX_HEAD_DIM ** -0.5, 1, cum_log_f)
    y = jnp.concatenate([y_pool, y_fox.reshape(b, s, FOX_WIDTH)], axis=-1)
    return y @ w_out


def mla_mixer(h, cos, sin, w_in, q_norm, kv_norm, w_q_b, w_kv_b, w_out):
    b, s, _ = h.shape
    proj = h @ w_in
    c_q = proj[..., :MLA_Q_LORA]
    c_kv = proj[..., MLA_Q_LORA:MLA_Q_LORA + MLA_KV_LORA]
    k_rope = apply_rope(proj[..., MLA_Q_LORA + MLA_KV_LORA:], cos, sin)
    q = (rms_norm(c_q, q_norm) @ w_q_b).reshape(b, s, MLA_HEADS, MLA_NOPE + MLA_ROPE)
    q_rope = apply_rope(q[..., MLA_NOPE:], cos[:, :, None, :], sin[:, :, None, :])
    qk = jnp.concatenate([q[..., :MLA_NOPE], q_rope], axis=-1)
    kv = (rms_norm(c_kv, kv_norm) @ w_kv_b).reshape(b, s, MLA_HEADS, MLA_NOPE + MLA_V)
    k = jnp.concatenate(
        [kv[..., :MLA_NOPE], jnp.broadcast_to(k_rope[:, :, None, :], (b, s, MLA_HEADS, MLA_ROPE))],
        axis=-1)
    v = kv[..., MLA_NOPE:]
    y = blocked_attention(qk, k, v, (MLA_NOPE + MLA_ROPE) ** -0.5, CHUNK)
    return y.reshape(b, s, MLA_HEADS * MLA_V) @ w_out


def setup_inputs(seed: int = 0) -> dict:
    key = jax.random.key(seed)
    ks = jax.random.split(key, 20)

    def normal(k, shape, scale):
        return scale * jax.random.normal(k, shape, jnp.float32)

    x = normal(ks[0], (BATCH, SEQ, D_MODEL), 1.0)
    start = jax.random.randint(ks[1], (BATCH, 1), 0, 64, dtype=jnp.int32) * CHUNK
    positions = (start + jnp.arange(SEQ, dtype=jnp.int32)[None, :]).astype(jnp.int32)
    norm_ffn = 1.0 + normal(ks[2], (DEPTH, 2, D_MODEL), 0.05)
    norm_mix = 1.0 + normal(ks[3], (DEPTH, D_MODEL), 0.05)
    norm_final = 1.0 + normal(ks[4], (D_MODEL,), 0.05)
    ffn_w_gate = normal(ks[5], (DEPTH, 2, D_MODEL, D_FF), D_MODEL ** -0.5)
    ffn_w_up = normal(ks[6], (DEPTH, 2, D_MODEL, D_FF), D_MODEL ** -0.5)
    ffn_w_down = normal(ks[7], (DEPTH, 2, D_FF, D_MODEL), D_FF ** -0.5)
    ab_w_in = normal(ks[8], (N_EVEN, D_MODEL, AB_IN), D_MODEL ** -0.5)
    ab_b_forget = jax.random.uniform(ks[9], (N_EVEN, FOX_HEADS), jnp.float32, 1.0, 6.0)
    pool_w = normal(ks[10], (N_EVEN, len(POOL_WINDOWS), POOL_GROUP, POOL_GROUP), POOL_GROUP ** -0.5)
    pool_scale = 1.0 + normal(ks[11], (N_EVEN, POOL_WIDTH), 0.1)
    ab_w_out = normal(ks[12], (N_EVEN, AB_MIX, D_MODEL), AB_MIX ** -0.5)
    mla_w_in = normal(ks[13], (N_ODD, D_MODEL, MLA_IN), D_MODEL ** -0.5)
    mla_q_norm = 1.0 + normal(ks[14], (N_ODD, MLA_Q_LORA), 0.05)
    mla_kv_norm = 1.0 + normal(ks[15], (N_ODD, MLA_KV_LORA), 0.05)
    mla_w_q_b = normal(ks[16], (N_ODD, MLA_Q_LORA, MLA_HEADS * (MLA_NOPE + MLA_ROPE)), MLA_Q_LORA ** -0.5)
    mla_w_kv_b = normal(ks[17], (N_ODD, MLA_KV_LORA, MLA_HEADS * (MLA_NOPE + MLA_V)), MLA_KV_LORA ** -0.5)
    mla_w_out = normal(ks[18], (N_ODD, MLA_HEADS * MLA_V, D_MODEL), (MLA_HEADS * MLA_V) ** -0.5)
    return {'x': x, 'positions': positions, 'norm_ffn': norm_ffn, 'norm_mix': norm_mix,
            'norm_final': norm_final, 'ffn_w_gate': ffn_w_gate, 'ffn_w_up': ffn_w_up,
            'ffn_w_down': ffn_w_down, 'ab_w_in': ab_w_in, 'ab_b_forget': ab_b_forget,
            'pool_w': pool_w, 'pool_scale': pool_scale, 'ab_w_out': ab_w_out,
            'mla_w_in': mla_w_in, 'mla_q_norm': mla_q_norm, 'mla_kv_norm': mla_kv_norm,
            'mla_w_q_b': mla_w_q_b, 'mla_w_kv_b': mla_w_kv_b, 'mla_w_out': mla_w_out}


def reference(x, positions, norm_ffn, norm_mix, norm_final, ffn_w_gate, ffn_w_up, ffn_w_down,
              ab_w_in, ab_b_forget, pool_w, pool_scale, ab_w_out,
              mla_w_in, mla_q_norm, mla_kv_norm, mla_w_q_b, mla_w_kv_b, mla_w_out):
    cos, sin = rope_tables(positions)
    h = x
    for layer in range(DEPTH):
        h = h + 0.5 * swiglu(rms_norm(h, norm_ffn[layer, 0]), ffn_w_gate[layer, 0],
                             ffn_w_up[layer, 0], ffn_w_down[layer, 0])
        hn = rms_norm(h, norm_mix[layer])
        i = layer // 2
        if layer % 2 == 0:
            h = h + pool_fox_mixer(hn, ab_w_in[i], ab_b_forget[i], pool_w[i], pool_scale[i], ab_w_out[i])
        else:
            h = h + mla_mixer(hn, cos, sin, mla_w_in[i], mla_q_norm[i], mla_kv_norm[i],
                              mla_w_q_b[i], mla_w_kv_b[i], mla_w_out[i])
        h = h + 0.5 * swiglu(rms_norm(h, norm_ffn[layer, 1]), ffn_w_gate[layer, 1],
                             ffn_w_up[layer, 1], ffn_w_down[layer, 1])
    return rms_norm(h, norm_final)
```

```cpp
#include <hip/hip_runtime.h>
#include <hip/hip_cooperative_groups.h>
#include <cstdio>
#include <cstdint>
namespace cg = cooperative_groups;
#ifndef ONE_LAUNCH
#define ONE_LAUNCH 1
#endif
namespace pg8 {
#define PG8_LAS __attribute__((address_space(3)))
typedef unsigned short bf16_t;
typedef short bf16x8 __attribute__((ext_vector_type(8)));
typedef float f32x4 __attribute__((ext_vector_type(4)));
typedef unsigned u32x4 __attribute__((ext_vector_type(4)));
constexpr int BM = 256, BK = 64, HALF = 128, HTB = HALF * BK * 2  , STAGE_BYTES = 8 * HTB, NXCD = 8, WGM = 8;

__host__ __device__ __forceinline__ int lds_byte(int r, int c) { const int st = (r >> 4) * 2 + (c >> 5), rr = r & 15, cc = c & 31, ob = rr * 64 + cc * 2; return st * 1024 + (ob ^ (((ob >> 9) & 1) << 5)); }
__host__ __device__ __forceinline__ void stage_rc(int b, int& R, int& C) { const int st = b / 1024, sb = b % 1024, swz = sb ^ (((sb >> 9) & 1) << 5); R = (st >> 1) * 16 + swz / 64; C = (st & 1) * 32 + (swz % 64) / 2; }
__host__ __device__ __forceinline__ int perm32(int rho) { const int n = rho >> 4, i = rho & 15; return 8 * (i >> 2) + 4 * n + (i & 3); }

struct Unit { int pm, pn; };
struct Gemm { const bf16_t* A; const bf16_t* Bt; int M, N, K; };

struct StaticOrder {
    int nM, nN, nwg, G, c;
    __host__ __device__ void init(int M, int N, int G_, int c_) { nM = M / BM; nN = N / BM; nwg = nM * nN; G = G_; c = c_; }
    __host__ __device__ bool next(int i, Unit& u) const {
        const long L = (long)i * G + c; if (L >= nwg) return false;
        int wgid = (int)L; { const int q = nwg / NXCD, r = nwg % NXCD, xcd = wgid % NXCD, off = wgid / NXCD; wgid = (xcd < r ? xcd * (q + 1) : r * (q + 1) + (xcd - r) * q) + off; }
        const int nig = WGM * nN, gid = wgid / nig, fm = gid * WGM, gsz = (nM - fm) < WGM ? (nM - fm) : WGM;
        u.pm = fm + ((wgid % nig) % gsz); u.pn = (wgid % nig) / gsz; return true;
    }
    __device__ __forceinline__ void a_ready(const Unit&) const {}
    __device__ __forceinline__ void done(const Unit&) const {}
};
__device__ __forceinline__ unsigned cvt_pk_bf16(float lo, float hi) { unsigned r; asm volatile("v_cvt_pk_bf16_f32 %0, %1, %2" : "=v"(r) : "v"(lo), "v"(hi)); return r; }
typedef float f32x2 __attribute__((ext_vector_type(2)));
struct EpiBf16S {
    static constexpr bool PERM = true, AFTER_DRAIN = false;
    bf16_t* O; int ldc; int sc_lo, sc_hi; float scale;
    __device__ __forceinline__ void operator()(const f32x4 (&acc)[2][2][4][2], const Unit& u, int wr, int wc, int fr, int fq) const {
        const int row0 = u.pm * BM + wr * 64 + fr; const int colt = u.pn * BM;
        const float sc = (colt >= sc_lo && colt < sc_hi) ? scale : 1.f;
        const int col0 = colt + wc * 32 + 8 * fq;
#pragma unroll
        for (int ai = 0; ai < 2; ++ai)
#pragma unroll
            for (int m = 0; m < 4; ++m) { bf16_t* rowp = O + (size_t)(row0 + ai * HALF + m * 16) * ldc + col0;
#pragma unroll
                for (int bj = 0; bj < 2; ++bj) { const f32x4 v0 = acc[ai][bj][m][0] * sc, v1 = acc[ai][bj][m][1] * sc;
                    u32x4 w; w.x = cvt_pk_bf16(v0[0], v0[1]); w.y = cvt_pk_bf16(v0[2], v0[3]); w.z = cvt_pk_bf16(v1[0], v1[1]); w.w = cvt_pk_bf16(v1[2], v1[3]);
                    *(u32x4*)(rowp + bj * HALF) = w; } }
    }
};
struct EpiSwiglu {
    static constexpr bool PERM = true, AFTER_DRAIN = false;
    bf16_t* O; int ldc;
    __device__ __forceinline__ void operator()(const f32x4 (&acc)[2][2][4][2], const Unit& u, int wr, int wc, int fr, int fq) const {
        const int row0 = u.pm * BM + wr * 64 + fr; const int col0 = u.pn * HALF + wc * 32 + 8 * fq;
#pragma unroll
        for (int ai = 0; ai < 2; ++ai)
#pragma unroll
            for (int m = 0; m < 4; ++m) { bf16_t* rowp = O + (size_t)(row0 + ai * HALF + m * 16) * ldc + col0;
                float a[8];
#pragma unroll
                for (int n = 0; n < 2; ++n)
#pragma unroll
                    for (int e = 0; e < 4; ++e) { const float g = acc[ai][0][m][n][e], up = acc[ai][1][m][n][e];
                        const float sg = g * __builtin_amdgcn_rcpf(1.0f + __builtin_amdgcn_exp2f(-1.4426950408889634f * g)); a[n * 4 + e] = sg * up; }
                u32x4 w; w.x = cvt_pk_bf16(a[0], a[1]); w.y = cvt_pk_bf16(a[2], a[3]); w.z = cvt_pk_bf16(a[4], a[5]); w.w = cvt_pk_bf16(a[6], a[7]);
                *(u32x4*)rowp = w; }
    }
};
struct EpiResF32 {
    static constexpr bool PERM = false, AFTER_DRAIN = false;
    const float* base; float* out; int ldc; float alpha;
    __device__ __forceinline__ void operator()(const f32x4 (&acc)[2][2][4][2], const Unit& u, int wr, int wc, int fr, int fq) const {
        const int col0 = u.pn * BM + wc * 32 + 4 * fq;
#pragma unroll
        for (int ai = 0; ai < 2; ++ai)
#pragma unroll
            for (int m = 0; m < 4; ++m) { const int r = u.pm * BM + ai * HALF + wr * 64 + m * 16 + fr; const size_t off = (size_t)r * ldc + col0;
#pragma unroll
                for (int bj = 0; bj < 2; ++bj)
#pragma unroll
                    for (int n = 0; n < 2; ++n) { f32x4 o = acc[ai][bj][m][n] * alpha;
                        if (base) o = o + *(const f32x4*)(base + off + bj * HALF + n * 16);
                        *(f32x4*)(out + off + bj * HALF + n * 16) = o; } }
    }
};

template <class Epi, class Sched, bool ALIGN_EPI = false, bool SP2 = false>
__device__ __forceinline__ void gemm_phase(PG8_LAS unsigned char* lds, const Gemm g, const Sched& S, const Epi& E) {
    int tid_l = threadIdx.x; asm volatile("" : "+v"(tid_l));
    const int tid = tid_l, wid = __builtin_amdgcn_readfirstlane(tid >> 6), lane = tid & 63, wr = wid >> 2, wc = wid & 3, fr = lane & 15, fq = lane >> 4;
    const int K = g.K, nt = K / BK;
    unsigned voffA[2], voffB[2];
#pragma unroll
    for (int i = 0; i < 2; ++i) { int R, C; stage_rc(tid * 16 + i * 8192, R, C); const int Rb = Epi::PERM ? ((R & ~31) + perm32(R & 31)) : R;
        voffA[i] = (unsigned)(R * K + C) * 2u; voffB[i] = (unsigned)(Rb * K + C) * 2u; }
    const size_t kstep = (size_t)(BK * 2);
    const size_t hstep = (size_t)HALF * K * 2;
    const size_t tstep = 2 * hstep;
    const unsigned ldsw = (unsigned)wid * 1024u;
    const int aoff = lds_byte(wr * 64 + fr, fq * 8), boff = lds_byte(wc * 32 + fr, fq * 8);
#define PG8_SA(b, h) (((b) * 2 + (h)) * HTB)
#define PG8_SB(b, h) ((4 + (b) * 2 + (h)) * HTB)
#define PG8_STAGE(bufoff, gbase, voff) do { _Pragma("unroll") for (int _i = 0; _i < 2; ++_i) \
        __builtin_amdgcn_global_load_lds((const unsigned*)((const char*)(gbase) + (voff)[_i]), (PG8_LAS unsigned*)(lds + (bufoff) + ldsw + _i * 8192), 16, 0, 0); } while (0)
#define PG8_LDA(dst, b, h) do { _Pragma("unroll") for (int m = 0; m < 4; ++m) _Pragma("unroll") for (int k = 0; k < 2; ++k) dst[m][k] = *(const PG8_LAS bf16x8*)(lds + PG8_SA(b, h) + aoff + m * 2048 + k * 1024); } while (0)
#define PG8_LDB(dst, b, h) do { _Pragma("unroll") for (int n = 0; n < 2; ++n) _Pragma("unroll") for (int k = 0; k < 2; ++k) dst[n][k] = *(const PG8_LAS bf16x8*)(lds + PG8_SB(b, h) + boff + n * 2048 + k * 1024); } while (0)
#define PG8_MMA(ai, bj, At, Bt) do { __builtin_amdgcn_s_setprio(1); _Pragma("unroll") for (int m = 0; m < 4; ++m) _Pragma("unroll") for (int n = 0; n < 2; ++n) _Pragma("unroll") for (int k = 0; k < 2; ++k) \
        acc[ai][bj][m][n] = __builtin_amdgcn_mfma_f32_16x16x32_bf16(Bt[n][k], At[m][k], acc[ai][bj][m][n], 0, 0, 0); __builtin_amdgcn_s_setprio(0); } while (0)
#define PG8_WAIT_V(n) asm volatile("s_waitcnt vmcnt(" #n ")" ::: "memory")
#define PG8_WAIT_L(n) asm volatile("s_waitcnt lgkmcnt(" #n ")" ::: "memory")
#define PG8_BAR __builtin_amdgcn_s_barrier()
#define PG8_SCHED __builtin_amdgcn_sched_barrier(0)
    Unit cur, nxt; int ui = 0;
    if (!S.next(0, cur)) return;
    f32x4 acc[2][2][4][2];
#pragma unroll
    for (int a = 0; a < 2; ++a)
#pragma unroll
        for (int b = 0; b < 2; ++b)
#pragma unroll
            for (int m = 0; m < 4; ++m)
#pragma unroll
                for (int n = 0; n < 2; ++n) acc[a][b][m][n] = (f32x4){0.f, 0.f, 0.f, 0.f};
    bf16x8 At[4][2], B0[2][2], B1[2][2];
    const char* cA = (const char*)g.A + (size_t)cur.pm * tstep; const char* cB = (const char*)g.Bt + (size_t)cur.pn * tstep;
    S.a_ready(cur);
    if constexpr (SP2) {
        PG8_STAGE(PG8_SB(0, 0), cB, voffB); PG8_STAGE(PG8_SB(0, 1), cB + hstep, voffB); PG8_STAGE(PG8_SA(0, 0), cA, voffA); PG8_STAGE(PG8_SA(0, 1), cA + hstep, voffA);
        if (wr == 1) PG8_BAR;
        PG8_WAIT_V(2); PG8_BAR;
        PG8_STAGE(PG8_SB(1, 0), cB + kstep, voffB); PG8_STAGE(PG8_SA(1, 0), cA + kstep, voffA); PG8_STAGE(PG8_SB(1, 1), cB + hstep + kstep, voffB);
        PG8_WAIT_V(6); PG8_BAR;
    } else {
        PG8_STAGE(PG8_SB(0, 0), cB, voffB); PG8_STAGE(PG8_SA(0, 0), cA, voffA); PG8_STAGE(PG8_SB(0, 1), cB + hstep, voffB); PG8_STAGE(PG8_SA(0, 1), cA + hstep, voffA);
        if (wr == 1) PG8_BAR;
        PG8_WAIT_V(4); PG8_BAR;
        PG8_STAGE(PG8_SB(1, 0), cB + kstep, voffB); PG8_STAGE(PG8_SA(1, 0), cA + kstep, voffA); PG8_STAGE(PG8_SB(1, 1), cB + hstep + kstep, voffB);
        PG8_WAIT_V(6); PG8_BAR;
    }
    for (;;) {
        const bool has_next = S.next(ui + 1, nxt);
        const char* nA = has_next ? (const char*)g.A + (size_t)nxt.pm * tstep : cA; const char* nB = has_next ? (const char*)g.Bt + (size_t)nxt.pn * tstep : cB;
        for (int t = 0; t < nt; t += 2) {
            const bool last = (t == nt - 2);
            const char* a1 = cA + (size_t)(t + 1) * kstep;
            const char* a2 = last ? nA : cA + (size_t)(t + 2) * kstep; const char* b2 = last ? nB : cB + (size_t)(t + 2) * kstep;
            const char* a3 = a2 + kstep; const char* b3 = b2 + kstep;
            if (last && has_next) S.a_ready(nxt);
            if constexpr (SP2) {
            PG8_LDB(B0, 0, 0); PG8_LDB(B1, 0, 1); PG8_SCHED; PG8_LDA(At, 0, 0); PG8_STAGE(PG8_SA(1, 1), a1 + hstep, voffA);
            PG8_WAIT_V(8); PG8_WAIT_L(0); PG8_BAR; PG8_MMA(0, 0, At, B0); PG8_MMA(0, 1, At, B1); PG8_BAR; PG8_SCHED;
            PG8_LDA(At, 0, 1); PG8_STAGE(PG8_SB(0, 0), b2, voffB); PG8_STAGE(PG8_SB(0, 1), b2 + hstep, voffB); PG8_STAGE(PG8_SA(0, 0), a2, voffA);
            PG8_WAIT_V(8); PG8_WAIT_L(0); PG8_BAR; PG8_MMA(1, 0, At, B0); PG8_MMA(1, 1, At, B1); PG8_BAR; PG8_SCHED;
            PG8_LDB(B0, 1, 0); PG8_LDB(B1, 1, 1); PG8_SCHED; PG8_LDA(At, 1, 0); PG8_STAGE(PG8_SA(0, 1), a2 + hstep, voffA);
            PG8_WAIT_V(8); PG8_WAIT_L(0); PG8_BAR; PG8_MMA(0, 0, At, B0); PG8_MMA(0, 1, At, B1); PG8_BAR; PG8_SCHED;
            PG8_LDA(At, 1, 1); PG8_STAGE(PG8_SB(1, 0), b3, voffB); PG8_STAGE(PG8_SB(1, 1), b3 + hstep, voffB); PG8_STAGE(PG8_SA(1, 0), a3, voffA);
            PG8_WAIT_V(8); PG8_WAIT_L(0); PG8_BAR; PG8_MMA(1, 0, At, B0); PG8_MMA(1, 1, At, B1); PG8_BAR; PG8_SCHED;
            } else {
            PG8_LDB(B0, 0, 0); PG8_SCHED; PG8_LDA(At, 0, 0); PG8_STAGE(PG8_SA(1, 1), a1 + hstep, voffA);
            PG8_WAIT_L(8); PG8_BAR; PG8_WAIT_L(0); PG8_MMA(0, 0, At, B0); PG8_BAR; PG8_SCHED;
            PG8_LDB(B1, 0, 1); PG8_STAGE(PG8_SB(0, 0), b2, voffB);
            PG8_BAR; PG8_WAIT_L(0); PG8_MMA(0, 1, At, B1); PG8_BAR;
            PG8_LDA(At, 0, 1); PG8_STAGE(PG8_SA(0, 0), a2, voffA);
            PG8_BAR; PG8_WAIT_L(0); PG8_MMA(1, 0, At, B0); PG8_BAR; PG8_SCHED;
            PG8_STAGE(PG8_SB(0, 1), b2 + hstep, voffB);
            PG8_WAIT_V(6); PG8_BAR; PG8_MMA(1, 1, At, B1); PG8_BAR;
            PG8_LDB(B0, 1, 0); PG8_SCHED; PG8_LDA(At, 1, 0); PG8_STAGE(PG8_SA(0, 1), a2 + hstep, voffA);
            PG8_WAIT_L(8); PG8_BAR; PG8_WAIT_L(0); PG8_MMA(0, 0, At, B0); PG8_BAR; PG8_SCHED;
            PG8_LDB(B1, 1, 1); PG8_STAGE(PG8_SB(1, 0), b3, voffB);
            PG8_BAR; PG8_WAIT_L(0); PG8_MMA(0, 1, At, B1); PG8_BAR;
            PG8_LDA(At, 1, 1); PG8_STAGE(PG8_SA(1, 0), a3, voffA);
            PG8_BAR; PG8_WAIT_L(0); PG8_MMA(1, 0, At, B0); PG8_BAR; PG8_SCHED;
            PG8_STAGE(PG8_SB(1, 1), b3 + hstep, voffB);
            PG8_WAIT_V(6); PG8_BAR; PG8_MMA(1, 1, At, B1); PG8_BAR;
            }
        }
        if constexpr (ALIGN_EPI) { if (wr == 0) PG8_BAR; }
        if constexpr (!Epi::AFTER_DRAIN) { E(acc, cur, wr, wc, fr, fq); S.done(cur); }
        if (!has_next) break;
#pragma unroll
        for (int a = 0; a < 2; ++a)
#pragma unroll
            for (int b = 0; b < 2; ++b)
#pragma unroll
                for (int m = 0; m < 4; ++m)
#pragma unroll
                    for (int n = 0; n < 2; ++n) acc[a][b][m][n] = (f32x4){0.f, 0.f, 0.f, 0.f};
        cur = nxt; cA = nA; cB = nB; ++ui;
        if constexpr (ALIGN_EPI) { if (wr == 1) PG8_BAR; }
    }
    PG8_WAIT_V(0);
    if constexpr (!ALIGN_EPI) { if (wr == 0) PG8_BAR; }
    PG8_BAR;
    if constexpr (Epi::AFTER_DRAIN) { E.fused(acc, cur, wr, wc, fr, fq, lds, wid, lane); S.done(cur); }
#undef PG8_SA
#undef PG8_SB
#undef PG8_STAGE
#undef PG8_LDA
#undef PG8_LDB
#undef PG8_MMA
#undef PG8_WAIT_V
#undef PG8_WAIT_L
#undef PG8_BAR
#undef PG8_SCHED
}
}
#define LAS __attribute__((address_space(3)))
typedef unsigned short bf16_t;
typedef short bf16x8 __attribute__((ext_vector_type(8)));
typedef float f32x4 __attribute__((ext_vector_type(4)));
typedef float f32x16 __attribute__((ext_vector_type(16)));
typedef unsigned u32x4 __attribute__((ext_vector_type(4)));
typedef unsigned u32x2 __attribute__((ext_vector_type(2)));

constexpr int SEQ = 16384, NB = 2, T = NB * SEQ, DM = 1024, FF = 2816;
constexpr size_t MiB = 1u << 20;
constexpr size_t WS_W = 0, WS_HN = 48 * MiB, WS_Y = 112 * MiB, WS_R1 = 176 * MiB, WS_VT = 352 * MiB, WS_KN = 416 * MiB, WS_SM = 480 * MiB, WS_END = 488 * MiB;
constexpr size_t W_GU0 = 0, W_D0 = 11 * MiB, W_GU1 = 17 * MiB, W_D1 = 28 * MiB, W_MIX = 34 * MiB;
constexpr size_t W_IN = W_MIX, W_V = W_MIX + 3 * MiB, W_OUT = W_MIX + 4 * MiB, W_P = W_MIX + 6 * MiB;
constexpr size_t W_MIN = W_MIX, W_QB = W_MIX + 1 * MiB, W_KNW = W_MIX + 2 * MiB, W_VVW = W_MIX + 2 * MiB + 512 * 1024;
constexpr size_t R_Q = 0, R_CQN = 96 * MiB, R_CKVN = 112 * MiB, R_KR = 128 * MiB;
constexpr size_t SM_LF = 0, SM_F = 1 * MiB, SM_CS = 4 * MiB;
constexpr int LDS_BYTES = 147456;
constexpr float LOG2E = 1.4426950408889634f;
constexpr int NPH = 49;
#ifndef EN_MASK
#define EN_MASK 0xFFFF
#endif
#define EN(b) ((EN_MASK >> (b)) & 1)

struct Args {
    const float* x; const int* pos; const float* norm_ffn; const float* norm_mix; const float* norm_final;
    const float* w_gate; const float* w_up; const float* w_down;
    const float* ab_w_in; const float* ab_b_forget; const float* pool_w; const float* pool_scale; const float* ab_w_out;
    const float* mla_w_in; const float* mla_q_norm; const float* mla_kv_norm; const float* mla_w_q_b; const float* mla_w_kv_b; const float* mla_w_out;
    float* out; unsigned char* ws; int ph_lo, ph_hi; int do_sync, pad;
};

__device__ __forceinline__ float wave_sum(float v) {
#pragma unroll
    for (int o = 1; o < 64; o <<= 1) v += __shfl_xor(v, o);
    return v;
}
typedef float f32x2_t __attribute__((ext_vector_type(2))); typedef __bf16 bf16x2_t __attribute__((ext_vector_type(2)));
__device__ __forceinline__ unsigned pk2(float lo, float hi) { f32x2_t v = {lo, hi}; bf16x2_t b = __builtin_convertvector(v, bf16x2_t); return __builtin_bit_cast(unsigned, b); }
__device__ __forceinline__ float bflo(unsigned w) { return __uint_as_float(w << 16); }
__device__ __forceinline__ float bfhi(unsigned w) { return __uint_as_float(w & 0xffff0000u); }
#define LDS_FENCE() asm volatile("s_waitcnt lgkmcnt(0)" ::: "memory")
#define LBAR() do { asm volatile("s_waitcnt lgkmcnt(0)" ::: "memory"); __builtin_amdgcn_s_barrier(); asm volatile("" ::: "memory"); } while (0)

__device__ __forceinline__ void transpose_item(const float* __restrict__ src, int ld, int k0, bf16_t* __restrict__ dst, int ldd, LAS float* scr, int lane) {
#pragma unroll 8
    for (int i = 0; i < 32; ++i) { const int kk = 2 * i + (lane >> 5); scr[kk * 33 + (lane & 31)] = src[(size_t)(k0 + kk) * ld + (lane & 31)]; }
    LDS_FENCE();
    const int c = lane & 7;
#pragma unroll
    for (int j = 0; j < 4; ++j) { const int n = (lane >> 3) + 8 * j; const LAS float* s = scr + (8 * c) * 33 + n;
        u32x4 o; o.x = pk2(s[0 * 33], s[1 * 33]); o.y = pk2(s[2 * 33], s[3 * 33]); o.z = pk2(s[4 * 33], s[5 * 33]); o.w = pk2(s[6 * 33], s[7 * 33]);
        *(u32x4*)(dst + (size_t)n * ldd + k0 + 8 * c) = o; }
    LDS_FENCE();
}

__device__ __forceinline__ void convert_layer(const Args& A, int l, LAS float* scr, int gw, int NGW, int lane) {
    const int i = l >> 1; const bool even = !(l & 1);
    constexpr int NF = 1408;
    unsigned char* W = A.ws + WS_W;
    const int total = 6 * NF + (even ? (768 + 256 + 512 + 32) : (208 + 192 + 128 + 512));
    for (int it = gw; it < total; it += NGW) {
        int r = it;
        if (r < 6 * NF) {
            const int f = r / (3 * NF), r2 = r % (3 * NF), kind = r2 / NF, q = r2 % NF;
            const size_t wo = (size_t)(l * 2 + f) * DM * FF;
            if (kind < 2) { const int kb = q / 88, nb = q % 88; const float* src = (kind == 0 ? A.w_gate : A.w_up) + wo + 32 * nb;
                bf16_t* dst = (bf16_t*)(W + (f ? W_GU1 : W_GU0)) + (size_t)((nb >> 2) * 256 + (nb & 3) * 32 + kind * 128) * DM;
                transpose_item(src, FF, 64 * kb, dst, DM, scr, lane); }
            else { const int kb = q / 32, nb = q % 32; const float* src = A.w_down + wo + 32 * nb;
                bf16_t* dst = (bf16_t*)(W + (f ? W_D1 : W_D0)) + (size_t)(32 * nb) * FF;
                transpose_item(src, DM, 64 * kb, dst, FF, scr, lane); }
            continue;
        }
        r -= 6 * NF;
        if (even) {
            const float* win = A.ab_w_in + (size_t)i * DM * 2056;
            if (r < 768) { const int kb = r / 48, nb = r % 48; transpose_item(win + 32 * nb, 2056, 64 * kb, (bf16_t*)(W + W_IN) + (size_t)(32 * nb) * DM, DM, scr, lane); continue; } r -= 768;
            if (r < 256) { const int kb = r / 16, nb = r % 16; transpose_item(win + 1536 + 32 * nb, 2056, 64 * kb, (bf16_t*)(W + W_V) + (size_t)(32 * nb) * DM, DM, scr, lane); continue; } r -= 256;
            if (r < 512) { const int kb = r / 32, nb = r % 32; transpose_item(A.ab_w_out + (size_t)i * DM * DM + 32 * nb, DM, 64 * kb, (bf16_t*)(W + W_OUT) + (size_t)(32 * nb) * DM, DM, scr, lane); continue; } r -= 512;
            { const int g = r >> 3, kb = (r & 7) >> 2, nb = r & 3; transpose_item(A.pool_w + (size_t)(i * 4 + g) * 16384 + 32 * nb, 128, 64 * kb, (bf16_t*)(W + W_P) + (size_t)g * 16384 + (size_t)(32 * nb) * 128, 128, scr, lane); }
        } else {
            if (r < 208) { const int kb = r / 13, nb = r % 13; transpose_item(A.mla_w_in + (size_t)i * DM * 416 + 32 * nb, 416, 64 * kb, (bf16_t*)(W + W_MIN) + (size_t)(32 * nb) * DM, DM, scr, lane); continue; } r -= 208;
            if (r < 192) { const int kb = r / 48, nb = r % 48; transpose_item(A.mla_w_q_b + (size_t)i * 256 * 1536 + 32 * nb, 1536, 64 * kb, (bf16_t*)(W + W_QB) + (size_t)(32 * nb) * 256, 256, scr, lane); continue; } r -= 192;
            if (r < 128) { const int kb = r / 64, nb = r % 64; const int col0 = 32 * nb, head = col0 >> 7, within = col0 & 127;
                bf16_t* dst = (within < 64) ? (bf16_t*)(W + W_KNW) + (size_t)(64 * head + within) * 256 : (bf16_t*)(W + W_VVW) + (size_t)(64 * head + within - 64) * 256;
                transpose_item(A.mla_w_kv_b + (size_t)i * 128 * 2048 + col0, 2048, 64 * kb, dst, 256, scr, lane); continue; } r -= 128;
            { const int kb = r / 32, nb = r % 32; transpose_item(A.mla_w_out + (size_t)i * DM * DM + 32 * nb, DM, 64 * kb, (bf16_t*)(W + W_OUT) + (size_t)(32 * nb) * DM, DM, scr, lane); }
        }
    }
    if (!even) {
        const int gt = gw * 64 + lane, NT_ = NGW * 64;
        for (int idx = gt; idx < 2048 * 16; idx += NT_) { const int row = idx >> 4, c = idx & 15;
            *(u32x4*)((bf16_t*)(W + W_KNW) + (size_t)row * 256 + 128 + 8 * c) = (u32x4){0u, 0u, 0u, 0u}; }
    }
}

__device__ __forceinline__ void rope_table(const Args& A, int gw, int NGW, int lane) {
    float* CS = (float*)(A.ws + WS_SM + SM_CS);
    const int gt = gw * 64 + lane, NT_ = NGW * 64;
    for (int idx = gt; idx < T * 16; idx += NT_) {
        const int t = idx >> 4, j = idx & 15;
        const int jm = j & 3, jd = j >> 2;
        const double base = jm == 0 ? 1.0 : (jm == 1 ? 0.5623413251903491 : (jm == 2 ? 0.31622776601683794 : 0.1778279410038923));
        const double p10 = jd == 0 ? 1.0 : (jd == 1 ? 0.1 : (jd == 2 ? 0.01 : 0.001));
        const float invf = (float)(base * p10);
        const float ang = (float)A.pos[t] * invf;
        const double rev = (double)ang * 0.15915494309189535;
        const float fr = (float)(rev - __builtin_rint(rev));
        CS[(size_t)t * 32 + j] = __builtin_amdgcn_cosf(fr);
        CS[(size_t)t * 32 + 16 + j] = __builtin_amdgcn_sinf(fr);
    }
}

template <int MODE>
__device__ __forceinline__ void norm_phase(const float* src, const float* __restrict__ g, bf16_t* dst16, float* dst32,
                                           const float* __restrict__ wfsrc, const float* __restrict__ bforget, float* LF, LAS float* wfT, int gw, int NGW, int lane, int tid) {
    if (MODE == 1) {
        for (int idx = tid; idx < 8192; idx += 512) { const int k = idx >> 3, f = idx & 7; wfT[f * 1024 + k] = wfsrc[(size_t)k * 2056 + 2048 + f]; }
        LDS_FENCE(); __syncthreads();
    }
    f32x4 gv[4];
#pragma unroll
    for (int j = 0; j < 4; ++j) gv[j] = *(const f32x4*)(g + 4 * lane + 256 * j);
    for (int m = gw; m < T; m += NGW) {
        const f32x4* xr = (const f32x4*)(src + (size_t)m * DM) + lane;
        f32x4 v[4]; float ss = 0.f;
#pragma unroll
        for (int j = 0; j < 4; ++j) { v[j] = xr[64 * j]; ss += (v[j].x * v[j].x + v[j].y * v[j].y) + (v[j].z * v[j].z + v[j].w * v[j].w); }
        ss = wave_sum(ss);
        const float rstd = 1.0f / sqrtf(ss * (1.0f / DM) + 1e-6f);
#pragma unroll
        for (int j = 0; j < 4; ++j) v[j] = v[j] * rstd * gv[j];
        if (MODE == 2) {
            f32x4* o = (f32x4*)(dst32 + (size_t)m * DM) + lane;
#pragma unroll
            for (int j = 0; j < 4; ++j) o[64 * j] = v[j];
        } else {
            u32x2* o = (u32x2*)(dst16 + (size_t)m * DM) + lane;
#pragma unroll
            for (int j = 0; j < 4; ++j) { u32x2 w; w.x = pk2(v[j].x, v[j].y); w.y = pk2(v[j].z, v[j].w); o[64 * j] = w; }
        }
        if (MODE == 1) {
            float mine = 0.f;
#pragma unroll
            for (int f = 0; f < 8; ++f) { float a = 0.f;
#pragma unroll
                for (int j = 0; j < 4; ++j) { const f32x4 w = *(const LAS f32x4*)(wfT + f * 1024 + 4 * lane + 256 * j); a += (v[j].x * w.x + v[j].y * w.y) + (v[j].z * w.z + v[j].w * w.w); }
                a = wave_sum(a); mine = (lane == f) ? a : mine; }
            if (lane < 8) { const float xx = mine + bforget[lane];
                const float ls = xx < 0.f ? xx - log1pf(expf(xx)) : -log1pf(expf(-xx));
                const int b = m / SEQ, t = m % SEQ; LF[(size_t)(b * 8 + lane) * SEQ + t] = ls; }
        }
    }
}

__device__ __forceinline__ void mla_small(const Args& A, int i, int gw, int NGW, int lane) {
    const float* PROJ = (const float*)(A.ws + WS_Y);
    bf16_t* CQN = (bf16_t*)(A.ws + WS_R1 + R_CQN); bf16_t* CKVN = (bf16_t*)(A.ws + WS_R1 + R_CKVN); bf16_t* KR = (bf16_t*)(A.ws + WS_R1 + R_KR);
    const float* CS = (const float*)(A.ws + WS_SM + SM_CS);
    const f32x4 gq = *(const f32x4*)(A.mla_q_norm + (size_t)i * 256 + 4 * lane);
    const f32x4 gk = *(const f32x4*)(A.mla_kv_norm + (size_t)i * 128 + 4 * (lane & 31));
    for (int m = gw; m < T; m += NGW) {
        const float* row = PROJ + (size_t)m * 512;
        const f32x4 a = *(const f32x4*)(row + 4 * lane);
        f32x4 b = (f32x4){0.f, 0.f, 0.f, 0.f};
        if (lane < 40) b = *(const f32x4*)(row + 256 + 4 * lane);
        const float sq = wave_sum((a.x * a.x + a.y * a.y) + (a.z * a.z + a.w * a.w));
        const float skv = wave_sum(lane < 32 ? (b.x * b.x + b.y * b.y) + (b.z * b.z + b.w * b.w) : 0.f);
        const float rq = 1.0f / sqrtf(sq * (1.0f / 256.0f) + 1e-6f), rkv = 1.0f / sqrtf(skv * (1.0f / 128.0f) + 1e-6f);
        { const f32x4 y = a * rq * gq; u32x2 w; w.x = pk2(y.x, y.y); w.y = pk2(y.z, y.w); *(u32x2*)(CQN + (size_t)m * 256 + 4 * lane) = w; }
        { const f32x4 y = b * rkv * gk; u32x2 w; w.x = pk2(y.x, y.y); w.y = pk2(y.z, y.w); if (lane >= 32) { w.x = 0u; w.y = 0u; }
          *(u32x2*)(CKVN + (size_t)m * 256 + 4 * lane) = w; }
        f32x4 p; p.x = __shfl_xor(b.x, 4); p.y = __shfl_xor(b.y, 4); p.z = __shfl_xor(b.z, 4); p.w = __shfl_xor(b.w, 4);
        if (lane >= 32 && lane < 40) { const int i0 = 4 * ((lane - 32) & 3);
            const f32x4 c = *(const f32x4*)(CS + (size_t)m * 32 + i0), s = *(const f32x4*)(CS + (size_t)m * 32 + 16 + i0);
            f32x4 o; if (lane < 36) o = b * c - p * s; else o = b * c + p * s;
            u32x2 w; w.x = pk2(o.x, o.y); w.y = pk2(o.z, o.w); *(u32x2*)(KR + (size_t)m * 32 + 4 * (lane - 32)) = w; }
    }
}

__device__ __forceinline__ void scan_pool(const Args& A, int i, LAS unsigned char* lds, int gw, int NGW, int lane, int tid, int wave) {
    if (blockIdx.x < 16) {
        const int bh = blockIdx.x; const float* lf = (const float*)(A.ws + WS_SM + SM_LF) + (size_t)bh * SEQ + tid * 32; double* Fo = (double*)(A.ws + WS_SM + SM_F) + (size_t)bh * SEQ + tid * 32;
        f32x4 v[8]; double tot = 0.0;
#pragma unroll
        for (int e = 0; e < 8; ++e) { v[e] = *(const f32x4*)(lf + 4 * e); tot += ((double)v[e].x + (double)v[e].y) + ((double)v[e].z + (double)v[e].w); }
        double incl = tot;
#pragma unroll
        for (int o = 1; o < 64; o <<= 1) { const double n = __shfl_up(incl, o); if (lane >= o) incl += n; }
        LAS double* wt = (LAS double*)lds;
        if (lane == 63) wt[wave] = incl;
        LDS_FENCE(); __syncthreads();
        double run = incl - tot;
        for (int j = 0; j < wave; ++j) run += wt[j];
#pragma unroll
        for (int e = 0; e < 8; ++e) { double o0, o1, o2, o3; run += (double)v[e].x; o0 = run; run += (double)v[e].y; o1 = run; run += (double)v[e].z; o2 = run; run += (double)v[e].w; o3 = run;
            Fo[4 * e + 0] = o0; Fo[4 * e + 1] = o1; Fo[4 * e + 2] = o2; Fo[4 * e + 3] = o3; }
        __syncthreads();
    }
    const bf16_t* P = (const bf16_t*)(A.ws + WS_R1); bf16_t* Y = (bf16_t*)(A.ws + WS_Y); const bf16_t* WP = (const bf16_t*)(A.ws + WS_W + W_P);
    const float* psc = A.pool_scale + (size_t)i * 512;
    const int r32 = lane & 31, hi = lane >> 5;
    for (int u = gw; u < 4096; u += NGW) {
        const int g = u & 3, rb = u >> 2, wnd = 2 << g;
        const int tg = 32 * rb + r32, t = tg & (SEQ - 1);
        const int cnt = (t + 1 < wnd) ? (t + 1) : wnd; const float inv = 1.0f / (float)cnt;
        const bf16_t* up = P + (size_t)tg * 1536 + 128 * g + 8 * hi;
        bf16x8 af[8];
#pragma unroll
        for (int kk = 0; kk < 8; ++kk) {
            const u32x4 cur = *(const u32x4*)(up + 16 * kk);
            float s0 = bflo(cur.x), s1 = bfhi(cur.x), s2 = bflo(cur.y), s3 = bfhi(cur.y), s4 = bflo(cur.z), s5 = bfhi(cur.z), s6 = bflo(cur.w), s7 = bfhi(cur.w);
            const float c0 = s0, c1 = s1, c2 = s2, c3 = s3, c4 = s4, c5 = s5, c6 = s6, c7 = s7;
            for (int j = 1; j < cnt; ++j) { const u32x4 w = *(const u32x4*)(up - (size_t)j * 1536 + 16 * kk);
                s0 += bflo(w.x); s1 += bfhi(w.x); s2 += bflo(w.y); s3 += bfhi(w.y); s4 += bflo(w.z); s5 += bfhi(w.z); s6 += bflo(w.w); s7 += bfhi(w.w); }
            u32x4 o; o.x = pk2(s0 * inv - c0, s1 * inv - c1); o.y = pk2(s2 * inv - c2, s3 * inv - c3); o.z = pk2(s4 * inv - c4, s5 * inv - c5); o.w = pk2(s6 * inv - c6, s7 * inv - c7);
            af[kk] = __builtin_bit_cast(bf16x8, o);
        }
        const bf16_t* wp = WP + (size_t)g * 16384 + (size_t)r32 * 128 + 8 * hi;
#pragma unroll
        for (int nb = 0; nb < 4; ++nb) {
            f32x16 acc = {};
#pragma unroll
            for (int kk = 0; kk < 8; ++kk) { const bf16x8 bfr = *(const bf16x8*)(wp + (size_t)(32 * nb) * 128 + 16 * kk); acc = __builtin_amdgcn_mfma_f32_32x32x16_bf16(af[kk], bfr, acc, 0, 0, 0); }
            const int col = 128 * g + 32 * nb + r32; const float sc = psc[col];
#pragma unroll
            for (int r = 0; r < 16; ++r) { const int row = 32 * rb + (r & 3) + 8 * (r >> 2) + 4 * hi;
                Y[(size_t)row * DM + col] = (bf16_t)(pk2(acc[r] * sc, 0.f) & 0xffffu); }
        }
    }
}

template <int DK, bool FOX>
__device__ __forceinline__ void attn_unit(LAS unsigned char* lds, const bf16_t* __restrict__ Qp, int ldq, const bf16_t* __restrict__ Kp, int ldk, const bf16_t* __restrict__ Kr,
                                          const bf16_t* __restrict__ VTp, const double* __restrict__ F, const float* __restrict__ CS, bf16_t* Yp, int q0, int tid) {
    constexpr int KSTR = DK * 2 + 16, VSTR = 144, KBYTES = 64 * KSTR, VBYTES = 64 * VSTR;
    constexpr int OFF_K = 0, OFF_V = 2 * KBYTES, OFF_FK = OFF_V + 2 * VBYTES, OFF_WS = OFF_FK + 512;
    constexpr int ND = DK / 16;
    const int lane = tid & 63, r32 = lane & 31, hi = lane >> 5, w = __builtin_amdgcn_readfirstlane(tid >> 6);
    const int wrow0 = q0 + 32 * w, trow = wrow0 + r32;
    bf16x8 qf[ND];
#pragma unroll
    for (int d0 = 0; d0 < ND; ++d0) qf[d0] = *(const bf16x8*)(Qp + (size_t)trow * ldq + 16 * d0 + 8 * hi);
    if (!FOX) {
        const u32x4 a = __builtin_bit_cast(u32x4, qf[ND - 2]), b = __builtin_bit_cast(u32x4, qf[ND - 1]);
        const float* cs = CS + (size_t)trow * 32 + 8 * hi;
        const f32x4 c0 = *(const f32x4*)cs, c1 = *(const f32x4*)(cs + 4), s0 = *(const f32x4*)(cs + 16), s1 = *(const f32x4*)(cs + 20);
        const float x1[8] = {bflo(a.x), bfhi(a.x), bflo(a.y), bfhi(a.y), bflo(a.z), bfhi(a.z), bflo(a.w), bfhi(a.w)};
        const float x2[8] = {bflo(b.x), bfhi(b.x), bflo(b.y), bfhi(b.y), bflo(b.z), bfhi(b.z), bflo(b.w), bfhi(b.w)};
        const float cc[8] = {c0.x, c0.y, c0.z, c0.w, c1.x, c1.y, c1.z, c1.w}, sn[8] = {s0.x, s0.y, s0.z, s0.w, s1.x, s1.y, s1.z, s1.w};
        u32x4 oa, ob;
        oa.x = pk2(x1[0] * cc[0] - x2[0] * sn[0], x1[1] * cc[1] - x2[1] * sn[1]); oa.y = pk2(x1[2] * cc[2] - x2[2] * sn[2], x1[3] * cc[3] - x2[3] * sn[3]);
        oa.z = pk2(x1[4] * cc[4] - x2[4] * sn[4], x1[5] * cc[5] - x2[5] * sn[5]); oa.w = pk2(x1[6] * cc[6] - x2[6] * sn[6], x1[7] * cc[7] - x2[7] * sn[7]);
        ob.x = pk2(x2[0] * cc[0] + x1[0] * sn[0], x2[1] * cc[1] + x1[1] * sn[1]); ob.y = pk2(x2[2] * cc[2] + x1[2] * sn[2], x2[3] * cc[3] + x1[3] * sn[3]);
        ob.z = pk2(x2[4] * cc[4] + x1[4] * sn[4], x2[5] * cc[5] + x1[5] * sn[5]); ob.w = pk2(x2[6] * cc[6] + x1[6] * sn[6], x2[7] * cc[7] + x1[7] * sn[7]);
        qf[ND - 2] = __builtin_bit_cast(bf16x8, oa); qf[ND - 1] = __builtin_bit_cast(bf16x8, ob);
    }
    float fq2 = 0.f; double Fref = 0.0;
    if (FOX) { Fref = F[q0]; fq2 = (float)((F[trow] - Fref) * (double)LOG2E); }
    f32x16 o0 = {}, o1 = {}; float mrun = -1e30f, lrun = 0.f;
    const int ktmax = (q0 >> 6) + 3, wkt = wrow0 >> 6;
    const int krow = tid >> 3, kch = tid & 7, rrow = (tid >> 2) & 63, rch = tid & 3;
    const bf16_t* kg = Kp + (size_t)krow * ldk + kch * 8;
    const bf16_t* vg = VTp + (size_t)krow * T + kch * 8;
    const bf16_t* rg = FOX ? Kp : Kr + (size_t)rrow * 32 + rch * 8;
    u32x4 kreg, vreg, rreg = {}; float fkreg = 0.f;
#define AT_GLOAD(kt) do { kreg = *(const u32x4*)(kg + (size_t)(kt) * 64 * ldk); vreg = *(const u32x4*)(vg + (size_t)(kt) * 64); \
        if (!FOX && tid < 256) rreg = *(const u32x4*)(rg + (size_t)(kt) * 64 * 32); \
        if (FOX && tid < 64) fkreg = -(float)((F[(kt) * 64 + tid] - Fref) * (double)LOG2E); } while (0)
#define AT_LWRITE(b) do { *(LAS u32x4*)(lds + OFF_K + (b) * KBYTES + krow * KSTR + kch * 16) = kreg; *(LAS u32x4*)(lds + OFF_V + (b) * VBYTES + krow * VSTR + kch * 16) = vreg; \
        if (!FOX && tid < 256) *(LAS u32x4*)(lds + OFF_K + (b) * KBYTES + rrow * KSTR + 128 + rch * 16) = rreg; \
        if (FOX && tid < 64) *(LAS float*)(lds + OFF_FK + (b) * 256 + tid * 4) = fkreg; } while (0)
    LAS float* wsf = (LAS float*)(lds + OFF_WS) + w * 64;
    const int sig = (r32 & 0x13) | ((r32 & 4) << 1) | ((r32 & 8) >> 1);
    AT_GLOAD(ktmax); AT_LWRITE(0); LBAR();
    int buf = 0;
    for (int kt = ktmax; kt >= 0; --kt) {
        if (kt > 0) AT_GLOAD(kt - 1);
        if (kt <= wkt) {
            const LAS unsigned char* kb = lds + OFF_K + buf * KBYTES + sig * KSTR + hi * 16;
            f32x16 s0, s1;
            if (FOX) { const LAS float* fk = (const LAS float*)(lds + OFF_FK + buf * 256) + 8 * hi;
                const f32x4 a0 = *(const LAS f32x4*)(fk), a1 = *(const LAS f32x4*)(fk + 4), a2 = *(const LAS f32x4*)(fk + 16), a3 = *(const LAS f32x4*)(fk + 20);
                const f32x4 b0 = *(const LAS f32x4*)(fk + 32), b1 = *(const LAS f32x4*)(fk + 36), b2 = *(const LAS f32x4*)(fk + 48), b3 = *(const LAS f32x4*)(fk + 52);
#pragma unroll
                for (int e = 0; e < 4; ++e) { s0[e] = a0[e] + fq2; s0[4 + e] = a1[e] + fq2; s0[8 + e] = a2[e] + fq2; s0[12 + e] = a3[e] + fq2;
                                              s1[e] = b0[e] + fq2; s1[4 + e] = b1[e] + fq2; s1[8 + e] = b2[e] + fq2; s1[12 + e] = b3[e] + fq2; }
            } else { s0 = (f32x16){}; s1 = (f32x16){}; }
#pragma unroll
            for (int d0 = 0; d0 < ND; ++d0) { const bf16x8 ka = *(const LAS bf16x8*)(kb + d0 * 32), kc = *(const LAS bf16x8*)(kb + 32 * KSTR + d0 * 32);
                s0 = __builtin_amdgcn_mfma_f32_32x32x16_bf16(ka, qf[d0], s0, 0, 0, 0); s1 = __builtin_amdgcn_mfma_f32_32x32x16_bf16(kc, qf[d0], s1, 0, 0, 0); }
            if (FOX && (64 * kt + 63 > wrow0)) { const int kv0 = 64 * kt + 8 * hi;
#pragma unroll
                for (int r = 0; r < 16; ++r) { const int kv = kv0 + 16 * (r >> 3) + (r & 7); if (kv > trow) s0[r] = -INFINITY; if (kv + 32 > trow) s1[r] = -INFINITY; } }
            float mloc = fmaxf(s0[0], s1[0]);
#pragma unroll
            for (int r = 1; r < 16; ++r) mloc = fmaxf(mloc, fmaxf(s0[r], s1[r]));
            mloc = fmaxf(mloc, __shfl_xor(mloc, 32));
            if (__any(mloc > mrun + 8.0f)) {
                const float mnew = fmaxf(mrun, mloc); const float alpha = __builtin_amdgcn_exp2f(mrun - mnew); lrun *= alpha; mrun = mnew;
                if (hi == 0) wsf[r32] = alpha;
                LDS_FENCE();
#pragma unroll
                for (int r4 = 0; r4 < 4; ++r4) { const f32x4 al = *(const LAS f32x4*)(wsf + 8 * r4 + 4 * hi);
#pragma unroll
                    for (int e = 0; e < 4; ++e) { o0[4 * r4 + e] *= al[e]; o1[4 * r4 + e] *= al[e]; } }
                LDS_FENCE();
            }
            float ls = 0.f;
#pragma unroll
            for (int r = 0; r < 16; ++r) { s0[r] = __builtin_amdgcn_exp2f(s0[r] - mrun); s1[r] = __builtin_amdgcn_exp2f(s1[r] - mrun); ls += s0[r] + s1[r]; }
            lrun += ls;
            u32x4 p0, p1, p2, p3;
            p0.x = pk2(s0[0], s0[1]); p0.y = pk2(s0[2], s0[3]); p0.z = pk2(s0[4], s0[5]); p0.w = pk2(s0[6], s0[7]);
            p1.x = pk2(s0[8], s0[9]); p1.y = pk2(s0[10], s0[11]); p1.z = pk2(s0[12], s0[13]); p1.w = pk2(s0[14], s0[15]);
            p2.x = pk2(s1[0], s1[1]); p2.y = pk2(s1[2], s1[3]); p2.z = pk2(s1[4], s1[5]); p2.w = pk2(s1[6], s1[7]);
            p3.x = pk2(s1[8], s1[9]); p3.y = pk2(s1[10], s1[11]); p3.z = pk2(s1[12], s1[13]); p3.w = pk2(s1[14], s1[15]);
            const bf16x8 pa0 = __builtin_bit_cast(bf16x8, p0), pa1 = __builtin_bit_cast(bf16x8, p1), pa2 = __builtin_bit_cast(bf16x8, p2), pa3 = __builtin_bit_cast(bf16x8, p3);
            const LAS unsigned char* vb = lds + OFF_V + buf * VBYTES + r32 * VSTR + hi * 16;
            { const bf16x8 v0 = *(const LAS bf16x8*)(vb), v1 = *(const LAS bf16x8*)(vb + 32 * VSTR);
              o0 = __builtin_amdgcn_mfma_f32_32x32x16_bf16(pa0, v0, o0, 0, 0, 0); o1 = __builtin_amdgcn_mfma_f32_32x32x16_bf16(pa0, v1, o1, 0, 0, 0); }
            { const bf16x8 v0 = *(const LAS bf16x8*)(vb + 32), v1 = *(const LAS bf16x8*)(vb + 32 * VSTR + 32);
              o0 = __builtin_amdgcn_mfma_f32_32x32x16_bf16(pa1, v0, o0, 0, 0, 0); o1 = __builtin_amdgcn_mfma_f32_32x32x16_bf16(pa1, v1, o1, 0, 0, 0); }
            { const bf16x8 v0 = *(const LAS bf16x8*)(vb + 64), v1 = *(const LAS bf16x8*)(vb + 32 * VSTR + 64);
              o0 = __builtin_amdgcn_mfma_f32_32x32x16_bf16(pa2, v0, o0, 0, 0, 0); o1 = __builtin_amdgcn_mfma_f32_32x32x16_bf16(pa2, v1, o1, 0, 0, 0); }
            { const bf16x8 v0 = *(const LAS bf16x8*)(vb + 96), v1 = *(const LAS bf16x8*)(vb + 32 * VSTR + 96);
              o0 = __builtin_amdgcn_mfma_f32_32x32x16_bf16(pa3, v0, o0, 0, 0, 0); o1 = __builtin_amdgcn_mfma_f32_32x32x16_bf16(pa3, v1, o1, 0, 0, 0); }
        }
        if (kt > 0) AT_LWRITE(buf ^ 1);
        LBAR(); buf ^= 1;
    }
#undef AT_GLOAD
#undef AT_LWRITE
    lrun += __shfl_xor(lrun, 32);
    if (hi == 0) wsf[32 + r32] = lrun;
    LDS_FENCE();
#pragma unroll
    for (int r4 = 0; r4 < 4; ++r4) { const f32x4 lv = *(const LAS f32x4*)(wsf + 32 + 8 * r4 + 4 * hi);
#pragma unroll
        for (int e = 0; e < 4; ++e) { const float inv = 1.0f / lv[e]; const int row = wrow0 + e + 8 * r4 + 4 * hi;
            Yp[(size_t)row * DM + r32] = (bf16_t)(pk2(o0[4 * r4 + e] * inv, 0.f) & 0xffffu);
            Yp[(size_t)row * DM + 32 + r32] = (bf16_t)(pk2(o1[4 * r4 + e] * inv, 0.f) & 0xffffu); } }
    LDS_FENCE();
}

__global__ void __launch_bounds__(512, 2) fwd_mega(Args Akern) {
    extern __shared__ __attribute__((aligned(16))) unsigned char lds_raw[];
    LAS unsigned char* lds = (LAS unsigned char*)lds_raw;
    const int G = gridDim.x, bx = blockIdx.x;
    const int vcu = (G % 8 == 0) ? (bx % 8) * (G / 8) + bx / 8 : bx;
    const int NGW = G * 8;
    const int ph_lo = Akern.ph_lo, ph_hi = Akern.ph_hi, do_sync = Akern.do_sync;
#if defined(__HIP_DEVICE_COMPILE__)
    const __attribute__((address_space(4))) Args* Ak = (const __attribute__((address_space(4))) Args*)__builtin_amdgcn_kernarg_segment_ptr();
#else
    const Args* Ak = &Akern;
#endif

    for (int ph = ph_lo; ph < ph_hi; ++ph) {
        asm volatile("" : "+s"(Ak));
        const Args A = *Ak;
        int tid = threadIdx.x; asm volatile("" : "+v"(tid));
        const int lane = tid & 63, wave = __builtin_amdgcn_readfirstlane(tid >> 6), gw = vcu * 8 + wave;
        unsigned char* ws = A.ws;
        bf16_t* HN = (bf16_t*)(ws + WS_HN); bf16_t* Yb = (bf16_t*)(ws + WS_Y); bf16_t* R1 = (bf16_t*)(ws + WS_R1); bf16_t* VT = (bf16_t*)(ws + WS_VT); bf16_t* KN = (bf16_t*)(ws + WS_KN);
        float* LFb = (float*)(ws + WS_SM + SM_LF); const double* Fb = (const double*)(ws + WS_SM + SM_F); const float* CS = (const float*)(ws + WS_SM + SM_CS);
        const int l = ph / 12, k = ph % 12, i = l >> 1; const bool even = !(l & 1);
        bool did = true;
        if (ph == NPH - 1) {
            if (EN(0)) norm_phase<2>(A.out, A.norm_final, nullptr, A.out, nullptr, nullptr, nullptr, nullptr, gw, NGW, lane, tid);
        } else if (k == 0 || k == 9) {
            const int f = (k == 0) ? 0 : 1;
            if (EN(1)) if (k == 0) { convert_layer(A, l, (LAS float*)(lds + wave * 16384), gw, NGW, lane); if (l == 0) rope_table(A, gw, NGW, lane); }
            if (EN(0)) norm_phase<0>((l == 0 && k == 0) ? A.x : A.out, A.norm_ffn + (size_t)(l * 2 + f) * DM, HN, nullptr, nullptr, nullptr, nullptr, nullptr, gw, NGW, lane, tid);
        } else if (k == 1 || k == 10) {
            const int f = (k == 1) ? 0 : 1;
            pg8::Gemm g{HN, (const bf16_t*)(ws + WS_W + (f ? W_GU1 : W_GU0)), T, 2 * FF, DM}; pg8::StaticOrder S; S.init(T, 2 * FF, G, bx);
            pg8::EpiSwiglu E{R1, FF};
            if (EN(2)) pg8::gemm_phase<pg8::EpiSwiglu, pg8::StaticOrder, true, true>(lds, g, S, E);
        } else if (k == 2 || k == 11 || k == 8 || (k == 4 && !even)) {
            pg8::Gemm g; pg8::EpiResF32 E;
            if (k == 2 || k == 11) { const int f = (k == 2) ? 0 : 1; g = pg8::Gemm{R1, (const bf16_t*)(ws + WS_W + (f ? W_D1 : W_D0)), T, DM, FF};
                E = pg8::EpiResF32{(l == 0 && k == 2) ? A.x : A.out, A.out, DM, 0.5f}; }
            else if (k == 8) { g = pg8::Gemm{Yb, (const bf16_t*)(ws + WS_W + W_OUT), T, DM, DM}; E = pg8::EpiResF32{A.out, A.out, DM, 1.0f}; }
            else { g = pg8::Gemm{HN, (const bf16_t*)(ws + WS_W + W_MIN), T, 512, DM}; E = pg8::EpiResF32{nullptr, (float*)(ws + WS_Y), 512, 1.0f}; }
            pg8::StaticOrder S; S.init(g.M, g.N, G, bx);
            if (EN(3)) pg8::gemm_phase<pg8::EpiResF32, pg8::StaticOrder, true, true>(lds, g, S, E);
        } else if (k == 3) {
            if (!EN(4)) {} else if (even) norm_phase<1>(A.out, A.norm_mix + (size_t)l * DM, HN, nullptr, A.ab_w_in + (size_t)i * DM * 2056, A.ab_b_forget + (size_t)i * 8, LFb, (LAS float*)lds, gw, NGW, lane, tid);
            else norm_phase<0>(A.out, A.norm_mix + (size_t)l * DM, HN, nullptr, nullptr, nullptr, nullptr, nullptr, gw, NGW, lane, tid);
        } else if ((k == 4 && even) || (k == 6 && !even)) {
            const int ng = even ? 2 : 3;
            for (int j = 0; j < ng; ++j) {
                pg8::Gemm g; pg8::EpiBf16S E;
                if (even) {
                    if (j == 0) { g = pg8::Gemm{HN, (const bf16_t*)(ws + WS_W + W_IN), T, 1536, DM}; E = pg8::EpiBf16S{R1, 1536, 512, 1024, 0.125f * LOG2E}; }
                    else { g = pg8::Gemm{(const bf16_t*)(ws + WS_W + W_V), HN, 512, T, DM}; E = pg8::EpiBf16S{VT, T, 0, 0, 1.0f}; }
                } else {
                    if (j == 0) { g = pg8::Gemm{(const bf16_t*)(ws + WS_R1 + R_CQN), (const bf16_t*)(ws + WS_W + W_QB), T, 1536, 256}; E = pg8::EpiBf16S{R1, 1536, 0, 1536, 0.10206207261596577f * LOG2E}; }
                    else if (j == 1) { g = pg8::Gemm{(const bf16_t*)(ws + WS_R1 + R_CKVN), (const bf16_t*)(ws + WS_W + W_KNW), T, 1024, 256}; E = pg8::EpiBf16S{KN, 1024, 0, 0, 1.0f}; }
                    else { g = pg8::Gemm{(const bf16_t*)(ws + WS_W + W_VVW), (const bf16_t*)(ws + WS_R1 + R_CKVN), 1024, T, 256}; E = pg8::EpiBf16S{VT, T, 0, 0, 1.0f}; }
                }
                pg8::StaticOrder S; S.init(g.M, g.N, G, bx);
                if (EN(5)) pg8::gemm_phase<pg8::EpiBf16S, pg8::StaticOrder, true, true>(lds, g, S, E);
                __syncthreads();
            }
        } else if (k == 5) {
            if (!EN(6)) {} else if (even) scan_pool(A, i, lds, gw, NGW, lane, tid, wave);
            else mla_small(A, i, gw, NGW, lane);
        } else if (k == 7) {
            if (even) {
                for (int p = vcu; p < 16 * 32; p += G) { const int bh = p >> 5, s = p & 31, b = bh >> 3, h = bh & 7;
                    for (int z = 0; z < 2; ++z) { const int qb = z ? s : 63 - s;
                        if (EN(7)) attn_unit<64, true>(lds, R1 + (size_t)(b * SEQ) * 1536 + 512 + 64 * h, 1536, R1 + (size_t)(b * SEQ) * 1536 + 1024 + 64 * h, 1536, nullptr,
                                            VT + (size_t)(64 * h) * T + (size_t)b * SEQ, Fb + (size_t)bh * SEQ, nullptr, Yb + (size_t)(b * SEQ) * DM + 512 + 64 * h, qb * 256, tid); } }
            } else {
                for (int p = vcu; p < 32 * 32; p += G) { const int bh = p >> 5, s = p & 31, b = bh >> 4, h = bh & 15;
                    for (int z = 0; z < 2; ++z) { const int qb = z ? s : 63 - s;
                        if (EN(8)) attn_unit<96, false>(lds, R1 + (size_t)(b * SEQ) * 1536 + 96 * h, 1536, KN + (size_t)(b * SEQ) * 1024 + 64 * h, 1024, (const bf16_t*)(ws + WS_R1 + R_KR) + (size_t)(b * SEQ) * 32,
                                             VT + (size_t)(64 * h) * T + (size_t)b * SEQ, nullptr, CS + (size_t)(b * SEQ) * 32, Yb + (size_t)(b * SEQ) * DM + 64 * h, qb * 256, tid); } }
            }
        } else did = false;
        if (did && ph + 1 < ph_hi) { if (do_sync) cg::this_grid().sync(); }
    }
}

extern "C" void kernel_launch(void* const* d_in, const int* in_sizes, int n_in, void* d_out, int out_size, void* d_ws, size_t ws_size, hipStream_t stream) {
    static int grid = 0;
    if (grid == 0) {
        if (n_in != 19 || out_size != T * DM || ws_size < WS_END) { fprintf(stderr, "kernel_launch: unexpected shapes (n_in %d out %d ws %zu)\n", n_in, out_size, ws_size); grid = -1; return; }
        int dev = 0, cus = 0, per_cu = 0;
        hipGetDevice(&dev); hipDeviceGetAttribute(&cus, hipDeviceAttributeMultiprocessorCount, dev);
        if (hipFuncSetAttribute((const void*)fwd_mega, hipFuncAttributeMaxDynamicSharedMemorySize, LDS_BYTES) != hipSuccess) { fprintf(stderr, "kernel_launch: hipFuncSetAttribute failed\n"); grid = -1; return; }
        if (hipOccupancyMaxActiveBlocksPerMultiprocessor(&per_cu, (const void*)fwd_mega, 512, LDS_BYTES) != hipSuccess || per_cu < 1) { fprintf(stderr, "kernel_launch: occupancy query says %d\n", per_cu); per_cu = 1; }
        (void)hipGetLastError();
        grid = cus * 1;
    }
    if (grid < 0) return;
    Args a{};
    a.x = (const float*)d_in[0]; a.pos = (const int*)d_in[1]; a.norm_ffn = (const float*)d_in[2]; a.norm_mix = (const float*)d_in[3]; a.norm_final = (const float*)d_in[4];
    a.w_gate = (const float*)d_in[5]; a.w_up = (const float*)d_in[6]; a.w_down = (const float*)d_in[7];
    a.ab_w_in = (const float*)d_in[8]; a.ab_b_forget = (const float*)d_in[9]; a.pool_w = (const float*)d_in[10]; a.pool_scale = (const float*)d_in[11]; a.ab_w_out = (const float*)d_in[12];
    a.mla_w_in = (const float*)d_in[13]; a.mla_q_norm = (const float*)d_in[14]; a.mla_kv_norm = (const float*)d_in[15]; a.mla_w_q_b = (const float*)d_in[16]; a.mla_w_kv_b = (const float*)d_in[17]; a.mla_w_out = (const float*)d_in[18];
    a.out = (float*)d_out; a.ws = (unsigned char*)d_ws; a.pad = 0;
#if ONE_LAUNCH
    a.ph_lo = 0; a.ph_hi = NPH; a.do_sync = 1;
    void* args[] = {&a};
    hipError_t e = hipLaunchCooperativeKernel((const void*)fwd_mega, dim3(grid), dim3(512), args, LDS_BYTES, stream);
    if (e != hipSuccess) fprintf(stderr, "cooperative launch failed: %s (grid %d)\n", hipGetErrorString(e), grid);
#else
    for (int ph = 0; ph < NPH; ++ph) {
        const int l = ph / 12, k = ph % 12; if (ph != NPH - 1 && k == 6 && !(l & 1)) continue;
        a.ph_lo = ph; a.ph_hi = ph + 1; a.do_sync = 0;
        hipLaunchKernelGGL(fwd_mega, dim3(grid), dim3(512), LDS_BYTES, stream, a);
    }
#endif
}
```

```cpp
#include <hip/hip_runtime.h>
#include <hip/hip_cooperative_groups.h>
#include <cstdio>
#include <cstdint>
namespace cg = cooperative_groups;
#ifndef ONE_LAUNCH
#define ONE_LAUNCH 1
#endif
namespace pg8 {
#define PG8_LAS __attribute__((address_space(3)))
typedef unsigned short bf16_t;
typedef short bf16x8 __attribute__((ext_vector_type(8)));
typedef float f32x4 __attribute__((ext_vector_type(4)));
typedef unsigned u32x4 __attribute__((ext_vector_type(4)));
constexpr int BM = 256, BK = 64, HALF = 128, HTB = HALF * BK * 2  , STAGE_BYTES = 8 * HTB, NXCD = 8, WGM = 8;

__host__ __device__ __forceinline__ int lds_byte(int r, int c) { const int st = (r >> 4) * 2 + (c >> 5), rr = r & 15, cc = c & 31, ob = rr * 64 + cc * 2; return st * 1024 + (ob ^ (((ob >> 9) & 1) << 5)); }
__host__ __device__ __forceinline__ void stage_rc(int b, int& R, int& C) { const int st = b / 1024, sb = b % 1024, swz = sb ^ (((sb >> 9) & 1) << 5); R = (st >> 1) * 16 + swz / 64; C = (st & 1) * 32 + (swz % 64) / 2; }
__host__ __device__ __forceinline__ int perm32(int rho) { const int n = rho >> 4, i = rho & 15; return 8 * (i >> 2) + 4 * n + (i & 3); }

struct Unit { int pm, pn; };
struct Gemm { const bf16_t* A; const bf16_t* Bt; int M, N, K; };

struct StaticOrder {
    int nM, nN, nwg, G, c;
    __host__ __device__ void init(int M, int N, int G_, int c_) { nM = M / BM; nN = N / BM; nwg = nM * nN; G = G_; c = c_; }
    __host__ __device__ bool next(int i, Unit& u) const {
        const long L = (long)i * G + c; if (L >= nwg) return false;
        int wgid = (int)L; { const int q = nwg / NXCD, r = nwg % NXCD, xcd = wgid % NXCD, off = wgid / NXCD; wgid = (xcd < r ? xcd * (q + 1) : r * (q + 1) + (xcd - r) * q) + off; }
        const int nig = WGM * nN, gid = wgid / nig, fm = gid * WGM, gsz = (nM - fm) < WGM ? (nM - fm) : WGM;
        u.pm = fm + ((wgid % nig) % gsz); u.pn = (wgid % nig) / gsz; return true;
    }
    __device__ __forceinline__ void a_ready(const Unit&) const {}
    __device__ __forceinline__ void done(const Unit&) const {}
};
__device__ __forceinline__ unsigned cvt_pk_bf16(float lo, float hi) { unsigned r; asm volatile("v_cvt_pk_bf16_f32 %0, %1, %2" : "=v"(r) : "v"(lo), "v"(hi)); return r; }
typedef float f32x2 __attribute__((ext_vector_type(2)));
struct EpiBf16S {
    static constexpr bool PERM = true, AFTER_DRAIN = false;
    bf16_t* O; int ldc; int sc_lo, sc_hi; float scale;
    __device__ __forceinline__ void operator()(const f32x4 (&acc)[2][2][4][2], const Unit& u, int wr, int wc, int fr, int fq) const {
        const int row0 = u.pm * BM + wr * 64 + fr; const int colt = u.pn * BM;
        const float sc = (colt >= sc_lo && colt < sc_hi) ? scale : 1.f;
        const int col0 = colt + wc * 32 + 8 * fq;
#pragma unroll
        for (int ai = 0; ai < 2; ++ai)
#pragma unroll
            for (int m = 0; m < 4; ++m) { bf16_t* rowp = O + (size_t)(row0 + ai * HALF + m * 16) * ldc + col0;
#pragma unroll
                for (int bj = 0; bj < 2; ++bj) { const f32x4 v0 = acc[ai][bj][m][0] * sc, v1 = acc[ai][bj][m][1] * sc;
                    u32x4 w; w.x = cvt_pk_bf16(v0[0], v0[1]); w.y = cvt_pk_bf16(v0[2], v0[3]); w.z = cvt_pk_bf16(v1[0], v1[1]); w.w = cvt_pk_bf16(v1[2], v1[3]);
                    *(u32x4*)(rowp + bj * HALF) = w; } }
    }
};
struct EpiSwiglu {
    static constexpr bool PERM = true, AFTER_DRAIN = false;
    bf16_t* O; int ldc;
    __device__ __forceinline__ void operator()(const f32x4 (&acc)[2][2][4][2], const Unit& u, int wr, int wc, int fr, int fq) const {
        const int row0 = u.pm * BM + wr * 64 + fr; const int col0 = u.pn * HALF + wc * 32 + 8 * fq;
#pragma unroll
        for (int ai = 0; ai < 2; ++ai)
#pragma unroll
            for (int m = 0; m < 4; ++m) { bf16_t* rowp = O + (size_t)(row0 + ai * HALF + m * 16) * ldc + col0;
                float a[8];
#pragma unroll
                for (int n = 0; n < 2; ++n)
#pragma unroll
                    for (int e = 0; e < 4; ++e) { const float g = acc[ai][0][m][n][e], up = acc[ai][1][m][n][e];
                        const float sg = g * __builtin_amdgcn_rcpf(1.0f + __builtin_amdgcn_exp2f(-1.4426950408889634f * g)); a[n * 4 + e] = sg * up; }
                u32x4 w; w.x = cvt_pk_bf16(a[0], a[1]); w.y = cvt_pk_bf16(a[2], a[3]); w.z = cvt_pk_bf16(a[4], a[5]); w.w = cvt_pk_bf16(a[6], a[7]);
                *(u32x4*)rowp = w; }
    }
};
struct EpiResF32 {
    static constexpr bool PERM = false, AFTER_DRAIN = false;
    const float* base; float* out; int ldc; float alpha;
    __device__ __forceinline__ void operator()(const f32x4 (&acc)[2][2][4][2], const Unit& u, int wr, int wc, int fr, int fq) const {
        const int col0 = u.pn * BM + wc * 32 + 4 * fq;
#pragma unroll
        for (int ai = 0; ai < 2; ++ai)
#pragma unroll
            for (int m = 0; m < 4; ++m) { const int r = u.pm * BM + ai * HALF + wr * 64 + m * 16 + fr; const size_t off = (size_t)r * ldc + col0;
#pragma unroll
                for (int bj = 0; bj < 2; ++bj)
#pragma unroll
                    for (int n = 0; n < 2; ++n) { f32x4 o = acc[ai][bj][m][n] * alpha;
                        if (base) o = o + *(const f32x4*)(base + off + bj * HALF + n * 16);
                        *(f32x4*)(out + off + bj * HALF + n * 16) = o; } }
    }
};

template <class Epi, class Sched, bool ALIGN_EPI = false, bool SP2 = false>
__device__ __forceinline__ void gemm_phase(PG8_LAS unsigned char* lds, const Gemm g, const Sched& S, const Epi& E) {
    int tid_l = threadIdx.x; asm volatile("" : "+v"(tid_l));
    const int tid = tid_l, wid = __builtin_amdgcn_readfirstlane(tid >> 6), lane = tid & 63, wr = wid >> 2, wc = wid & 3, fr = lane & 15, fq = lane >> 4;
    const int K = g.K, nt = K / BK;
    unsigned voffA[2], voffB[2];
#pragma unroll
    for (int i = 0; i < 2; ++i) { int R, C; stage_rc(tid * 16 + i * 8192, R, C); const int Rb = Epi::PERM ? ((R & ~31) + perm32(R & 31)) : R;
        voffA[i] = (unsigned)(R * K + C) * 2u; voffB[i] = (unsigned)(Rb * K + C) * 2u; }
    const size_t kstep = (size_t)(BK * 2);
    const size_t hstep = (size_t)HALF * K * 2;
    const size_t tstep = 2 * hstep;
    const unsigned ldsw = (unsigned)wid * 1024u;
    const int aoff = lds_byte(wr * 64 + fr, fq * 8), boff = lds_byte(wc * 32 + fr, fq * 8);
#define PG8_SA(b, h) (((b) * 2 + (h)) * HTB)
#define PG8_SB(b, h) ((4 + (b) * 2 + (h)) * HTB)
#define PG8_STAGE(bufoff, gbase, voff) do { _Pragma("unroll") for (int _i = 0; _i < 2; ++_i) \
        __builtin_amdgcn_global_load_lds((const unsigned*)((const char*)(gbase) + (voff)[_i]), (PG8_LAS unsigned*)(lds + (bufoff) + ldsw + _i * 8192), 16, 0, 0); } while (0)
#define PG8_LDA(dst, b, h) do { _Pragma("unroll") for (int m = 0; m < 4; ++m) _Pragma("unroll") for (int k = 0; k < 2; ++k) dst[m][k] = *(const PG8_LAS bf16x8*)(lds + PG8_SA(b, h) + aoff + m * 2048 + k * 1024); } while (0)
#define PG8_LDB(dst, b, h) do { _Pragma("unroll") for (int n = 0; n < 2; ++n) _Pragma("unroll") for (int k = 0; k < 2; ++k) dst[n][k] = *(const PG8_LAS bf16x8*)(lds + PG8_SB(b, h) + boff + n * 2048 + k * 1024); } while (0)
#define PG8_MMA(ai, bj, At, Bt) do { __builtin_amdgcn_s_setprio(1); _Pragma("unroll") for (int m = 0; m < 4; ++m) _Pragma("unroll") for (int n = 0; n < 2; ++n) _Pragma("unroll") for (int k = 0; k < 2; ++k) \
        acc[ai][bj][m][n] = __builtin_amdgcn_mfma_f32_16x16x32_bf16(Bt[n][k], At[m][k], acc[ai][bj][m][n], 0, 0, 0); __builtin_amdgcn_s_setprio(0); } while (0)
#define PG8_WAIT_V(n) asm volatile("s_waitcnt vmcnt(" #n ")" ::: "memory")
#define PG8_WAIT_L(n) asm volatile("s_waitcnt lgkmcnt(" #n ")" ::: "memory")
#define PG8_BAR __builtin_amdgcn_s_barrier()
#define PG8_SCHED __builtin_amdgcn_sched_barrier(0)
    Unit cur, nxt; int ui = 0;
    if (!S.next(0, cur)) return;
    f32x4 acc[2][2][4][2];
#pragma unroll
    for (int a = 0; a < 2; ++a)
#pragma unroll
        for (int b = 0; b < 2; ++b)
#pragma unroll
            for (int m = 0; m < 4; ++m)
#pragma unroll
                for (int n = 0; n < 2; ++n) acc[a][b][m][n] = (f32x4){0.f, 0.f, 0.f, 0.f};
    bf16x8 At[4][2], B0[2][2], B1[2][2];
    const char* cA = (const char*)g.A + (size_t)cur.pm * tstep; const char* cB = (const char*)g.Bt + (size_t)cur.pn * tstep;
    S.a_ready(cur);
    if constexpr (SP2) {
        PG8_STAGE(PG8_SB(0, 0), cB, voffB); PG8_STAGE(PG8_SB(0, 1), cB + hstep, voffB); PG8_STAGE(PG8_SA(0, 0), cA, voffA); PG8_STAGE(PG8_SA(0, 1), cA + hstep, voffA);
        if (wr == 1) PG8_BAR;
        PG8_WAIT_V(2); PG8_BAR;
        PG8_STAGE(PG8_SB(1, 0), cB + kstep, voffB); PG8_STAGE(PG8_SA(1, 0), cA + kstep, voffA); PG8_STAGE(PG8_SB(1, 1), cB + hstep + kstep, voffB);
        PG8_WAIT_V(6); PG8_BAR;
    } else {
        PG8_STAGE(PG8_SB(0, 0), cB, voffB); PG8_STAGE(PG8_SA(0, 0), cA, voffA); PG8_STAGE(PG8_SB(0, 1), cB + hstep, voffB); PG8_STAGE(PG8_SA(0, 1), cA + hstep, voffA);
        if (wr == 1) PG8_BAR;
        PG8_WAIT_V(4); PG8_BAR;
        PG8_STAGE(PG8_SB(1, 0), cB + kstep, voffB); PG8_STAGE(PG8_SA(1, 0), cA + kstep, voffA); PG8_STAGE(PG8_SB(1, 1), cB + hstep + kstep, voffB);
        PG8_WAIT_V(6); PG8_BAR;
    }
    for (;;) {
        const bool has_next = S.next(ui + 1, nxt);
        const char* nA = has_next ? (const char*)g.A + (size_t)nxt.pm * tstep : cA; const char* nB = has_next ? (const char*)g.Bt + (size_t)nxt.pn * tstep : cB;
        for (int t = 0; t < nt; t += 2) {
            const bool last = (t == nt - 2);
            const char* a1 = cA + (size_t)(t + 1) * kstep;
            const char* a2 = last ? nA : cA + (size_t)(t + 2) * kstep; const char* b2 = last ? nB : cB + (size_t)(t + 2) * kstep;
            const char* a3 = a2 + kstep; const char* b3 = b2 + kstep;
            if (last && has_next) S.a_ready(nxt);
            if constexpr (SP2) {
            PG8_LDB(B0, 0, 0); PG8_LDB(B1, 0, 1); PG8_SCHED; PG8_LDA(At, 0, 0); PG8_STAGE(PG8_SA(1, 1), a1 + hstep, voffA);
            PG8_WAIT_V(8); PG8_WAIT_L(0); PG8_BAR; PG8_MMA(0, 0, At, B0); PG8_MMA(0, 1, At, B1); PG8_BAR; PG8_SCHED;
            PG8_LDA(At, 0, 1); PG8_STAGE(PG8_SB(0, 0), b2, voffB); PG8_STAGE(PG8_SB(0, 1), b2 + hstep, voffB); PG8_STAGE(PG8_SA(0, 0), a2, voffA);
            PG8_WAIT_V(8); PG8_WAIT_L(0); PG8_BAR; PG8_MMA(1, 0, At, B0); PG8_MMA(1, 1, At, B1); PG8_BAR; PG8_SCHED;
            PG8_LDB(B0, 1, 0); PG8_LDB(B1, 1, 1); PG8_SCHED; PG8_LDA(At, 1, 0); PG8_STAGE(PG8_SA(0, 1), a2 + hstep, voffA);
            PG8_WAIT_V(8); PG8_WAIT_L(0); PG8_BAR; PG8_MMA(0, 0, At, B0); PG8_MMA(0, 1, At, B1); PG8_BAR; PG8_SCHED;
            PG8_LDA(At, 1, 1); PG8_STAGE(PG8_SB(1, 0), b3, voffB); PG8_STAGE(PG8_SB(1, 1), b3 + hstep, voffB); PG8_STAGE(PG8_SA(1, 0), a3, voffA);
            PG8_WAIT_V(8); PG8_WAIT_L(0); PG8_BAR; PG8_MMA(1, 0, At, B0); PG8_MMA(1, 1, At, B1); PG8_BAR; PG8_SCHED;
            } else {
            PG8_LDB(B0, 0, 0); PG8_SCHED; PG8_LDA(At, 0, 0); PG8_STAGE(PG8_SA(1, 1), a1 + hstep, voffA);
            PG8_WAIT_L(8); PG8_BAR; PG8_WAIT_L(0); PG8_MMA(0, 0, At, B0); PG8_BAR; PG8_SCHED;
            PG8_LDB(B1, 0, 1); PG8_STAGE(PG8_SB(0, 0), b2, voffB);
            PG8_BAR; PG8_WAIT_L(0); PG8_MMA(0, 1, At, B1); PG8_BAR;
            PG8_LDA(At, 0, 1); PG8_STAGE(PG8_SA(0, 0), a2, voffA);
            PG8_BAR; PG8_WAIT_L(0); PG8_MMA(1, 0, At, B0); PG8_BAR; PG8_SCHED;
            PG8_STAGE(PG8_SB(0, 1), b2 + hstep, voffB);
            PG8_WAIT_V(6); PG8_BAR; PG8_MMA(1, 1, At, B1); PG8_BAR;
            PG8_LDB(B0, 1, 0); PG8_SCHED; PG8_LDA(At, 1, 0); PG8_STAGE(PG8_SA(0, 1), a2 + hstep, voffA);
            PG8_WAIT_L(8); PG8_BAR; PG8_WAIT_L(0); PG8_MMA(0, 0, At, B0); PG8_BAR; PG8_SCHED;
            PG8_LDB(B1, 1, 1); PG8_STAGE(PG8_SB(1, 0), b3, voffB);
            PG8_BAR; PG8_WAIT_L(0); PG8_MMA(0, 1, At, B1); PG8_BAR;
            PG8_LDA(At, 1, 1); PG8_STAGE(PG8_SA(1, 0), a3, voffA);
            PG8_BAR; PG8_WAIT_L(0); PG8_MMA(1, 0, At, B0); PG8_BAR; PG8_SCHED;
            PG8_STAGE(PG8_SB(1, 1), b3 + hstep, voffB);
            PG8_WAIT_V(6); PG8_BAR; PG8_MMA(1, 1, At, B1); PG8_BAR;
            }
        }
        if constexpr (ALIGN_EPI) { if (wr == 0) PG8_BAR; }
        if constexpr (!Epi::AFTER_DRAIN) { E(acc, cur, wr, wc, fr, fq); S.done(cur); }
        if (!has_next) break;
#pragma unroll
        for (int a = 0; a < 2; ++a)
#pragma unroll
            for (int b = 0; b < 2; ++b)
#pragma unroll
                for (int m = 0; m < 4; ++m)
#pragma unroll
                    for (int n = 0; n < 2; ++n) acc[a][b][m][n] = (f32x4){0.f, 0.f, 0.f, 0.f};
        cur = nxt; cA = nA; cB = nB; ++ui;
        if constexpr (ALIGN_EPI) { if (wr == 1) PG8_BAR; }
    }
    PG8_WAIT_V(0);
    if constexpr (!ALIGN_EPI) { if (wr == 0) PG8_BAR; }
    PG8_BAR;
    if constexpr (Epi::AFTER_DRAIN) { E.fused(acc, cur, wr, wc, fr, fq, lds, wid, lane); S.done(cur); }
#undef PG8_SA
#undef PG8_SB
#undef PG8_STAGE
#undef PG8_LDA
#undef PG8_LDB
#undef PG8_MMA
#undef PG8_WAIT_V
#undef PG8_WAIT_L
#undef PG8_BAR
#undef PG8_SCHED
}
}
#define LAS __attribute__((address_space(3)))
typedef unsigned short bf16_t;
typedef short bf16x8 __attribute__((ext_vector_type(8)));
typedef float f32x4 __attribute__((ext_vector_type(4)));
typedef float f32x16 __attribute__((ext_vector_type(16)));
typedef unsigned u32x4 __attribute__((ext_vector_type(4)));
typedef unsigned u32x2 __attribute__((ext_vector_type(2)));

constexpr int SEQ = 16384, NB = 2, T = NB * SEQ, DM = 1024, FF = 2816;
constexpr size_t MiB = 1u << 20;
constexpr size_t WS_W = 0, WS_HN = 48 * MiB, WS_Y = 112 * MiB, WS_R1 = 176 * MiB, WS_VT = 352 * MiB, WS_KN = 416 * MiB, WS_SM = 480 * MiB, WS_END = 488 * MiB;
constexpr size_t W_GU0 = 0, W_D0 = 11 * MiB, W_GU1 = 17 * MiB, W_D1 = 28 * MiB, W_MIX = 34 * MiB;
constexpr size_t W_IN = W_MIX, W_V = W_MIX + 3 * MiB, W_OUT = W_MIX + 4 * MiB, W_P = W_MIX + 6 * MiB;
constexpr size_t W_MIN = W_MIX, W_QB = W_MIX + 1 * MiB, W_KNW = W_MIX + 2 * MiB, W_VVW = W_MIX + 2 * MiB + 512 * 1024;
constexpr size_t R_Q = 0, R_CQN = 96 * MiB, R_CKVN = 112 * MiB, R_KR = 128 * MiB;
constexpr size_t SM_LF = 0, SM_F = 1 * MiB, SM_CS = 4 * MiB;
constexpr int LDS_BYTES = 147456;
constexpr float LOG2E = 1.4426950408889634f;
constexpr int NPH = 49;
#ifndef EN_MASK
#define EN_MASK 0xFFFF
#endif
#define EN(b) ((EN_MASK >> (b)) & 1)

struct Args {
    const float* x; const int* pos; const float* norm_ffn; const float* norm_mix; const float* norm_final;
    const float* w_gate; const float* w_up; const float* w_down;
    const float* ab_w_in; const float* ab_b_forget; const float* pool_w; const float* pool_scale; const float* ab_w_out;
    const float* mla_w_in; const float* mla_q_norm; const float* mla_kv_norm; const float* mla_w_q_b; const float* mla_w_kv_b; const float* mla_w_out;
    float* out; unsigned char* ws; int ph_lo, ph_hi; int do_sync, pad;
};

__device__ __forceinline__ float wave_sum(float v) {
#pragma unroll
    for (int o = 1; o < 64; o <<= 1) v += __shfl_xor(v, o);
    return v;
}
typedef float f32x2_t __attribute__((ext_vector_type(2))); typedef __bf16 bf16x2_t __attribute__((ext_vector_type(2)));
__device__ __forceinline__ unsigned pk2(float lo, float hi) { f32x2_t v = {lo, hi}; bf16x2_t b = __builtin_convertvector(v, bf16x2_t); return __builtin_bit_cast(unsigned, b); }
__device__ __forceinline__ float bflo(unsigned w) { return __uint_as_float(w << 16); }
__device__ __forceinline__ float bfhi(unsigned w) { return __uint_as_float(w & 0xffff0000u); }
__device__ __forceinline__ float max3f(float a, float b, float c) { float r; asm("v_max3_f32 %0, %1, %2, %3" : "=v"(r) : "v"(a), "v"(b), "v"(c)); return r; }
#define LDS_FENCE() asm volatile("s_waitcnt lgkmcnt(0)" ::: "memory")
#define LBAR() do { asm volatile("s_waitcnt lgkmcnt(0)" ::: "memory"); __builtin_amdgcn_s_barrier(); asm volatile("" ::: "memory"); } while (0)

__device__ __forceinline__ void transpose_item(const float* __restrict__ src, int ld, int k0, bf16_t* __restrict__ dst, int ldd, LAS float* scr, int lane) {
#pragma unroll 8
    for (int i = 0; i < 32; ++i) { const int kk = 2 * i + (lane >> 5); scr[kk * 33 + (lane & 31)] = src[(size_t)(k0 + kk) * ld + (lane & 31)]; }
    LDS_FENCE();
    const int c = lane & 7;
#pragma unroll
    for (int j = 0; j < 4; ++j) { const int n = (lane >> 3) + 8 * j; const LAS float* s = scr + (8 * c) * 33 + n;
        u32x4 o; o.x = pk2(s[0 * 33], s[1 * 33]); o.y = pk2(s[2 * 33], s[3 * 33]); o.z = pk2(s[4 * 33], s[5 * 33]); o.w = pk2(s[6 * 33], s[7 * 33]);
        *(u32x4*)(dst + (size_t)n * ldd + k0 + 8 * c) = o; }
    LDS_FENCE();
}

__device__ __forceinline__ void convert_layer(const Args& A, int l, LAS float* scr, int gw, int NGW, int lane) {
    const int i = l >> 1; const bool even = !(l & 1);
    constexpr int NF = 1408;
    unsigned char* W = A.ws + WS_W;
    const int total = 6 * NF + (even ? (768 + 256 + 512 + 32) : (208 + 192 + 128 + 512));
    for (int it = gw; it < total; it += NGW) {
        int r = it;
        if (r < 6 * NF) {
            const int f = r / (3 * NF), r2 = r % (3 * NF), kind = r2 / NF, q = r2 % NF;
            const size_t wo = (size_t)(l * 2 + f) * DM * FF;
            if (kind < 2) { const int kb = q / 88, nb = q % 88; const float* src = (kind == 0 ? A.w_gate : A.w_up) + wo + 32 * nb;
                bf16_t* dst = (bf16_t*)(W + (f ? W_GU1 : W_GU0)) + (size_t)((nb >> 2) * 256 + (nb & 3) * 32 + kind * 128) * DM;
                transpose_item(src, FF, 64 * kb, dst, DM, scr, lane); }
            else { const int kb = q / 32, nb = q % 32; const float* src = A.w_down + wo + 32 * nb;
                bf16_t* dst = (bf16_t*)(W + (f ? W_D1 : W_D0)) + (size_t)(32 * nb) * FF;
                transpose_item(src, DM, 64 * kb, dst, FF, scr, lane); }
            continue;
        }
        r -= 6 * NF;
        if (even) {
            const float* win = A.ab_w_in + (size_t)i * DM * 2056;
            if (r < 768) { const int kb = r / 48, nb = r % 48; transpose_item(win + 32 * nb, 2056, 64 * kb, (bf16_t*)(W + W_IN) + (size_t)(32 * nb) * DM, DM, scr, lane); continue; } r -= 768;
            if (r < 256) { const int kb = r / 16, nb = r % 16; transpose_item(win + 1536 + 32 * nb, 2056, 64 * kb, (bf16_t*)(W + W_V) + (size_t)(32 * nb) * DM, DM, scr, lane); continue; } r -= 256;
            if (r < 512) { const int kb = r / 32, nb = r % 32; transpose_item(A.ab_w_out + (size_t)i * DM * DM + 32 * nb, DM, 64 * kb, (bf16_t*)(W + W_OUT) + (size_t)(32 * nb) * DM, DM, scr, lane); continue; } r -= 512;
            { const int g = r >> 3, kb = (r & 7) >> 2, nb = r & 3; transpose_item(A.pool_w + (size_t)(i * 4 + g) * 16384 + 32 * nb, 128, 64 * kb, (bf16_t*)(W + W_P) + (size_t)g * 16384 + (size_t)(32 * nb) * 128, 128, scr, lane); }
        } else {
            if (r < 208) { const int kb = r / 13, nb = r % 13; transpose_item(A.mla_w_in + (size_t)i * DM * 416 + 32 * nb, 416, 64 * kb, (bf16_t*)(W + W_MIN) + (size_t)(32 * nb) * DM, DM, scr, lane); continue; } r -= 208;
            if (r < 192) { const int kb = r / 48, nb = r % 48; transpose_item(A.mla_w_q_b + (size_t)i * 256 * 1536 + 32 * nb, 1536, 64 * kb, (bf16_t*)(W + W_QB) + (size_t)(32 * nb) * 256, 256, scr, lane); continue; } r -= 192;
            if (r < 128) { const int kb = r / 64, nb = r % 64; const int col0 = 32 * nb, head = col0 >> 7, within = col0 & 127;
                bf16_t* dst = (within < 64) ? (bf16_t*)(W + W_KNW) + (size_t)(64 * head + within) * 256 : (bf16_t*)(W + W_VVW) + (size_t)(64 * head + within - 64) * 256;
                transpose_item(A.mla_w_kv_b + (size_t)i * 128 * 2048 + col0, 2048, 64 * kb, dst, 256, scr, lane); continue; } r -= 128;
            { const int kb = r / 32, nb = r % 32; transpose_item(A.mla_w_out + (size_t)i * DM * DM + 32 * nb, DM, 64 * kb, (bf16_t*)(W + W_OUT) + (size_t)(32 * nb) * DM, DM, scr, lane); }
        }
    }
    if (!even) {
        const int gt = gw * 64 + lane, NT_ = NGW * 64;
        for (int idx = gt; idx < 2048 * 16; idx += NT_) { const int row = idx >> 4, c = idx & 15;
            *(u32x4*)((bf16_t*)(W + W_KNW) + (size_t)row * 256 + 128 + 8 * c) = (u32x4){0u, 0u, 0u, 0u}; }
    }
}

__device__ __forceinline__ void rope_table(const Args& A, int gw, int NGW, int lane) {
    float* CS = (float*)(A.ws + WS_SM + SM_CS);
    const int gt = gw * 64 + lane, NT_ = NGW * 64;
    for (int idx = gt; idx < T * 16; idx += NT_) {
        const int t = idx >> 4, j = idx & 15;
        const int jm = j & 3, jd = j >> 2;
        const double base = jm == 0 ? 1.0 : (jm == 1 ? 0.5623413251903491 : (jm == 2 ? 0.31622776601683794 : 0.1778279410038923));
        const double p10 = jd == 0 ? 1.0 : (jd == 1 ? 0.1 : (jd == 2 ? 0.01 : 0.001));
        const float invf = (float)(base * p10);
        const float ang = (float)A.pos[t] * invf;
        const double rev = (double)ang * 0.15915494309189535;
        const float fr = (float)(rev - __builtin_rint(rev));
        CS[(size_t)t * 32 + j] = __builtin_amdgcn_cosf(fr);
        CS[(size_t)t * 32 + 16 + j] = __builtin_amdgcn_sinf(fr);
    }
}

template <int MODE>
__device__ __forceinline__ void norm_phase(const float* src, const float* __restrict__ g, bf16_t* dst16, float* dst32,
                                           const float* __restrict__ wfsrc, const float* __restrict__ bforget, float* LF, LAS float* wfT, int gw, int NGW, int lane, int tid) {
    if (MODE == 1) {
        for (int idx = tid; idx < 8192; idx += 512) { const int k = idx >> 3, f = idx & 7; wfT[f * 1024 + k] = wfsrc[(size_t)k * 2056 + 2048 + f]; }
        LDS_FENCE(); __syncthreads();
    }
    f32x4 gv[4];
#pragma unroll
    for (int j = 0; j < 4; ++j) gv[j] = *(const f32x4*)(g + 4 * lane + 256 * j);
    for (int m = gw; m < T; m += NGW) {
        const f32x4* xr = (const f32x4*)(src + (size_t)m * DM) + lane;
        f32x4 v[4]; float ss = 0.f;
#pragma unroll
        for (int j = 0; j < 4; ++j) { v[j] = xr[64 * j]; ss += (v[j].x * v[j].x + v[j].y * v[j].y) + (v[j].z * v[j].z + v[j].w * v[j].w); }
        ss = wave_sum(ss);
        const float rstd = 1.0f / sqrtf(ss * (1.0f / DM) + 1e-6f);
#pragma unroll
        for (int j = 0; j < 4; ++j) v[j] = v[j] * rstd * gv[j];
        if (MODE == 2) {
            f32x4* o = (f32x4*)(dst32 + (size_t)m * DM) + lane;
#pragma unroll
            for (int j = 0; j < 4; ++j) o[64 * j] = v[j];
        } else {
            u32x2* o = (u32x2*)(dst16 + (size_t)m * DM) + lane;
#pragma unroll
            for (int j = 0; j < 4; ++j) { u32x2 w; w.x = pk2(v[j].x, v[j].y); w.y = pk2(v[j].z, v[j].w); o[64 * j] = w; }
        }
        if (MODE == 1) {
            float mine = 0.f;
#pragma unroll
            for (int f = 0; f < 8; ++f) { float a = 0.f;
#pragma unroll
                for (int j = 0; j < 4; ++j) { const f32x4 w = *(const LAS f32x4*)(wfT + f * 1024 + 4 * lane + 256 * j); a += (v[j].x * w.x + v[j].y * w.y) + (v[j].z * w.z + v[j].w * w.w); }
                a = wave_sum(a); mine = (lane == f) ? a : mine; }
            if (lane < 8) { const float xx = mine + bforget[lane];
                const float ls = xx < 0.f ? xx - log1pf(expf(xx)) : -log1pf(expf(-xx));
                const int b = m / SEQ, t = m % SEQ; LF[(size_t)(b * 8 + lane) * SEQ + t] = ls; }
        }
    }
}

__device__ __forceinline__ void mla_small(const Args& A, int i, int gw, int NGW, int lane) {
    const float* PROJ = (const float*)(A.ws + WS_Y);
    bf16_t* CQN = (bf16_t*)(A.ws + WS_R1 + R_CQN); bf16_t* CKVN = (bf16_t*)(A.ws + WS_R1 + R_CKVN); bf16_t* KR = (bf16_t*)(A.ws + WS_R1 + R_KR);
    const float* CS = (const float*)(A.ws + WS_SM + SM_CS);
    const f32x4 gq = *(const f32x4*)(A.mla_q_norm + (size_t)i * 256 + 4 * lane);
    const f32x4 gk = *(const f32x4*)(A.mla_kv_norm + (size_t)i * 128 + 4 * (lane & 31));
    for (int m = gw; m < T; m += NGW) {
        const float* row = PROJ + (size_t)m * 512;
        const f32x4 a = *(const f32x4*)(row + 4 * lane);
        f32x4 b = (f32x4){0.f, 0.f, 0.f, 0.f};
        if (lane < 40) b = *(const f32x4*)(row + 256 + 4 * lane);
        const float sq = wave_sum((a.x * a.x + a.y * a.y) + (a.z * a.z + a.w * a.w));
        const float skv = wave_sum(lane < 32 ? (b.x * b.x + b.y * b.y) + (b.z * b.z + b.w * b.w) : 0.f);
        const float rq = 1.0f / sqrtf(sq * (1.0f / 256.0f) + 1e-6f), rkv = 1.0f / sqrtf(skv * (1.0f / 128.0f) + 1e-6f);
        { const f32x4 y = a * rq * gq; u32x2 w; w.x = pk2(y.x, y.y); w.y = pk2(y.z, y.w); *(u32x2*)(CQN + (size_t)m * 256 + 4 * lane) = w; }
        { const f32x4 y = b * rkv * gk; u32x2 w; w.x = pk2(y.x, y.y); w.y = pk2(y.z, y.w); if (lane >= 32) { w.x = 0u; w.y = 0u; }
          *(u32x2*)(CKVN + (size_t)m * 256 + 4 * lane) = w; }
        f32x4 p; p.x = __shfl_xor(b.x, 4); p.y = __shfl_xor(b.y, 4); p.z = __shfl_xor(b.z, 4); p.w = __shfl_xor(b.w, 4);
        if (lane >= 32 && lane < 40) { const int i0 = 4 * ((lane - 32) & 3);
            const f32x4 c = *(const f32x4*)(CS + (size_t)m * 32 + i0), s = *(const f32x4*)(CS + (size_t)m * 32 + 16 + i0);
            f32x4 o; if (lane < 36) o = b * c - p * s; else o = b * c + p * s;
            u32x2 w; w.x = pk2(o.x, o.y); w.y = pk2(o.z, o.w); *(u32x2*)(KR + (size_t)m * 32 + 4 * (lane - 32)) = w; }
    }
}

__device__ __forceinline__ void scan_pool(const Args& A, int i, LAS unsigned char* lds, int gw, int NGW, int lane, int tid, int wave) {
    if (blockIdx.x < 16) {
        const int bh = blockIdx.x; const float* lf = (const float*)(A.ws + WS_SM + SM_LF) + (size_t)bh * SEQ + tid * 32; double* Fo = (double*)(A.ws + WS_SM + SM_F) + (size_t)bh * SEQ + tid * 32;
        f32x4 v[8]; double tot = 0.0;
#pragma unroll
        for (int e = 0; e < 8; ++e) { v[e] = *(const f32x4*)(lf + 4 * e); tot += ((double)v[e].x + (double)v[e].y) + ((double)v[e].z + (double)v[e].w); }
        double incl = tot;
#pragma unroll
        for (int o = 1; o < 64; o <<= 1) { const double n = __shfl_up(incl, o); if (lane >= o) incl += n; }
        LAS double* wt = (LAS double*)lds;
        if (lane == 63) wt[wave] = incl;
        LDS_FENCE(); __syncthreads();
        double run = incl - tot;
        for (int j = 0; j < wave; ++j) run += wt[j];
#pragma unroll
        for (int e = 0; e < 8; ++e) { double o0, o1, o2, o3; run += (double)v[e].x; o0 = run; run += (double)v[e].y; o1 = run; run += (double)v[e].z; o2 = run; run += (double)v[e].w; o3 = run;
            Fo[4 * e + 0] = o0; Fo[4 * e + 1] = o1; Fo[4 * e + 2] = o2; Fo[4 * e + 3] = o3; }
        __syncthreads();
    }
    const bf16_t* P = (const bf16_t*)(A.ws + WS_R1); bf16_t* Y = (bf16_t*)(A.ws + WS_Y); const bf16_t* WP = (const bf16_t*)(A.ws + WS_W + W_P);
    const float* psc = A.pool_scale + (size_t)i * 512;
    const int r32 = lane & 31, hi = lane >> 5;
    for (int u = gw; u < 4096; u += NGW) {
        const int g = u & 3, rb = u >> 2, wnd = 2 << g;
        const int tg = 32 * rb + r32, t = tg & (SEQ - 1);
        const int cnt = (t + 1 < wnd) ? (t + 1) : wnd; const float inv = 1.0f / (float)cnt;
        const bf16_t* up = P + (size_t)tg * 1536 + 128 * g + 8 * hi;
        bf16x8 af[8];
#pragma unroll
        for (int kk = 0; kk < 8; ++kk) {
            const u32x4 cur = *(const u32x4*)(up + 16 * kk);
            float s0 = bflo(cur.x), s1 = bfhi(cur.x), s2 = bflo(cur.y), s3 = bfhi(cur.y), s4 = bflo(cur.z), s5 = bfhi(cur.z), s6 = bflo(cur.w), s7 = bfhi(cur.w);
            const float c0 = s0, c1 = s1, c2 = s2, c3 = s3, c4 = s4, c5 = s5, c6 = s6, c7 = s7;
            for (int j = 1; j < cnt; ++j) { const u32x4 w = *(const u32x4*)(up - (size_t)j * 1536 + 16 * kk);
                s0 += bflo(w.x); s1 += bfhi(w.x); s2 += bflo(w.y); s3 += bfhi(w.y); s4 += bflo(w.z); s5 += bfhi(w.z); s6 += bflo(w.w); s7 += bfhi(w.w); }
            u32x4 o; o.x = pk2(s0 * inv - c0, s1 * inv - c1); o.y = pk2(s2 * inv - c2, s3 * inv - c3); o.z = pk2(s4 * inv - c4, s5 * inv - c5); o.w = pk2(s6 * inv - c6, s7 * inv - c7);
            af[kk] = __builtin_bit_cast(bf16x8, o);
        }
        const bf16_t* wp = WP + (size_t)g * 16384 + (size_t)r32 * 128 + 8 * hi;
#pragma unroll
        for (int nb = 0; nb < 4; ++nb) {
            f32x16 acc = {};
#pragma unroll
            for (int kk = 0; kk < 8; ++kk) { const bf16x8 bfr = *(const bf16x8*)(wp + (size_t)(32 * nb) * 128 + 16 * kk); acc = __builtin_amdgcn_mfma_f32_32x32x16_bf16(af[kk], bfr, acc, 0, 0, 0); }
            const int col = 128 * g + 32 * nb + r32; const float sc = psc[col];
#pragma unroll
            for (int r = 0; r < 16; ++r) { const int row = 32 * rb + (r & 3) + 8 * (r >> 2) + 4 * hi;
                Y[(size_t)row * DM + col] = (bf16_t)(pk2(acc[r] * sc, 0.f) & 0xffffu); }
        }
    }
}

template <int DK, bool FOX>
__device__ __forceinline__ void attn_unit(LAS unsigned char* lds, const bf16_t* __restrict__ Qp, int ldq, const bf16_t* __restrict__ Kp, int ldk, const bf16_t* __restrict__ Kr,
                                          const bf16_t* __restrict__ VTp, const double* __restrict__ F, const float* __restrict__ CS, bf16_t* Yp, int q0, int tid) {
    constexpr int KSTR = DK * 2 + 16, VSTR = 144, KBYTES = 64 * KSTR, VBYTES = 64 * VSTR;
    constexpr int OFF_K = 0, OFF_V = 2 * KBYTES, OFF_FK = OFF_V + 2 * VBYTES, OFF_WS = OFF_FK + 512;
    constexpr int ND = DK / 16;
    const int lane = tid & 63, r32 = lane & 31, hi = lane >> 5, w = __builtin_amdgcn_readfirstlane(tid >> 6);
    const int wrow0 = q0 + 32 * w, trow = wrow0 + r32;
    bf16x8 qf[ND];
#pragma unroll
    for (int d0 = 0; d0 < ND; ++d0) qf[d0] = *(const bf16x8*)(Qp + (size_t)trow * ldq + 16 * d0 + 8 * hi);
    if (!FOX) {
        const u32x4 a = __builtin_bit_cast(u32x4, qf[ND - 2]), b = __builtin_bit_cast(u32x4, qf[ND - 1]);
        const float* cs = CS + (size_t)trow * 32 + 8 * hi;
        const f32x4 c0 = *(const f32x4*)cs, c1 = *(const f32x4*)(cs + 4), s0 = *(const f32x4*)(cs + 16), s1 = *(const f32x4*)(cs + 20);
        const float x1[8] = {bflo(a.x), bfhi(a.x), bflo(a.y), bfhi(a.y), bflo(a.z), bfhi(a.z), bflo(a.w), bfhi(a.w)};
        const float x2[8] = {bflo(b.x), bfhi(b.x), bflo(b.y), bfhi(b.y), bflo(b.z), bfhi(b.z), bflo(b.w), bfhi(b.w)};
        const float cc[8] = {c0.x, c0.y, c0.z, c0.w, c1.x, c1.y, c1.z, c1.w}, sn[8] = {s0.x, s0.y, s0.z, s0.w, s1.x, s1.y, s1.z, s1.w};
        u32x4 oa, ob;
        oa.x = pk2(x1[0] * cc[0] - x2[0] * sn[0], x1[1] * cc[1] - x2[1] * sn[1]); oa.y = pk2(x1[2] * cc[2] - x2[2] * sn[2], x1[3] * cc[3] - x2[3] * sn[3]);
        oa.z = pk2(x1[4] * cc[4] - x2[4] * sn[4], x1[5] * cc[5] - x2[5] * sn[5]); oa.w = pk2(x1[6] * cc[6] - x2[6] * sn[6], x1[7] * cc[7] - x2[7] * sn[7]);
        ob.x = pk2(x2[0] * cc[0] + x1[0] * sn[0], x2[1] * cc[1] + x1[1] * sn[1]); ob.y = pk2(x2[2] * cc[2] + x1[2] * sn[2], x2[3] * cc[3] + x1[3] * sn[3]);
        ob.z = pk2(x2[4] * cc[4] + x1[4] * sn[4], x2[5] * cc[5] + x1[5] * sn[5]); ob.w = pk2(x2[6] * cc[6] + x1[6] * sn[6], x2[7] * cc[7] + x1[7] * sn[7]);
        qf[ND - 2] = __builtin_bit_cast(bf16x8, oa); qf[ND - 1] = __builtin_bit_cast(bf16x8, ob);
    }
    float fq2 = 0.f; double Fref = 0.0;
    if (FOX) { Fref = F[q0]; fq2 = (float)((F[trow] - Fref) * (double)LOG2E); }
    f32x16 o0 = {}, o1 = {}; f32x16 negm = {}; float mrun = 0.f, lrun = 0.f;
    const int ktmax = (q0 >> 6) + 3, wkt = wrow0 >> 6;
    const int krow = tid >> 3, kch = tid & 7, rrow = (tid >> 2) & 63, rch = tid & 3;
    const bf16_t* kg = Kp + (size_t)krow * ldk + kch * 8;
    const bf16_t* vg = VTp + (size_t)krow * T + kch * 8;
    const bf16_t* rg = FOX ? Kp : Kr + (size_t)rrow * 32 + rch * 8;
    u32x4 kreg, vreg, rreg = {}; float fkreg = 0.f;
#define AT_GLOAD(kt) do { kreg = *(const u32x4*)(kg + (size_t)(kt) * 64 * ldk); vreg = *(const u32x4*)(vg + (size_t)(kt) * 64); \
        if (!FOX && tid < 256) rreg = *(const u32x4*)(rg + (size_t)(kt) * 64 * 32); \
        if (FOX && tid < 64) fkreg = -(float)((F[(kt) * 64 + tid] - Fref) * (double)LOG2E); } while (0)
#define AT_LWRITE(b) do { *(LAS u32x4*)(lds + OFF_K + (b) * KBYTES + krow * KSTR + kch * 16) = kreg; *(LAS u32x4*)(lds + OFF_V + (b) * VBYTES + krow * VSTR + kch * 16) = vreg; \
        if (!FOX && tid < 256) *(LAS u32x4*)(lds + OFF_K + (b) * KBYTES + rrow * KSTR + 128 + rch * 16) = rreg; \
        if (FOX && tid < 64) *(LAS float*)(lds + OFF_FK + (b) * 256 + tid * 4) = fkreg; } while (0)
    LAS float* wsf = (LAS float*)(lds + OFF_WS) + w * 64;
    const int sig = (r32 & 0x13) | ((r32 & 4) << 1) | ((r32 & 8) >> 1);
    AT_GLOAD(ktmax); AT_LWRITE(0); LBAR();
    int buf = 0;
    for (int kt = ktmax; kt >= 0; --kt) {
        if (kt > 0) AT_GLOAD(kt - 1);
        if (kt <= wkt) {
            const LAS unsigned char* kb = lds + OFF_K + buf * KBYTES + sig * KSTR + hi * 16;
            bf16x8 kf[2 * ND];
#pragma unroll
            for (int d0 = 0; d0 < ND; ++d0) { kf[2 * d0] = *(const LAS bf16x8*)(kb + d0 * 32); kf[2 * d0 + 1] = *(const LAS bf16x8*)(kb + 32 * KSTR + d0 * 32); }
            f32x16 s0, s1;
            if (FOX) { const LAS float* fk = (const LAS float*)(lds + OFF_FK + buf * 256) + 8 * hi; const float cq = fq2 - mrun;
                const f32x4 a0 = *(const LAS f32x4*)(fk), a1 = *(const LAS f32x4*)(fk + 4), a2 = *(const LAS f32x4*)(fk + 16), a3 = *(const LAS f32x4*)(fk + 20);
                const f32x4 b0 = *(const LAS f32x4*)(fk + 32), b1 = *(const LAS f32x4*)(fk + 36), b2 = *(const LAS f32x4*)(fk + 48), b3 = *(const LAS f32x4*)(fk + 52);
#pragma unroll
                for (int e = 0; e < 4; ++e) { s0[e] = a0[e] + cq; s0[4 + e] = a1[e] + cq; s0[8 + e] = a2[e] + cq; s0[12 + e] = a3[e] + cq;
                                              s1[e] = b0[e] + cq; s1[4 + e] = b1[e] + cq; s1[8 + e] = b2[e] + cq; s1[12 + e] = b3[e] + cq; }
            } else { s0 = negm; s1 = negm; }
            __builtin_amdgcn_sched_barrier(0);
#pragma unroll
            for (int d0 = 0; d0 < ND; ++d0) {
                s0 = __builtin_amdgcn_mfma_f32_32x32x16_bf16(kf[2 * d0], qf[d0], s0, 0, 0, 0); s1 = __builtin_amdgcn_mfma_f32_32x32x16_bf16(kf[2 * d0 + 1], qf[d0], s1, 0, 0, 0); }
            const LAS unsigned char* vb = lds + OFF_V + buf * VBYTES + r32 * VSTR + hi * 16;
            bf16x8 vf[8];
#pragma unroll
            for (int c = 0; c < 4; ++c) { vf[2 * c] = *(const LAS bf16x8*)(vb + 32 * c); vf[2 * c + 1] = *(const LAS bf16x8*)(vb + 32 * VSTR + 32 * c); }
            __builtin_amdgcn_sched_barrier(0);
            if (FOX && (64 * kt + 63 > wrow0)) { const int kv0 = 64 * kt + 8 * hi;
#pragma unroll
                for (int r = 0; r < 16; ++r) { const int kv = kv0 + 16 * (r >> 3) + (r & 7); if (kv > trow) s0[r] = -INFINITY; if (kv + 32 > trow) s1[r] = -INFINITY; } }
            float ma = max3f(s0[0], s0[1], s1[0]), mb = max3f(s0[2], s0[3], s1[1]); ma = max3f(ma, s1[2], s1[3]);
#pragma unroll
            for (int r = 4; r < 16; r += 4) { ma = max3f(ma, s0[r], s0[r + 1]); mb = max3f(mb, s0[r + 2], s0[r + 3]); ma = max3f(ma, s1[r], s1[r + 1]); mb = max3f(mb, s1[r + 2], s1[r + 3]); }
            float mloc = max3f(ma, mb, mb);
            mloc = max3f(mloc, __shfl_xor(mloc, 32), mloc);
            if (__any(mloc > 8.0f)) {
                const float dl = fmaxf(mloc, 0.f); mrun += dl; const float alpha = __builtin_amdgcn_exp2f(-dl); lrun *= alpha;
#pragma unroll
                for (int r = 0; r < 16; ++r) { s0[r] -= dl; s1[r] -= dl; negm[r] = -mrun; }
                if (hi == 0) wsf[r32] = alpha;
                LDS_FENCE();
#pragma unroll
                for (int r4 = 0; r4 < 4; ++r4) { const f32x4 al = *(const LAS f32x4*)(wsf + 8 * r4 + 4 * hi);
#pragma unroll
                    for (int e = 0; e < 4; ++e) { o0[4 * r4 + e] *= al[e]; o1[4 * r4 + e] *= al[e]; } }
                LDS_FENCE();
            }
            float ls = 0.f;
#pragma unroll
            for (int r = 0; r < 16; ++r) { s0[r] = __builtin_amdgcn_exp2f(s0[r]); s1[r] = __builtin_amdgcn_exp2f(s1[r]); ls += s0[r] + s1[r]; }
            lrun += ls;
            u32x4 p0, p1, p2, p3;
            p0.x = pk2(s0[0], s0[1]); p0.y = pk2(s0[2], s0[3]); p0.z = pk2(s0[4], s0[5]); p0.w = pk2(s0[6], s0[7]);
            p1.x = pk2(s0[8], s0[9]); p1.y = pk2(s0[10], s0[11]); p1.z = pk2(s0[12], s0[13]); p1.w = pk2(s0[14], s0[15]);
            p2.x = pk2(s1[0], s1[1]); p2.y = pk2(s1[2], s1[3]); p2.z = pk2(s1[4], s1[5]); p2.w = pk2(s1[6], s1[7]);
            p3.x = pk2(s1[8], s1[9]); p3.y = pk2(s1[10], s1[11]); p3.z = pk2(s1[12], s1[13]); p3.w = pk2(s1[14], s1[15]);
            const bf16x8 pa0 = __builtin_bit_cast(bf16x8, p0), pa1 = __builtin_bit_cast(bf16x8, p1), pa2 = __builtin_bit_cast(bf16x8, p2), pa3 = __builtin_bit_cast(bf16x8, p3);
            o0 = __builtin_amdgcn_mfma_f32_32x32x16_bf16(pa0, vf[0], o0, 0, 0, 0); o1 = __builtin_amdgcn_mfma_f32_32x32x16_bf16(pa0, vf[1], o1, 0, 0, 0);
            o0 = __builtin_amdgcn_mfma_f32_32x32x16_bf16(pa1, vf[2], o0, 0, 0, 0); o1 = __builtin_amdgcn_mfma_f32_32x32x16_bf16(pa1, vf[3], o1, 0, 0, 0);
            o0 = __builtin_amdgcn_mfma_f32_32x32x16_bf16(pa2, vf[4], o0, 0, 0, 0); o1 = __builtin_amdgcn_mfma_f32_32x32x16_bf16(pa2, vf[5], o1, 0, 0, 0);
            o0 = __builtin_amdgcn_mfma_f32_32x32x16_bf16(pa3, vf[6], o0, 0, 0, 0); o1 = __builtin_amdgcn_mfma_f32_32x32x16_bf16(pa3, vf[7], o1, 0, 0, 0);
        }
        if (kt > 0) AT_LWRITE(buf ^ 1);
        LBAR(); buf ^= 1;
    }
#undef AT_GLOAD
#undef AT_LWRITE
    lrun += __shfl_xor(lrun, 32);
    if (hi == 0) wsf[32 + r32] = lrun;
    LDS_FENCE();
#pragma unroll
    for (int r4 = 0; r4 < 4; ++r4) { const f32x4 lv = *(const LAS f32x4*)(wsf + 32 + 8 * r4 + 4 * hi);
#pragma unroll
        for (int e = 0; e < 4; ++e) { const float inv = 1.0f / lv[e]; const int row = wrow0 + e + 8 * r4 + 4 * hi;
            Yp[(size_t)row * DM + r32] = (bf16_t)(pk2(o0[4 * r4 + e] * inv, 0.f) & 0xffffu);
            Yp[(size_t)row * DM + 32 + r32] = (bf16_t)(pk2(o1[4 * r4 + e] * inv, 0.f) & 0xffffu); } }
    LDS_FENCE();
}

__global__ void __launch_bounds__(512, 2) fwd_mega(Args Akern) {
    extern __shared__ __attribute__((aligned(16))) unsigned char lds_raw[];
    LAS unsigned char* lds = (LAS unsigned char*)lds_raw;
    const int G = gridDim.x, bx = blockIdx.x;
    const int vcu = (G % 8 == 0) ? (bx % 8) * (G / 8) + bx / 8 : bx;
    const int NGW = G * 8;
    const int ph_lo = Akern.ph_lo, ph_hi = Akern.ph_hi, do_sync = Akern.do_sync;
#if defined(__HIP_DEVICE_COMPILE__)
    const __attribute__((address_space(4))) Args* Ak = (const __attribute__((address_space(4))) Args*)__builtin_amdgcn_kernarg_segment_ptr();
#else
    const Args* Ak = &Akern;
#endif

    for (int ph = ph_lo; ph < ph_hi; ++ph) {
        asm volatile("" : "+s"(Ak));
        const Args A = *Ak;
        int tid = threadIdx.x; asm volatile("" : "+v"(tid));
        const int lane = tid & 63, wave = __builtin_amdgcn_readfirstlane(tid >> 6), gw = vcu * 8 + wave;
        unsigned char* ws = A.ws;
        bf16_t* HN = (bf16_t*)(ws + WS_HN); bf16_t* Yb = (bf16_t*)(ws + WS_Y); bf16_t* R1 = (bf16_t*)(ws + WS_R1); bf16_t* VT = (bf16_t*)(ws + WS_VT); bf16_t* KN = (bf16_t*)(ws + WS_KN);
        float* LFb = (float*)(ws + WS_SM + SM_LF); const double* Fb = (const double*)(ws + WS_SM + SM_F); const float* CS = (const float*)(ws + WS_SM + SM_CS);
        const int l = ph / 12, k = ph % 12, i = l >> 1; const bool even = !(l & 1);
        bool did = true;
        if (ph == NPH - 1) {
            if (EN(0)) norm_phase<2>(A.out, A.norm_final, nullptr, A.out, nullptr, nullptr, nullptr, nullptr, gw, NGW, lane, tid);
        } else if (k == 0 || k == 9) {
            const int f = (k == 0) ? 0 : 1;
            if (EN(1)) if (k == 0) { convert_layer(A, l, (LAS float*)(lds + wave * 16384), gw, NGW, lane); if (l == 0) rope_table(A, gw, NGW, lane); }
            if (EN(0)) norm_phase<0>((l == 0 && k == 0) ? A.x : A.out, A.norm_ffn + (size_t)(l * 2 + f) * DM, HN, nullptr, nullptr, nullptr, nullptr, nullptr, gw, NGW, lane, tid);
        } else if (k == 1 || k == 10) {
            const int f = (k == 1) ? 0 : 1;
            pg8::Gemm g{HN, (const bf16_t*)(ws + WS_W + (f ? W_GU1 : W_GU0)), T, 2 * FF, DM}; pg8::StaticOrder S; S.init(T, 2 * FF, G, bx);
            pg8::EpiSwiglu E{R1, FF};
            if (EN(2)) pg8::gemm_phase<pg8::EpiSwiglu, pg8::StaticOrder, true, true>(lds, g, S, E);
        } else if (k == 2 || k == 11 || k == 8 || (k == 4 && !even)) {
            pg8::Gemm g; pg8::EpiResF32 E;
            if (k == 2 || k == 11) { const int f = (k == 2) ? 0 : 1; g = pg8::Gemm{R1, (const bf16_t*)(ws + WS_W + (f ? W_D1 : W_D0)), T, DM, FF};
                E = pg8::EpiResF32{(l == 0 && k == 2) ? A.x : A.out, A.out, DM, 0.5f}; }
            else if (k == 8) { g = pg8::Gemm{Yb, (const bf16_t*)(ws + WS_W + W_OUT), T, DM, DM}; E = pg8::EpiResF32{A.out, A.out, DM, 1.0f}; }
            else { g = pg8::Gemm{HN, (const bf16_t*)(ws + WS_W + W_MIN), T, 512, DM}; E = pg8::EpiResF32{nullptr, (float*)(ws + WS_Y), 512, 1.0f}; }
            pg8::StaticOrder S; S.init(g.M, g.N, G, bx);
            if (EN(3)) pg8::gemm_phase<pg8::EpiResF32, pg8::StaticOrder, true, true>(lds, g, S, E);
        } else if (k == 3) {
            if (!EN(4)) {} else if (even) norm_phase<1>(A.out, A.norm_mix + (size_t)l * DM, HN, nullptr, A.ab_w_in + (size_t)i * DM * 2056, A.ab_b_forget + (size_t)i * 8, LFb, (LAS float*)lds, gw, NGW, lane, tid);
            else norm_phase<0>(A.out, A.norm_mix + (size_t)l * DM, HN, nullptr, nullptr, nullptr, nullptr, nullptr, gw, NGW, lane, tid);
        } else if ((k == 4 && even) || (k == 6 && !even)) {
            const int ng = even ? 2 : 3;
            for (int j = 0; j < ng; ++j) {
                pg8::Gemm g; pg8::EpiBf16S E;
                if (even) {
                    if (j == 0) { g = pg8::Gemm{HN, (const bf16_t*)(ws + WS_W + W_IN), T, 1536, DM}; E = pg8::EpiBf16S{R1, 1536, 512, 1024, 0.125f * LOG2E}; }
                    else { g = pg8::Gemm{(const bf16_t*)(ws + WS_W + W_V), HN, 512, T, DM}; E = pg8::EpiBf16S{VT, T, 0, 0, 1.0f}; }
                } else {
                    if (j == 0) { g = pg8::Gemm{(const bf16_t*)(ws + WS_R1 + R_CQN), (const bf16_t*)(ws + WS_W + W_QB), T, 1536, 256}; E = pg8::EpiBf16S{R1, 1536, 0, 1536, 0.10206207261596577f * LOG2E}; }
                    else if (j == 1) { g = pg8::Gemm{(const bf16_t*)(ws + WS_R1 + R_CKVN), (const bf16_t*)(ws + WS_W + W_KNW), T, 1024, 256}; E = pg8::EpiBf16S{KN, 1024, 0, 0, 1.0f}; }
                    else { g = pg8::Gemm{(const bf16_t*)(ws + WS_W + W_VVW), (const bf16_t*)(ws + WS_R1 + R_CKVN), 1024, T, 256}; E = pg8::EpiBf16S{VT, T, 0, 0, 1.0f}; }
                }
                pg8::StaticOrder S; S.init(g.M, g.N, G, bx);
                if (EN(5)) pg8::gemm_phase<pg8::EpiBf16S, pg8::StaticOrder, true, true>(lds, g, S, E);
                __syncthreads();
            }
        } else if (k == 5) {
            if (!EN(6)) {} else if (even) scan_pool(A, i, lds, gw, NGW, lane, tid, wave);
            else mla_small(A, i, gw, NGW, lane);
        } else if (k == 7) {
            if (even) {
                for (int p = vcu; p < 16 * 32; p += G) { const int bh = p >> 5, s = p & 31, b = bh >> 3, h = bh & 7;
                    for (int z = 0; z < 2; ++z) { const int qb = z ? s : 63 - s;
                        if (EN(7)) attn_unit<64, true>(lds, R1 + (size_t)(b * SEQ) * 1536 + 512 + 64 * h, 1536, R1 + (size_t)(b * SEQ) * 1536 + 1024 + 64 * h, 1536, nullptr,
                                            VT + (size_t)(64 * h) * T + (size_t)b * SEQ, Fb + (size_t)bh * SEQ, nullptr, Yb + (size_t)(b * SEQ) * DM + 512 + 64 * h, qb * 256, tid); } }
            } else {
                for (int p = vcu; p < 32 * 32; p += G) { const int bh = p >> 5, s = p & 31, b = bh >> 4, h = bh & 15;
                    for (int z = 0; z < 2; ++z) { const int qb = z ? s : 63 - s;
                        if (EN(8)) attn_unit<96, false>(lds, R1 + (size_t)(b * SEQ) * 1536 + 96 * h, 1536, KN + (size_t)(b * SEQ) * 1024 + 64 * h, 1024, (const bf16_t*)(ws + WS_R1 + R_KR) + (size_t)(b * SEQ) * 32,
                                             VT + (size_t)(64 * h) * T + (size_t)b * SEQ, nullptr, CS + (size_t)(b * SEQ) * 32, Yb + (size_t)(b * SEQ) * DM + 64 * h, qb * 256, tid); } }
            }
        } else did = false;
        if (did && ph + 1 < ph_hi) { if (do_sync) cg::this_grid().sync(); }
    }
}

extern "C" void kernel_launch(void* const* d_in, const int* in_sizes, int n_in, void* d_out, int out_size, void* d_ws, size_t ws_size, hipStream_t stream) {
    static int grid = 0;
    if (grid == 0) {
        if (n_in != 19 || out_size != T * DM || ws_size < WS_END) { fprintf(stderr, "kernel_launch: unexpected shapes (n_in %d out %d ws %zu)\n", n_in, out_size, ws_size); grid = -1; return; }
        int dev = 0, cus = 0, per_cu = 0;
        hipGetDevice(&dev); hipDeviceGetAttribute(&cus, hipDeviceAttributeMultiprocessorCount, dev);
        if (hipFuncSetAttribute((const void*)fwd_mega, hipFuncAttributeMaxDynamicSharedMemorySize, LDS_BYTES) != hipSuccess) { fprintf(stderr, "kernel_launch: hipFuncSetAttribute failed\n"); grid = -1; return; }
        if (hipOccupancyMaxActiveBlocksPerMultiprocessor(&per_cu, (const void*)fwd_mega, 512, LDS_BYTES) != hipSuccess || per_cu < 1) { fprintf(stderr, "kernel_launch: occupancy query says %d\n", per_cu); per_cu = 1; }
        (void)hipGetLastError();
        grid = cus * 1;
    }
    if (grid < 0) return;
    Args a{};
    a.x = (const float*)d_in[0]; a.pos = (const int*)d_in[1]; a.norm_ffn = (const float*)d_in[2]; a.norm_mix = (const float*)d_in[3]; a.norm_final = (const float*)d_in[4];
    a.w_gate = (const float*)d_in[5]; a.w_up = (const float*)d_in[6]; a.w_down = (const float*)d_in[7];
    a.ab_w_in = (const float*)d_in[8]; a.ab_b_forget = (const float*)d_in[9]; a.pool_w = (const float*)d_in[10]; a.pool_scale = (const float*)d_in[11]; a.ab_w_out = (const float*)d_in[12];
    a.mla_w_in = (const float*)d_in[13]; a.mla_q_norm = (const float*)d_in[14]; a.mla_kv_norm = (const float*)d_in[15]; a.mla_w_q_b = (const float*)d_in[16]; a.mla_w_kv_b = (const float*)d_in[17]; a.mla_w_out = (const float*)d_in[18];
    a.out = (float*)d_out; a.ws = (unsigned char*)d_ws; a.pad = 0;
#if ONE_LAUNCH
    a.ph_lo = 0; a.ph_hi = NPH; a.do_sync = 1;
    void* args[] = {&a};
    hipError_t e = hipLaunchCooperativeKernel((const void*)fwd_mega, dim3(grid), dim3(512), args, LDS_BYTES, stream);
    if (e != hipSuccess) fprintf(stderr, "cooperative launch failed: %s (grid %d)\n", hipGetErrorString(e), grid);
#else
    for (int ph = 0; ph < NPH; ++ph) {
        const int l = ph / 12, k = ph % 12; if (ph != NPH - 1 && k == 6 && !(l & 1)) continue;
        a.ph_lo = ph; a.ph_hi = ph + 1; a.do_sync = 0;
        hipLaunchKernelGGL(fwd_mega, dim3(grid), dim3(512), LDS_BYTES, stream, a);
    }
#endif
}
```

```cpp
#include <hip/hip_runtime.h>
#include <hip/hip_cooperative_groups.h>
#include <cstdio>
#include <cstdint>
namespace cg = cooperative_groups;
#ifndef ONE_LAUNCH
#define ONE_LAUNCH 1
#endif
namespace pg8 {
#define PG8_LAS __attribute__((address_space(3)))
typedef unsigned short bf16_t;
typedef short bf16x8 __attribute__((ext_vector_type(8)));
typedef float f32x4 __attribute__((ext_vector_type(4)));
typedef unsigned u32x4 __attribute__((ext_vector_type(4)));
constexpr int BM = 256, BK = 64, HALF = 128, HTB = HALF * BK * 2  , STAGE_BYTES = 8 * HTB, NXCD = 8, WGM = 8;

__host__ __device__ __forceinline__ int lds_byte(int r, int c) { const int st = (r >> 4) * 2 + (c >> 5), rr = r & 15, cc = c & 31, ob = rr * 64 + cc * 2; return st * 1024 + (ob ^ (((ob >> 9) & 1) << 5)); }
__host__ __device__ __forceinline__ void stage_rc(int b, int& R, int& C) { const int st = b / 1024, sb = b % 1024, swz = sb ^ (((sb >> 9) & 1) << 5); R = (st >> 1) * 16 + swz / 64; C = (st & 1) * 32 + (swz % 64) / 2; }
__host__ __device__ __forceinline__ int perm32(int rho) { const int n = rho >> 4, i = rho & 15; return 8 * (i >> 2) + 4 * n + (i & 3); }

struct Unit { int pm, pn; };
struct Gemm { const bf16_t* A; const bf16_t* Bt; int M, N, K; };

struct StaticOrder {
    int nM, nN, nwg, G, c;
    __host__ __device__ void init(int M, int N, int G_, int c_) { nM = M / BM; nN = N / BM; nwg = nM * nN; G = G_; c = c_; }
    __host__ __device__ bool next(int i, Unit& u) const {
        const long L = (long)i * G + c; if (L >= nwg) return false;
        int wgid = (int)L; { const int q = nwg / NXCD, r = nwg % NXCD, xcd = wgid % NXCD, off = wgid / NXCD; wgid = (xcd < r ? xcd * (q + 1) : r * (q + 1) + (xcd - r) * q) + off; }
        const int nig = WGM * nN, gid = wgid / nig, fm = gid * WGM, gsz = (nM - fm) < WGM ? (nM - fm) : WGM;
        u.pm = fm + ((wgid % nig) % gsz); u.pn = (wgid % nig) / gsz; return true;
    }
    __device__ __forceinline__ void a_ready(const Unit&) const {}
    __device__ __forceinline__ void done(const Unit&) const {}
};
__device__ __forceinline__ unsigned cvt_pk_bf16(float lo, float hi) { unsigned r; asm volatile("v_cvt_pk_bf16_f32 %0, %1, %2" : "=v"(r) : "v"(lo), "v"(hi)); return r; }
typedef float f32x2 __attribute__((ext_vector_type(2)));
struct EpiBf16S {
    static constexpr bool PERM = true, AFTER_DRAIN = false;
    bf16_t* O; int ldc; int sc_lo, sc_hi; float scale;
    __device__ __forceinline__ void operator()(const f32x4 (&acc)[2][2][4][2], const Unit& u, int wr, int wc, int fr, int fq) const {
        const int row0 = u.pm * BM + wr * 64 + fr; const int colt = u.pn * BM;
        const float sc = (colt >= sc_lo && colt < sc_hi) ? scale : 1.f;
        const int col0 = colt + wc * 32 + 8 * fq;
#pragma unroll
        for (int ai = 0; ai < 2; ++ai)
#pragma unroll
            for (int m = 0; m < 4; ++m) { bf16_t* rowp = O + (size_t)(row0 + ai * HALF + m * 16) * ldc + col0;
#pragma unroll
                for (int bj = 0; bj < 2; ++bj) { const f32x4 v0 = acc[ai][bj][m][0] * sc, v1 = acc[ai][bj][m][1] * sc;
                    u32x4 w; w.x = cvt_pk_bf16(v0[0], v0[1]); w.y = cvt_pk_bf16(v0[2], v0[3]); w.z = cvt_pk_bf16(v1[0], v1[1]); w.w = cvt_pk_bf16(v1[2], v1[3]);
                    *(u32x4*)(rowp + bj * HALF) = w; } }
    }
};
struct EpiSwiglu {
    static constexpr bool PERM = true, AFTER_DRAIN = false;
    bf16_t* O; int ldc;
    __device__ __forceinline__ void operator()(const f32x4 (&acc)[2][2][4][2], const Unit& u, int wr, int wc, int fr, int fq) const {
        const int row0 = u.pm * BM + wr * 64 + fr; const int col0 = u.pn * HALF + wc * 32 + 8 * fq;
#pragma unroll
        for (int ai = 0; ai < 2; ++ai)
#pragma unroll
            for (int m = 0; m < 4; ++m) { bf16_t* rowp = O + (size_t)(row0 + ai * HALF + m * 16) * ldc + col0;
                float a[8];
#pragma unroll
                for (int n = 0; n < 2; ++n)
#pragma unroll
                    for (int e = 0; e < 4; ++e) { const float g = acc[ai][0][m][n][e], up = acc[ai][1][m][n][e];
                        const float sg = g * __builtin_amdgcn_rcpf(1.0f + __builtin_amdgcn_exp2f(-1.4426950408889634f * g)); a[n * 4 + e] = sg * up; }
                u32x4 w; w.x = cvt_pk_bf16(a[0], a[1]); w.y = cvt_pk_bf16(a[2], a[3]); w.z = cvt_pk_bf16(a[4], a[5]); w.w = cvt_pk_bf16(a[6], a[7]);
                *(u32x4*)rowp = w; }
    }
};
struct EpiResF32 {
    static constexpr bool PERM = false, AFTER_DRAIN = false;
    const float* base; float* out; int ldc; float alpha;
    __device__ __forceinline__ void operator()(const f32x4 (&acc)[2][2][4][2], const Unit& u, int wr, int wc, int fr, int fq) const {
        const int col0 = u.pn * BM + wc * 32 + 4 * fq;
#pragma unroll
        for (int ai = 0; ai < 2; ++ai)
#pragma unroll
            for (int m = 0; m < 4; ++m) { const int r = u.pm * BM + ai * HALF + wr * 64 + m * 16 + fr; const size_t off = (size_t)r * ldc + col0;
#pragma unroll
                for (int bj = 0; bj < 2; ++bj)
#pragma unroll
                    for (int n = 0; n < 2; ++n) { f32x4 o = acc[ai][bj][m][n] * alpha;
                        if (base) o = o + *(const f32x4*)(base + off + bj * HALF + n * 16);
                        *(f32x4*)(out + off + bj * HALF + n * 16) = o; } }
    }
};

template <class Epi, class Sched, bool ALIGN_EPI = false, bool SP2 = false>
__device__ __forceinline__ void gemm_phase(PG8_LAS unsigned char* lds, const Gemm g, const Sched& S, const Epi& E) {
    int tid_l = threadIdx.x; asm volatile("" : "+v"(tid_l));
    const int tid = tid_l, wid = __builtin_amdgcn_readfirstlane(tid >> 6), lane = tid & 63, wr = wid >> 2, wc = wid & 3, fr = lane & 15, fq = lane >> 4;
    const int K = g.K, nt = K / BK;
    unsigned voffA[2], voffB[2];
#pragma unroll
    for (int i = 0; i < 2; ++i) { int R, C; stage_rc(tid * 16 + i * 8192, R, C); const int Rb = Epi::PERM ? ((R & ~31) + perm32(R & 31)) : R;
        voffA[i] = (unsigned)(R * K + C) * 2u; voffB[i] = (unsigned)(Rb * K + C) * 2u; }
    const size_t kstep = (size_t)(BK * 2);
    const size_t hstep = (size_t)HALF * K * 2;
    const size_t tstep = 2 * hstep;
    const unsigned ldsw = (unsigned)wid * 1024u;
    const int aoff = lds_byte(wr * 64 + fr, fq * 8), boff = lds_byte(wc * 32 + fr, fq * 8);
#define PG8_SA(b, h) (((b) * 2 + (h)) * HTB)
#define PG8_SB(b, h) ((4 + (b) * 2 + (h)) * HTB)
#define PG8_STAGE(bufoff, gbase, voff) do { _Pragma("unroll") for (int _i = 0; _i < 2; ++_i) \
        __builtin_amdgcn_global_load_lds((const unsigned*)((const char*)(gbase) + (voff)[_i]), (PG8_LAS unsigned*)(lds + (bufoff) + ldsw + _i * 8192), 16, 0, 0); } while (0)
#define PG8_LDA(dst, b, h) do { _Pragma("unroll") for (int m = 0; m < 4; ++m) _Pragma("unroll") for (int k = 0; k < 2; ++k) dst[m][k] = *(const PG8_LAS bf16x8*)(lds + PG8_SA(b, h) + aoff + m * 2048 + k * 1024); } while (0)
#define PG8_LDB(dst, b, h) do { _Pragma("unroll") for (int n = 0; n < 2; ++n) _Pragma("unroll") for (int k = 0; k < 2; ++k) dst[n][k] = *(const PG8_LAS bf16x8*)(lds + PG8_SB(b, h) + boff + n * 2048 + k * 1024); } while (0)
#define PG8_MMA(ai, bj, At, Bt) do { __builtin_amdgcn_s_setprio(1); _Pragma("unroll") for (int m = 0; m < 4; ++m) _Pragma("unroll") for (int n = 0; n < 2; ++n) _Pragma("unroll") for (int k = 0; k < 2; ++k) \
        acc[ai][bj][m][n] = __builtin_amdgcn_mfma_f32_16x16x32_bf16(Bt[n][k], At[m][k], acc[ai][bj][m][n], 0, 0, 0); __builtin_amdgcn_s_setprio(0); } while (0)
#define PG8_WAIT_V(n) asm volatile("s_waitcnt vmcnt(" #n ")" ::: "memory")
#define PG8_WAIT_L(n) asm volatile("s_waitcnt lgkmcnt(" #n ")" ::: "memory")
#define PG8_BAR __builtin_amdgcn_s_barrier()
#define PG8_SCHED __builtin_amdgcn_sched_barrier(0)
    Unit cur, nxt; int ui = 0;
    if (!S.next(0, cur)) return;
    f32x4 acc[2][2][4][2];
#pragma unroll
    for (int a = 0; a < 2; ++a)
#pragma unroll
        for (int b = 0; b < 2; ++b)
#pragma unroll
            for (int m = 0; m < 4; ++m)
#pragma unroll
                for (int n = 0; n < 2; ++n) acc[a][b][m][n] = (f32x4){0.f, 0.f, 0.f, 0.f};
    bf16x8 At[4][2], B0[2][2], B1[2][2];
    const char* cA = (const char*)g.A + (size_t)cur.pm * tstep; const char* cB = (const char*)g.Bt + (size_t)cur.pn * tstep;
    S.a_ready(cur);
    if constexpr (SP2) {
        PG8_STAGE(PG8_SB(0, 0), cB, voffB); PG8_STAGE(PG8_SB(0, 1), cB + hstep, voffB); PG8_STAGE(PG8_SA(0, 0), cA, voffA); PG8_STAGE(PG8_SA(0, 1), cA + hstep, voffA);
        if (wr == 1) PG8_BAR;
        PG8_WAIT_V(2); PG8_BAR;
        PG8_STAGE(PG8_SB(1, 0), cB + kstep, voffB); PG8_STAGE(PG8_SA(1, 0), cA + kstep, voffA); PG8_STAGE(PG8_SB(1, 1), cB + hstep + kstep, voffB);
        PG8_WAIT_V(6); PG8_BAR;
    } else {
        PG8_STAGE(PG8_SB(0, 0), cB, voffB); PG8_STAGE(PG8_SA(0, 0), cA, voffA); PG8_STAGE(PG8_SB(0, 1), cB + hstep, voffB); PG8_STAGE(PG8_SA(0, 1), cA + hstep, voffA);
        if (wr == 1) PG8_BAR;
        PG8_WAIT_V(4); PG8_BAR;
        PG8_STAGE(PG8_SB(1, 0), cB + kstep, voffB); PG8_STAGE(PG8_SA(1, 0), cA + kstep, voffA); PG8_STAGE(PG8_SB(1, 1), cB + hstep + kstep, voffB);
        PG8_WAIT_V(6); PG8_BAR;
    }
    for (;;) {
        const bool has_next = S.next(ui + 1, nxt);
        const char* nA = has_next ? (const char*)g.A + (size_t)nxt.pm * tstep : cA; const char* nB = has_next ? (const char*)g.Bt + (size_t)nxt.pn * tstep : cB;
        for (int t = 0; t < nt; t += 2) {
            const bool last = (t == nt - 2);
            const char* a1 = cA + (size_t)(t + 1) * kstep;
            const char* a2 = last ? nA : cA + (size_t)(t + 2) * kstep; const char* b2 = last ? nB : cB + (size_t)(t + 2) * kstep;
            const char* a3 = a2 + kstep; const char* b3 = b2 + kstep;
            if (last && has_next) S.a_ready(nxt);
            if constexpr (SP2) {
            PG8_LDB(B0, 0, 0); PG8_LDB(B1, 0, 1); PG8_SCHED; PG8_LDA(At, 0, 0); PG8_STAGE(PG8_SA(1, 1), a1 + hstep, voffA);
            PG8_WAIT_V(8); PG8_WAIT_L(0); PG8_BAR; PG8_MMA(0, 0, At, B0); PG8_MMA(0, 1, At, B1); PG8_BAR; PG8_SCHED;
            PG8_LDA(At, 0, 1); PG8_STAGE(PG8_SB(0, 0), b2, voffB); PG8_STAGE(PG8_SB(0, 1), b2 + hstep, voffB); PG8_STAGE(PG8_SA(0, 0), a2, voffA);
            PG8_WAIT_V(8); PG8_WAIT_L(0); PG8_BAR; PG8_MMA(1, 0, At, B0); PG8_MMA(1, 1, At, B1); PG8_BAR; PG8_SCHED;
            PG8_LDB(B0, 1, 0); PG8_LDB(B1, 1, 1); PG8_SCHED; PG8_LDA(At, 1, 0); PG8_STAGE(PG8_SA(0, 1), a2 + hstep, voffA);
            PG8_WAIT_V(8); PG8_WAIT_L(0); PG8_BAR; PG8_MMA(0, 0, At, B0); PG8_MMA(0, 1, At, B1); PG8_BAR; PG8_SCHED;
            PG8_LDA(At, 1, 1); PG8_STAGE(PG8_SB(1, 0), b3, voffB); PG8_STAGE(PG8_SB(1, 1), b3 + hstep, voffB); PG8_STAGE(PG8_SA(1, 0), a3, voffA);
            PG8_WAIT_V(8); PG8_WAIT_L(0); PG8_BAR; PG8_MMA(1, 0, At, B0); PG8_MMA(1, 1, At, B1); PG8_BAR; PG8_SCHED;
            } else {
            PG8_LDB(B0, 0, 0); PG8_SCHED; PG8_LDA(At, 0, 0); PG8_STAGE(PG8_SA(1, 1), a1 + hstep, voffA);
            PG8_WAIT_L(8); PG8_BAR; PG8_WAIT_L(0); PG8_MMA(0, 0, At, B0); PG8_BAR; PG8_SCHED;
            PG8_LDB(B1, 0, 1); PG8_STAGE(PG8_SB(0, 0), b2, voffB);
            PG8_BAR; PG8_WAIT_L(0); PG8_MMA(0, 1, At, B1); PG8_BAR;
            PG8_LDA(At, 0, 1); PG8_STAGE(PG8_SA(0, 0), a2, voffA);
            PG8_BAR; PG8_WAIT_L(0); PG8_MMA(1, 0, At, B0); PG8_BAR; PG8_SCHED;
            PG8_STAGE(PG8_SB(0, 1), b2 + hstep, voffB);
            PG8_WAIT_V(6); PG8_BAR; PG8_MMA(1, 1, At, B1); PG8_BAR;
            PG8_LDB(B0, 1, 0); PG8_SCHED; PG8_LDA(At, 1, 0); PG8_STAGE(PG8_SA(0, 1), a2 + hstep, voffA);
            PG8_WAIT_L(8); PG8_BAR; PG8_WAIT_L(0); PG8_MMA(0, 0, At, B0); PG8_BAR; PG8_SCHED;
            PG8_LDB(B1, 1, 1); PG8_STAGE(PG8_SB(1, 0), b3, voffB);
            PG8_BAR; PG8_WAIT_L(0); PG8_MMA(0, 1, At, B1); PG8_BAR;
            PG8_LDA(At, 1, 1); PG8_STAGE(PG8_SA(1, 0), a3, voffA);
            PG8_BAR; PG8_WAIT_L(0); PG8_MMA(1, 0, At, B0); PG8_BAR; PG8_SCHED;
            PG8_STAGE(PG8_SB(1, 1), b3 + hstep, voffB);
            PG8_WAIT_V(6); PG8_BAR; PG8_MMA(1, 1, At, B1); PG8_BAR;
            }
        }
        if constexpr (ALIGN_EPI) { if (wr == 0) PG8_BAR; }
        if constexpr (!Epi::AFTER_DRAIN) { E(acc, cur, wr, wc, fr, fq); S.done(cur); }
        if (!has_next) break;
#pragma unroll
        for (int a = 0; a < 2; ++a)
#pragma unroll
            for (int b = 0; b < 2; ++b)
#pragma unroll
                for (int m = 0; m < 4; ++m)
#pragma unroll
                    for (int n = 0; n < 2; ++n) acc[a][b][m][n] = (f32x4){0.f, 0.f, 0.f, 0.f};
        cur = nxt; cA = nA; cB = nB; ++ui;
        if constexpr (ALIGN_EPI) { if (wr == 1) PG8_BAR; }
    }
    PG8_WAIT_V(0);
    if constexpr (!ALIGN_EPI) { if (wr == 0) PG8_BAR; }
    PG8_BAR;
    if constexpr (Epi::AFTER_DRAIN) { E.fused(acc, cur, wr, wc, fr, fq, lds, wid, lane); S.done(cur); }
#undef PG8_SA
#undef PG8_SB
#undef PG8_STAGE
#undef PG8_LDA
#undef PG8_LDB
#undef PG8_MMA
#undef PG8_WAIT_V
#undef PG8_WAIT_L
#undef PG8_BAR
#undef PG8_SCHED
}
}
#define LAS __attribute__((address_space(3)))
typedef unsigned short bf16_t;
typedef short bf16x8 __attribute__((ext_vector_type(8)));
typedef float f32x4 __attribute__((ext_vector_type(4)));
typedef float f32x16 __attribute__((ext_vector_type(16)));
typedef unsigned u32x4 __attribute__((ext_vector_type(4)));
typedef unsigned u32x2 __attribute__((ext_vector_type(2)));

constexpr int SEQ = 16384, NB = 2, T = NB * SEQ, DM = 1024, FF = 2816;
constexpr size_t MiB = 1u << 20;
constexpr size_t WS_W = 0, WS_HN = 48 * MiB, WS_Y = 112 * MiB, WS_R1 = 176 * MiB, WS_VT = 352 * MiB, WS_KN = 416 * MiB, WS_SM = 480 * MiB, WS_END = 488 * MiB;
constexpr size_t W_GU0 = 0, W_D0 = 11 * MiB, W_GU1 = 17 * MiB, W_D1 = 28 * MiB, W_MIX = 34 * MiB;
constexpr size_t W_IN = W_MIX, W_V = W_MIX + 3 * MiB, W_OUT = W_MIX + 4 * MiB, W_P = W_MIX + 6 * MiB;
constexpr size_t W_MIN = W_MIX, W_QB = W_MIX + 1 * MiB, W_KNW = W_MIX + 2 * MiB, W_VVW = W_MIX + 2 * MiB + 512 * 1024;
constexpr size_t R_Q = 0, R_CQN = 96 * MiB, R_CKVN = 112 * MiB, R_KR = 128 * MiB;
constexpr size_t SM_LF = 0, SM_F = 1 * MiB, SM_CS = 4 * MiB;
constexpr int LDS_BYTES = 147456;
constexpr float LOG2E = 1.4426950408889634f;
constexpr int NPH = 49;
#ifndef EN_MASK
#define EN_MASK 0xFFFF
#endif
#define EN(b) ((EN_MASK >> (b)) & 1)

struct Args {
    const float* x; const int* pos; const float* norm_ffn; const float* norm_mix; const float* norm_final;
    const float* w_gate; const float* w_up; const float* w_down;
    const float* ab_w_in; const float* ab_b_forget; const float* pool_w; const float* pool_scale; const float* ab_w_out;
    const float* mla_w_in; const float* mla_q_norm; const float* mla_kv_norm; const float* mla_w_q_b; const float* mla_w_kv_b; const float* mla_w_out;
    float* out; unsigned char* ws; int ph_lo, ph_hi; int do_sync, pad;
};

__device__ __forceinline__ float wave_sum(float v) {
#pragma unroll
    for (int o = 1; o < 64; o <<= 1) v += __shfl_xor(v, o);
    return v;
}
typedef float f32x2_t __attribute__((ext_vector_type(2))); typedef __bf16 bf16x2_t __attribute__((ext_vector_type(2)));
__device__ __forceinline__ unsigned pk2(float lo, float hi) { f32x2_t v = {lo, hi}; bf16x2_t b = __builtin_convertvector(v, bf16x2_t); return __builtin_bit_cast(unsigned, b); }
__device__ __forceinline__ float bflo(unsigned w) { return __uint_as_float(w << 16); }
__device__ __forceinline__ float bfhi(unsigned w) { return __uint_as_float(w & 0xffff0000u); }
__device__ __forceinline__ float max3f(float a, float b, float c) { float r; asm("v_max3_f32 %0, %1, %2, %3" : "=v"(r) : "v"(a), "v"(b), "v"(c)); return r; }
#define LDS_FENCE() asm volatile("s_waitcnt lgkmcnt(0)" ::: "memory")
#define LBAR() do { asm volatile("s_waitcnt lgkmcnt(0)" ::: "memory"); __builtin_amdgcn_s_barrier(); asm volatile("" ::: "memory"); } while (0)

__device__ __forceinline__ void transpose_item(const float* __restrict__ src, int ld, int k0, bf16_t* __restrict__ dst, int ldd, LAS float* scr, int lane) {
#pragma unroll 8
    for (int i = 0; i < 32; ++i) { const int kk = 2 * i + (lane >> 5); scr[kk * 33 + (lane & 31)] = src[(size_t)(k0 + kk) * ld + (lane & 31)]; }
    LDS_FENCE();
    const int c = lane & 7;
#pragma unroll
    for (int j = 0; j < 4; ++j) { const int n = (lane >> 3) + 8 * j; const LAS float* s = scr + (8 * c) * 33 + n;
        u32x4 o; o.x = pk2(s[0 * 33], s[1 * 33]); o.y = pk2(s[2 * 33], s[3 * 33]); o.z = pk2(s[4 * 33], s[5 * 33]); o.w = pk2(s[6 * 33], s[7 * 33]);
        *(u32x4*)(dst + (size_t)n * ldd + k0 + 8 * c) = o; }
    LDS_FENCE();
}

__device__ __forceinline__ void convert_layer(const Args& A, int l, LAS float* scr, int gw, int NGW, int lane) {
    const int i = l >> 1; const bool even = !(l & 1);
    constexpr int NF = 1408;
    unsigned char* W = A.ws + WS_W;
    const int total = 6 * NF + (even ? (768 + 256 + 512 + 32) : (208 + 192 + 128 + 512));
    for (int it = gw; it < total; it += NGW) {
        int r = it;
        if (r < 6 * NF) {
            const int f = r / (3 * NF), r2 = r % (3 * NF), kind = r2 / NF, q = r2 % NF;
            const size_t wo = (size_t)(l * 2 + f) * DM * FF;
            if (kind < 2) { const int kb = q / 88, nb = q % 88; const float* src = (kind == 0 ? A.w_gate : A.w_up) + wo + 32 * nb;
                bf16_t* dst = (bf16_t*)(W + (f ? W_GU1 : W_GU0)) + (size_t)((nb >> 2) * 256 + (nb & 3) * 32 + kind * 128) * DM;
                transpose_item(src, FF, 64 * kb, dst, DM, scr, lane); }
            else { const int kb = q / 32, nb = q % 32; const float* src = A.w_down + wo + 32 * nb;
                bf16_t* dst = (bf16_t*)(W + (f ? W_D1 : W_D0)) + (size_t)(32 * nb) * FF;
                transpose_item(src, DM, 64 * kb, dst, FF, scr, lane); }
            continue;
        }
        r -= 6 * NF;
        if (even) {
            const float* win = A.ab_w_in + (size_t)i * DM * 2056;
            if (r < 768) { const int kb = r / 48, nb = r % 48; transpose_item(win + 32 * nb, 2056, 64 * kb, (bf16_t*)(W + W_IN) + (size_t)(32 * nb) * DM, DM, scr, lane); continue; } r -= 768;
            if (r < 256) { const int kb = r / 16, nb = r % 16; transpose_item(win + 1536 + 32 * nb, 2056, 64 * kb, (bf16_t*)(W + W_V) + (size_t)(32 * nb) * DM, DM, scr, lane); continue; } r -= 256;
            if (r < 512) { const int kb = r / 32, nb = r % 32; transpose_item(A.ab_w_out + (size_t)i * DM * DM + 32 * nb, DM, 64 * kb, (bf16_t*)(W + W_OUT) + (size_t)(32 * nb) * DM, DM, scr, lane); continue; } r -= 512;
            { const int g = r >> 3, kb = (r & 7) >> 2, nb = r & 3; transpose_item(A.pool_w + (size_t)(i * 4 + g) * 16384 + 32 * nb, 128, 64 * kb, (bf16_t*)(W + W_P) + (size_t)g * 16384 + (size_t)(32 * nb) * 128, 128, scr, lane); }
        } else {
            if (r < 208) { const int kb = r / 13, nb = r % 13; transpose_item(A.mla_w_in + (size_t)i * DM * 416 + 32 * nb, 416, 64 * kb, (bf16_t*)(W + W_MIN) + (size_t)(32 * nb) * DM, DM, scr, lane); continue; } r -= 208;
            if (r < 192) { const int kb = r / 48, nb = r % 48; transpose_item(A.mla_w_q_b + (size_t)i * 256 * 1536 + 32 * nb, 1536, 64 * kb, (bf16_t*)(W + W_QB) + (size_t)(32 * nb) * 256, 256, scr, lane); continue; } r -= 192;
            if (r < 128) { const int kb = r / 64, nb = r % 64; const int col0 = 32 * nb, head = col0 >> 7, within = col0 & 127;
                bf16_t* dst = (within < 64) ? (bf16_t*)(W + W_KNW) + (size_t)(64 * head + within) * 256 : (bf16_t*)(W + W_VVW) + (size_t)(64 * head + within - 64) * 256;
                transpose_item(A.mla_w_kv_b + (size_t)i * 128 * 2048 + col0, 2048, 64 * kb, dst, 256, scr, lane); continue; } r -= 128;
            { const int kb = r / 32, nb = r % 32; transpose_item(A.mla_w_out + (size_t)i * DM * DM + 32 * nb, DM, 64 * kb, (bf16_t*)(W + W_OUT) + (size_t)(32 * nb) * DM, DM, scr, lane); }
        }
    }
    if (!even) {
        const int gt = gw * 64 + lane, NT_ = NGW * 64;
        for (int idx = gt; idx < 2048 * 16; idx += NT_) { const int row = idx >> 4, c = idx & 15;
            *(u32x4*)((bf16_t*)(W + W_KNW) + (size_t)row * 256 + 128 + 8 * c) = (u32x4){0u, 0u, 0u, 0u}; }
    }
}

__constant__ float ROPE_INVF[16] = {(float)1.0, (float)0.5623413251903491, (float)0.31622776601683794, (float)0.1778279410038923, (float)0.1, (float)0.05623413251903491, (float)0.031622776601683794, (float)0.01778279410038923,
    (float)0.01, (float)0.005623413251903491, (float)0.0031622776601683794, (float)0.001778279410038923, (float)0.001, (float)0.0005623413251903491, (float)0.00031622776601683794, (float)0.0001778279410038923};
__device__ __forceinline__ void rope_table(const Args& A, int gw, int NGW, int lane) {
    float* CS = (float*)(A.ws + WS_SM + SM_CS);
    const int gt = gw * 64 + lane, NT_ = NGW * 64;
    for (int idx = gt; idx < T * 16; idx += NT_) {
        const int t = idx >> 4, j = idx & 15;
        const float invf = ROPE_INVF[j];
        const float ang = (float)A.pos[t] * invf;
        const double rev = (double)ang * 0.15915494309189535;
        const float fr = (float)(rev - __builtin_rint(rev));
        CS[(size_t)t * 32 + j] = __builtin_amdgcn_cosf(fr);
        CS[(size_t)t * 32 + 16 + j] = __builtin_amdgcn_sinf(fr);
    }
}

template <int MODE>
__device__ __forceinline__ void norm_phase(const float* src, const float* __restrict__ g, bf16_t* dst16, float* dst32,
                                           const float* __restrict__ wfsrc, const float* __restrict__ bforget, float* LF, LAS float* wfT, int gw, int NGW, int lane, int tid) {
    if (MODE == 1) {
        for (int idx = tid; idx < 8192; idx += 512) { const int k = idx >> 3, f = idx & 7; wfT[f * 1024 + k] = wfsrc[(size_t)k * 2056 + 2048 + f]; }
        LDS_FENCE(); __syncthreads();
    }
    f32x4 gv[4];
#pragma unroll
    for (int j = 0; j < 4; ++j) gv[j] = *(const f32x4*)(g + 4 * lane + 256 * j);
    for (int m = gw; m < T; m += NGW) {
        const f32x4* xr = (const f32x4*)(src + (size_t)m * DM) + lane;
        f32x4 v[4]; float ss = 0.f;
#pragma unroll
        for (int j = 0; j < 4; ++j) { v[j] = xr[64 * j]; ss += (v[j].x * v[j].x + v[j].y * v[j].y) + (v[j].z * v[j].z + v[j].w * v[j].w); }
        ss = wave_sum(ss);
        const float rstd = 1.0f / sqrtf(ss * (1.0f / DM) + 1e-6f);
#pragma unroll
        for (int j = 0; j < 4; ++j) v[j] = v[j] * rstd * gv[j];
        if (MODE == 2) {
            f32x4* o = (f32x4*)(dst32 + (size_t)m * DM) + lane;
#pragma unroll
            for (int j = 0; j < 4; ++j) o[64 * j] = v[j];
        } else {
            u32x2* o = (u32x2*)(dst16 + (size_t)m * DM) + lane;
#pragma unroll
            for (int j = 0; j < 4; ++j) { u32x2 w; w.x = pk2(v[j].x, v[j].y); w.y = pk2(v[j].z, v[j].w); o[64 * j] = w; }
        }
        if (MODE == 1) {
            float mine = 0.f;
#pragma unroll
            for (int f = 0; f < 8; ++f) { float a = 0.f;
#pragma unroll
                for (int j = 0; j < 4; ++j) { const f32x4 w = *(const LAS f32x4*)(wfT + f * 1024 + 4 * lane + 256 * j); a += (v[j].x * w.x + v[j].y * w.y) + (v[j].z * w.z + v[j].w * w.w); }
                a = wave_sum(a); mine = (lane == f) ? a : mine; }
            if (lane < 8) { const float xx = mine + bforget[lane];
                const float ls = xx < 0.f ? xx - log1pf(expf(xx)) : -log1pf(expf(-xx));
                const int b = m / SEQ, t = m % SEQ; LF[(size_t)(b * 8 + lane) * SEQ + t] = ls; }
        }
    }
}

__device__ __forceinline__ void mla_small(const Args& A, int i, int gw, int NGW, int lane) {
    const float* PROJ = (const float*)(A.ws + WS_Y);
    bf16_t* CQN = (bf16_t*)(A.ws + WS_R1 + R_CQN); bf16_t* CKVN = (bf16_t*)(A.ws + WS_R1 + R_CKVN); bf16_t* KR = (bf16_t*)(A.ws + WS_R1 + R_KR);
    const float* CS = (const float*)(A.ws + WS_SM + SM_CS);
    const f32x4 gq = *(const f32x4*)(A.mla_q_norm + (size_t)i * 256 + 4 * lane);
    const f32x4 gk = *(const f32x4*)(A.mla_kv_norm + (size_t)i * 128 + 4 * (lane & 31));
    for (int m = gw; m < T; m += NGW) {
        const float* row = PROJ + (size_t)m * 512;
        const f32x4 a = *(const f32x4*)(row + 4 * lane);
        f32x4 b = (f32x4){0.f, 0.f, 0.f, 0.f};
        if (lane < 40) b = *(const f32x4*)(row + 256 + 4 * lane);
        const float sq = wave_sum((a.x * a.x + a.y * a.y) + (a.z * a.z + a.w * a.w));
        const float skv = wave_sum(lane < 32 ? (b.x * b.x + b.y * b.y) + (b.z * b.z + b.w * b.w) : 0.f);
        const float rq = 1.0f / sqrtf(sq * (1.0f / 256.0f) + 1e-6f), rkv = 1.0f / sqrtf(skv * (1.0f / 128.0f) + 1e-6f);
        { const f32x4 y = a * rq * gq; u32x2 w; w.x = pk2(y.x, y.y); w.y = pk2(y.z, y.w); *(u32x2*)(CQN + (size_t)m * 256 + 4 * lane) = w; }
        { const f32x4 y = b * rkv * gk; u32x2 w; w.x = pk2(y.x, y.y); w.y = pk2(y.z, y.w); if (lane >= 32) { w.x = 0u; w.y = 0u; }
          *(u32x2*)(CKVN + (size_t)m * 256 + 4 * lane) = w; }
        f32x4 p; p.x = __shfl_xor(b.x, 4); p.y = __shfl_xor(b.y, 4); p.z = __shfl_xor(b.z, 4); p.w = __shfl_xor(b.w, 4);
        if (lane >= 32 && lane < 40) { const int i0 = 4 * ((lane - 32) & 3);
            const f32x4 c = *(const f32x4*)(CS + (size_t)m * 32 + i0), s = *(const f32x4*)(CS + (size_t)m * 32 + 16 + i0);
            f32x4 o; if (lane < 36) o = b * c - p * s; else o = b * c + p * s;
            u32x2 w; w.x = pk2(o.x, o.y); w.y = pk2(o.z, o.w); *(u32x2*)(KR + (size_t)m * 32 + 4 * (lane - 32)) = w; }
    }
}

__device__ __forceinline__ void scan_pool(const Args& A, int i, LAS unsigned char* lds, int gw, int NGW, int lane, int tid, int wave) {
    if (blockIdx.x < 16) {
        const int bh = blockIdx.x; const float* lf = (const float*)(A.ws + WS_SM + SM_LF) + (size_t)bh * SEQ + tid * 32; double* Fo = (double*)(A.ws + WS_SM + SM_F) + (size_t)bh * SEQ + tid * 32;
        f32x4 v[8]; double tot = 0.0;
#pragma unroll
        for (int e = 0; e < 8; ++e) { v[e] = *(const f32x4*)(lf + 4 * e); tot += ((double)v[e].x + (double)v[e].y) + ((double)v[e].z + (double)v[e].w); }
        double incl = tot;
#pragma unroll
        for (int o = 1; o < 64; o <<= 1) { const double n = __shfl_up(incl, o); if (lane >= o) incl += n; }
        LAS double* wt = (LAS double*)lds;
        if (lane == 63) wt[wave] = incl;
        LDS_FENCE(); __syncthreads();
        double run = incl - tot;
        for (int j = 0; j < wave; ++j) run += wt[j];
#pragma unroll
        for (int e = 0; e < 8; ++e) { double o0, o1, o2, o3; run += (double)v[e].x; o0 = run; run += (double)v[e].y; o1 = run; run += (double)v[e].z; o2 = run; run += (double)v[e].w; o3 = run;
            Fo[4 * e + 0] = o0; Fo[4 * e + 1] = o1; Fo[4 * e + 2] = o2; Fo[4 * e + 3] = o3; }
        __syncthreads();
    }
    const bf16_t* P = (const bf16_t*)(A.ws + WS_R1); bf16_t* Y = (bf16_t*)(A.ws + WS_Y); const bf16_t* WP = (const bf16_t*)(A.ws + WS_W + W_P);
    const float* psc = A.pool_scale + (size_t)i * 512;
    const int r32 = lane & 31, hi = lane >> 5;
    for (int u = gw; u < 4096; u += NGW) {
        const int g = u & 3, rb = u >> 2, wnd = 2 << g;
        const int tg = 32 * rb + r32, t = tg & (SEQ - 1);
        const int cnt = (t + 1 < wnd) ? (t + 1) : wnd; const float inv = 1.0f / (float)cnt;
        const bf16_t* up = P + (size_t)tg * 1536 + 128 * g + 8 * hi;
        bf16x8 af[8];
#pragma unroll
        for (int kk = 0; kk < 8; ++kk) {
            const u32x4 cur = *(const u32x4*)(up + 16 * kk);
            float s0 = bflo(cur.x), s1 = bfhi(cur.x), s2 = bflo(cur.y), s3 = bfhi(cur.y), s4 = bflo(cur.z), s5 = bfhi(cur.z), s6 = bflo(cur.w), s7 = bfhi(cur.w);
            const float c0 = s0, c1 = s1, c2 = s2, c3 = s3, c4 = s4, c5 = s5, c6 = s6, c7 = s7;
            for (int j = 1; j < cnt; ++j) { const u32x4 w = *(const u32x4*)(up - (size_t)j * 1536 + 16 * kk);
                s0 += bflo(w.x); s1 += bfhi(w.x); s2 += bflo(w.y); s3 += bfhi(w.y); s4 += bflo(w.z); s5 += bfhi(w.z); s6 += bflo(w.w); s7 += bfhi(w.w); }
            u32x4 o; o.x = pk2(s0 * inv - c0, s1 * inv - c1); o.y = pk2(s2 * inv - c2, s3 * inv - c3); o.z = pk2(s4 * inv - c4, s5 * inv - c5); o.w = pk2(s6 * inv - c6, s7 * inv - c7);
            af[kk] = __builtin_bit_cast(bf16x8, o);
        }
        const bf16_t* wp = WP + (size_t)g * 16384 + (size_t)r32 * 128 + 8 * hi;
#pragma unroll
        for (int nb = 0; nb < 4; ++nb) {
            f32x16 acc = {};
#pragma unroll
            for (int kk = 0; kk < 8; ++kk) { const bf16x8 bfr = *(const bf16x8*)(wp + (size_t)(32 * nb) * 128 + 16 * kk); acc = __builtin_amdgcn_mfma_f32_32x32x16_bf16(af[kk], bfr, acc, 0, 0, 0); }
            const int col = 128 * g + 32 * nb + r32; const float sc = psc[col];
#pragma unroll
            for (int r = 0; r < 16; ++r) { const int row = 32 * rb + (r & 3) + 8 * (r >> 2) + 4 * hi;
                Y[(size_t)row * DM + col] = (bf16_t)(pk2(acc[r] * sc, 0.f) & 0xffffu); }
        }
    }
}

template <int DK, bool FOX>
__device__ __forceinline__ void attn_unit(LAS unsigned char* lds, const bf16_t* __restrict__ Qp, int ldq, const bf16_t* __restrict__ Kp, int ldk, const bf16_t* __restrict__ Kr,
                                          const bf16_t* __restrict__ VTp, const double* __restrict__ F, const float* __restrict__ CS, bf16_t* Yp, int q0, int tid_in) {
    int tid = tid_in;
    constexpr int KSTR = DK * 2 + 16, VSTR = 144, KBYTES = 64 * KSTR, VBYTES = 64 * VSTR;
    constexpr int OFF_K = 0, OFF_V = 2 * KBYTES, OFF_FK = OFF_V + 3 * VBYTES, OFF_WS = OFF_FK + 512;
    constexpr int ND = DK / 16;
    asm volatile("" : "+v"(tid));
    const int lane = tid & 63, r32 = lane & 31, hi = lane >> 5, w = __builtin_amdgcn_readfirstlane(tid >> 6);
    const int wrow0 = q0 + 32 * w, trow = wrow0 + r32;
    bf16x8 qf[ND];
#pragma unroll
    for (int d0 = 0; d0 < ND; ++d0) qf[d0] = *(const bf16x8*)(Qp + (size_t)trow * ldq + 16 * d0 + 8 * hi);
    if (!FOX) {
        const u32x4 a = __builtin_bit_cast(u32x4, qf[ND - 2]), b = __builtin_bit_cast(u32x4, qf[ND - 1]);
        const float* cs = CS + (size_t)trow * 32 + 8 * hi;
        const f32x4 c0 = *(const f32x4*)cs, c1 = *(const f32x4*)(cs + 4), s0 = *(const f32x4*)(cs + 16), s1 = *(const f32x4*)(cs + 20);
        const float x1[8] = {bflo(a.x), bfhi(a.x), bflo(a.y), bfhi(a.y), bflo(a.z), bfhi(a.z), bflo(a.w), bfhi(a.w)};
        const float x2[8] = {bflo(b.x), bfhi(b.x), bflo(b.y), bfhi(b.y), bflo(b.z), bfhi(b.z), bflo(b.w), bfhi(b.w)};
        const float cc[8] = {c0.x, c0.y, c0.z, c0.w, c1.x, c1.y, c1.z, c1.w}, sn[8] = {s0.x, s0.y, s0.z, s0.w, s1.x, s1.y, s1.z, s1.w};
        u32x4 oa, ob;
        oa.x = pk2(x1[0] * cc[0] - x2[0] * sn[0], x1[1] * cc[1] - x2[1] * sn[1]); oa.y = pk2(x1[2] * cc[2] - x2[2] * sn[2], x1[3] * cc[3] - x2[3] * sn[3]);
        oa.z = pk2(x1[4] * cc[4] - x2[4] * sn[4], x1[5] * cc[5] - x2[5] * sn[5]); oa.w = pk2(x1[6] * cc[6] - x2[6] * sn[6], x1[7] * cc[7] - x2[7] * sn[7]);
        ob.x = pk2(x2[0] * cc[0] + x1[0] * sn[0], x2[1] * cc[1] + x1[1] * sn[1]); ob.y = pk2(x2[2] * cc[2] + x1[2] * sn[2], x2[3] * cc[3] + x1[3] * sn[3]);
        ob.z = pk2(x2[4] * cc[4] + x1[4] * sn[4], x2[5] * cc[5] + x1[5] * sn[5]); ob.w = pk2(x2[6] * cc[6] + x1[6] * sn[6], x2[7] * cc[7] + x1[7] * sn[7]);
        qf[ND - 2] = __builtin_bit_cast(bf16x8, oa); qf[ND - 1] = __builtin_bit_cast(bf16x8, ob);
    }
    float fq2 = 0.f; double Fref = 0.0;
    if (FOX) { Fref = F[q0]; fq2 = (float)((F[trow] - Fref) * (double)LOG2E); }
    f32x16 o0 = {}, o1 = {}; float mrun = 0.f, lrun = 0.f;
    const int ktmax = (q0 >> 6) + 3, wkt = wrow0 >> 6;
    const int krow = tid >> 3, kch = tid & 7, rrow = (tid >> 2) & 63, rch = tid & 3;
    const unsigned koff = (unsigned)(krow * ldk + kch * 8) * 2u, voff = (unsigned)(krow * T + kch * 8) * 2u, roff = (unsigned)(rrow * 32 + rch * 8) * 2u;
    u32x4 kreg, vreg, rreg = {}; float fkreg = 0.f;
#define AT_GLOAD(kt) do { kreg = *(const u32x4*)((const char*)(Kp + (size_t)(kt) * 64 * ldk) + koff); vreg = *(const u32x4*)((const char*)(VTp + (size_t)(kt) * 64) + voff); \
        if (!FOX && tid < 256) rreg = *(const u32x4*)((const char*)(Kr + (size_t)(kt) * 64 * 32) + roff); \
        if (FOX && tid < 64) fkreg = -(float)((F[(kt) * 64 + tid] - Fref) * (double)LOG2E); } while (0)
#define AT_LWRITE(KT) do { *(LAS u32x4*)(lds + OFF_K + ((KT) & 1) * KBYTES + krow * KSTR + kch * 16) = kreg; *(LAS u32x4*)(lds + OFF_V + ((KT) % 3) * VBYTES + krow * VSTR + kch * 16) = vreg; \
        if (!FOX && tid < 256) *(LAS u32x4*)(lds + OFF_K + ((KT) & 1) * KBYTES + rrow * KSTR + 128 + rch * 16) = rreg; \
        if (FOX && tid < 64) *(LAS float*)(lds + OFF_FK + ((KT) & 1) * 256 + tid * 4) = fkreg; } while (0)
    LAS float* wsf = (LAS float*)(lds + OFF_WS) + w * 64;
    const int sig = (r32 & 0x13) | ((r32 & 4) << 1) | ((r32 & 8) >> 1);
#define AT_KFH(KT, H) _Pragma("unroll") for (int d0 = (H) * (ND / 2); d0 < ((H) + 1) * (ND / 2); ++d0) { kf[2 * d0] = *(const LAS bf16x8*)(kb_ + d0 * 32); kf[2 * d0 + 1] = *(const LAS bf16x8*)(kb_ + 32 * KSTR + d0 * 32); }
#define AT_KB(KT) const LAS unsigned char* kb_ = lds + OFF_K + ((KT) & 1) * KBYTES + sig * KSTR + hi * 16; bf16x8 kf[2 * ND];
#define AT_VF(SLOT) const LAS unsigned char* vb_ = lds + OFF_V + (SLOT) * VBYTES + r32 * VSTR + hi * 16; bf16x8 vf[8]; \
    _Pragma("unroll") for (int c = 0; c < 4; ++c) { vf[2 * c] = *(const LAS bf16x8*)(vb_ + 32 * c); vf[2 * c + 1] = *(const LAS bf16x8*)(vb_ + 32 * VSTR + 32 * c); }
#define AT_CINIT(SC0, SC1, KT) do { if (FOX) { const LAS float* fk = (const LAS float*)(lds + OFF_FK + ((KT) & 1) * 256) + 8 * hi; const float cq = fq2 - mrun; \
        const f32x4 a0 = *(const LAS f32x4*)(fk), a1 = *(const LAS f32x4*)(fk + 4), a2 = *(const LAS f32x4*)(fk + 16), a3 = *(const LAS f32x4*)(fk + 20); \
        const f32x4 b0 = *(const LAS f32x4*)(fk + 32), b1 = *(const LAS f32x4*)(fk + 36), b2 = *(const LAS f32x4*)(fk + 48), b3 = *(const LAS f32x4*)(fk + 52); \
        _Pragma("unroll") for (int e = 0; e < 4; ++e) { SC0[e] = a0[e] + cq; SC0[4 + e] = a1[e] + cq; SC0[8 + e] = a2[e] + cq; SC0[12 + e] = a3[e] + cq; \
                                                      SC1[e] = b0[e] + cq; SC1[4 + e] = b1[e] + cq; SC1[8 + e] = b2[e] + cq; SC1[12 + e] = b3[e] + cq; } \
    } else { SC0 = (f32x16){}; SC1 = (f32x16){}; } } while (0)
#define AT_QKH(SC0, SC1, H) do { _Pragma("unroll") for (int d0 = (H) * (ND / 2); d0 < ((H) + 1) * (ND / 2); ++d0) { \
        SC0 = __builtin_amdgcn_mfma_f32_32x32x16_bf16(kf[2 * d0], qf[d0], SC0, 0, 0, 0); SC1 = __builtin_amdgcn_mfma_f32_32x32x16_bf16(kf[2 * d0 + 1], qf[d0], SC1, 0, 0, 0); } } while (0)
#define AT_EXPH(SP) _Pragma("unroll") for (int r = 0; r < 16; ++r) { SP[r] = __builtin_amdgcn_exp2f(SP[r]); ls_ += SP[r]; }
#define AT_PACK(SP0, SP1) u32x4 p0, p1, p2, p3; \
    p0.x = pk2(SP0[0], SP0[1]); p0.y = pk2(SP0[2], SP0[3]); p0.z = pk2(SP0[4], SP0[5]); p0.w = pk2(SP0[6], SP0[7]); \
    p1.x = pk2(SP0[8], SP0[9]); p1.y = pk2(SP0[10], SP0[11]); p1.z = pk2(SP0[12], SP0[13]); p1.w = pk2(SP0[14], SP0[15]); \
    p2.x = pk2(SP1[0], SP1[1]); p2.y = pk2(SP1[2], SP1[3]); p2.z = pk2(SP1[4], SP1[5]); p2.w = pk2(SP1[6], SP1[7]); \
    p3.x = pk2(SP1[8], SP1[9]); p3.y = pk2(SP1[10], SP1[11]); p3.z = pk2(SP1[12], SP1[13]); p3.w = pk2(SP1[14], SP1[15]); \

#define AT_PV() do { const bf16x8 pa0 = __builtin_bit_cast(bf16x8, p0), pa1 = __builtin_bit_cast(bf16x8, p1), pa2 = __builtin_bit_cast(bf16x8, p2), pa3 = __builtin_bit_cast(bf16x8, p3); \
    o0 = __builtin_amdgcn_mfma_f32_32x32x16_bf16(pa0, vf[0], o0, 0, 0, 0); o1 = __builtin_amdgcn_mfma_f32_32x32x16_bf16(pa0, vf[1], o1, 0, 0, 0); \
    o0 = __builtin_amdgcn_mfma_f32_32x32x16_bf16(pa1, vf[2], o0, 0, 0, 0); o1 = __builtin_amdgcn_mfma_f32_32x32x16_bf16(pa1, vf[3], o1, 0, 0, 0); \
    o0 = __builtin_amdgcn_mfma_f32_32x32x16_bf16(pa2, vf[4], o0, 0, 0, 0); o1 = __builtin_amdgcn_mfma_f32_32x32x16_bf16(pa2, vf[5], o1, 0, 0, 0); \
    o0 = __builtin_amdgcn_mfma_f32_32x32x16_bf16(pa3, vf[6], o0, 0, 0, 0); o1 = __builtin_amdgcn_mfma_f32_32x32x16_bf16(pa3, vf[7], o1, 0, 0, 0); } while (0)
#define AT_REL(SC0, SC1) do { if (!FOX) { if (__any(mrun != 0.f)) { _Pragma("unroll") for (int r = 0; r < 16; ++r) { SC0[r] -= mrun; SC1[r] -= mrun; } } } } while (0)
#define AT_MAX(SC0, SC1) float mloc; { float ma = max3f(SC0[0], SC0[1], SC1[0]), mb = max3f(SC0[2], SC0[3], SC1[1]); ma = max3f(ma, SC1[2], SC1[3]); \
        _Pragma("unroll") for (int r = 4; r < 16; r += 4) { ma = max3f(ma, SC0[r], SC0[r + 1]); mb = max3f(mb, SC0[r + 2], SC0[r + 3]); ma = max3f(ma, SC1[r], SC1[r + 1]); mb = max3f(mb, SC1[r + 2], SC1[r + 3]); } \
        mloc = max3f(ma, mb, mb); mloc = max3f(mloc, __shfl_xor(mloc, 32), mloc); }
#define AT_DEC(SC0, SC1) do { if (__any(mloc > 12.0f)) { \
        const float dl = fmaxf(mloc, 0.f); mrun += dl; const float alpha = __builtin_amdgcn_exp2f(-dl); lrun *= alpha; \
        _Pragma("unroll") for (int r = 0; r < 16; ++r) { SC0[r] -= dl; SC1[r] -= dl; } \
        if (hi == 0) wsf[r32] = alpha; \
        LDS_FENCE(); \
        _Pragma("unroll") for (int r4 = 0; r4 < 4; ++r4) { const f32x4 al = *(const LAS f32x4*)(wsf + 8 * r4 + 4 * hi); \
            _Pragma("unroll") for (int e = 0; e < 4; ++e) { o0[4 * r4 + e] *= al[e]; o1[4 * r4 + e] *= al[e]; } } \
        LDS_FENCE(); } } while (0)
#define AT_FIRST(SC0, SC1, KT) do { AT_KB(KT); AT_KFH(KT, 0); AT_KFH(KT, 1); AT_CINIT(SC0, SC1, KT); __builtin_amdgcn_sched_barrier(0); AT_QKH(SC0, SC1, 0); AT_QKH(SC0, SC1, 1); \
        AT_REL(SC0, SC1); \
        if (FOX) { const int kv0 = 64 * (KT) + 8 * hi; \
            _Pragma("unroll") for (int r = 0; r < 16; ++r) { const int kv = kv0 + 16 * (r >> 3) + (r & 7); if (kv > trow) SC0[r] = -INFINITY; if (kv + 32 > trow) SC1[r] = -INFINITY; } } \
        AT_MAX(SC0, SC1); AT_DEC(SC0, SC1); } while (0)
#define AT_STEADY(SC0, SC1, SP0, SP1, KT) do { AT_KB(KT); AT_KFH(KT, 0); AT_CINIT(SC0, SC1, KT); float ls_ = 0.f; __builtin_amdgcn_sched_barrier(0); \
        AT_QKH(SC0, SC1, 0); AT_KFH(KT, 1); AT_EXPH(SP0); asm volatile("" : "+v"(SP0), "+v"(ls_)); AT_SGB_QK(); __builtin_amdgcn_sched_barrier(0); \
        AT_QKH(SC0, SC1, 1); AT_VF(((KT) + 1) % 3); AT_EXPH(SP1); lrun += ls_; AT_PACK(SP0, SP1); asm volatile("" : "+v"(p0), "+v"(p1), "+v"(p2), "+v"(p3), "+v"(lrun)); AT_SGB_QK(); __builtin_amdgcn_sched_barrier(0); \
        AT_REL(SC0, SC1); \
        AT_PV(); AT_MAX(SC0, SC1); AT_SGB_PV(); __builtin_amdgcn_sched_barrier(0); AT_DEC(SC0, SC1); } while (0)
#define AT_DRAIN(SP0, SP1) do { AT_VF(0); float ls_ = 0.f; AT_EXPH(SP0); AT_EXPH(SP1); lrun += ls_; AT_PACK(SP0, SP1); AT_PV(); } while (0)
#ifndef AT_HINTS
#define AT_HINTS 1
#endif
#if AT_HINTS
#define AT_SGB_QK() do { _Pragma("unroll") for (int i_ = 0; i_ < ND; ++i_) { __builtin_amdgcn_sched_group_barrier(0x008, 1, 0); __builtin_amdgcn_sched_group_barrier(0x002, (DK == 96 ? 7 : 10), 0); } } while (0)
#define AT_SGB_PV() do { _Pragma("unroll") for (int i_ = 0; i_ < 8; ++i_) { __builtin_amdgcn_sched_group_barrier(0x008, 1, 0); __builtin_amdgcn_sched_group_barrier(0x002, 2, 0); } } while (0)
#else
#define AT_SGB_QK() do {} while (0)
#define AT_SGB_PV() do {} while (0)
#endif
#define AT_STEP_STEADY(SC0, SC1, SP0, SP1, KT) do { const int kt_ = (KT); if (kt_ > 0) AT_GLOAD(kt_ - 1); AT_STEADY(SC0, SC1, SP0, SP1, kt_); if (kt_ > 0) AT_LWRITE(kt_ - 1); LBAR(); } while (0)
    f32x16 sA0 = {}, sA1 = {}, sB0 = {}, sB1 = {};
    AT_GLOAD(ktmax); AT_LWRITE(ktmax); LBAR();
    for (int kt = ktmax; kt > wkt; --kt) { AT_GLOAD(kt - 1); AT_LWRITE(kt - 1); LBAR(); }
    { if (wkt > 0) AT_GLOAD(wkt - 1); AT_FIRST(sA0, sA1, wkt); if (wkt > 0) AT_LWRITE(wkt - 1); LBAR(); }
    int kt = wkt - 1;
    for (; kt >= 1; kt -= 2) {
        AT_STEP_STEADY(sB0, sB1, sA0, sA1, kt);
        AT_STEP_STEADY(sA0, sA1, sB0, sB1, kt - 1);
    }
    if (kt == 0) { AT_STEP_STEADY(sB0, sB1, sA0, sA1, 0); AT_DRAIN(sB0, sB1); LBAR(); }
    else { AT_DRAIN(sA0, sA1); LBAR(); }
#undef AT_GLOAD
#undef AT_LWRITE
#undef AT_KFH
#undef AT_KB
#undef AT_QKH
#undef AT_EXPH
#undef AT_PACK
#undef AT_REL
#undef AT_STEP_STEADY
#undef AT_VF
#undef AT_CINIT
#undef AT_QK
#undef AT_SOFT
#undef AT_PV
#undef AT_MAX
#undef AT_DEC
#undef AT_FIRST
#undef AT_STEADY
#undef AT_DRAIN
#undef AT_STEP
    lrun += __shfl_xor(lrun, 32);
    if (hi == 0) wsf[32 + r32] = lrun;
    LDS_FENCE();
#pragma unroll
    for (int r4 = 0; r4 < 4; ++r4) { const f32x4 lv = *(const LAS f32x4*)(wsf + 32 + 8 * r4 + 4 * hi);
#pragma unroll
        for (int e = 0; e < 4; ++e) { const float inv = 1.0f / lv[e]; const int row = wrow0 + e + 8 * r4 + 4 * hi;
            Yp[(size_t)row * DM + r32] = (bf16_t)(pk2(o0[4 * r4 + e] * inv, 0.f) & 0xffffu);
            Yp[(size_t)row * DM + 32 + r32] = (bf16_t)(pk2(o1[4 * r4 + e] * inv, 0.f) & 0xffffu); } }
    LDS_FENCE();
}

__global__ void __launch_bounds__(512, 2) fwd_mega(Args Akern) {
    extern __shared__ __attribute__((aligned(16))) unsigned char lds_raw[];
    LAS unsigned char* lds = (LAS unsigned char*)lds_raw;
    const int G = gridDim.x, bx = blockIdx.x;
    const int vcu = (G % 8 == 0) ? (bx % 8) * (G / 8) + bx / 8 : bx;
    const int NGW = G * 8;
    const int ph_lo = Akern.ph_lo, ph_hi = Akern.ph_hi, do_sync = Akern.do_sync;
#if defined(__HIP_DEVICE_COMPILE__)
    const __attribute__((address_space(4))) Args* Ak = (const __attribute__((address_space(4))) Args*)__builtin_amdgcn_kernarg_segment_ptr();
#else
    const Args* Ak = &Akern;
#endif

    for (int ph = ph_lo; ph < ph_hi; ++ph) {
        asm volatile("" : "+s"(Ak));
        const Args A = *Ak;
        int tid = threadIdx.x; asm volatile("" : "+v"(tid));
        const int lane = tid & 63, wave = __builtin_amdgcn_readfirstlane(tid >> 6), gw = vcu * 8 + wave;
        unsigned char* ws = A.ws;
        bf16_t* HN = (bf16_t*)(ws + WS_HN); bf16_t* Yb = (bf16_t*)(ws + WS_Y); bf16_t* R1 = (bf16_t*)(ws + WS_R1); bf16_t* VT = (bf16_t*)(ws + WS_VT); bf16_t* KN = (bf16_t*)(ws + WS_KN);
        float* LFb = (float*)(ws + WS_SM + SM_LF); const double* Fb = (const double*)(ws + WS_SM + SM_F); const float* CS = (const float*)(ws + WS_SM + SM_CS);
        const int l = ph / 12, k = ph % 12, i = l >> 1; const bool even = !(l & 1);
        bool did = true;
        if (ph == NPH - 1) {
            if (EN(0)) norm_phase<2>(A.out, A.norm_final, nullptr, A.out, nullptr, nullptr, nullptr, nullptr, gw, NGW, lane, tid);
        } else if (k == 0 || k == 9) {
            const int f = (k == 0) ? 0 : 1;
            if (EN(1)) if (k == 0) { convert_layer(A, l, (LAS float*)(lds + wave * 16384), gw, NGW, lane); if (l == 0) rope_table(A, gw, NGW, lane); }
            if (EN(0)) norm_phase<0>((l == 0 && k == 0) ? A.x : A.out, A.norm_ffn + (size_t)(l * 2 + f) * DM, HN, nullptr, nullptr, nullptr, nullptr, nullptr, gw, NGW, lane, tid);
        } else if (k == 1 || k == 10) {
            const int f = (k == 1) ? 0 : 1;
            pg8::Gemm g{HN, (const bf16_t*)(ws + WS_W + (f ? W_GU1 : W_GU0)), T, 2 * FF, DM}; pg8::StaticOrder S; S.init(T, 2 * FF, G, bx);
            pg8::EpiSwiglu E{R1, FF};
            if (EN(2)) pg8::gemm_phase<pg8::EpiSwiglu, pg8::StaticOrder, true, true>(lds, g, S, E);
        } else if (k == 2 || k == 11 || k == 8 || (k == 4 && !even)) {
            pg8::Gemm g; pg8::EpiResF32 E;
            if (k == 2 || k == 11) { const int f = (k == 2) ? 0 : 1; g = pg8::Gemm{R1, (const bf16_t*)(ws + WS_W + (f ? W_D1 : W_D0)), T, DM, FF};
                E = pg8::EpiResF32{(l == 0 && k == 2) ? A.x : A.out, A.out, DM, 0.5f}; }
            else if (k == 8) { g = pg8::Gemm{Yb, (const bf16_t*)(ws + WS_W + W_OUT), T, DM, DM}; E = pg8::EpiResF32{A.out, A.out, DM, 1.0f}; }
            else { g = pg8::Gemm{HN, (const bf16_t*)(ws + WS_W + W_MIN), T, 512, DM}; E = pg8::EpiResF32{nullptr, (float*)(ws + WS_Y), 512, 1.0f}; }
            pg8::StaticOrder S; S.init(g.M, g.N, G, bx);
            if (EN(3)) pg8::gemm_phase<pg8::EpiResF32, pg8::StaticOrder, true, true>(lds, g, S, E);
        } else if (k == 3) {
            if (!EN(4)) {} else if (even) norm_phase<1>(A.out, A.norm_mix + (size_t)l * DM, HN, nullptr, A.ab_w_in + (size_t)i * DM * 2056, A.ab_b_forget + (size_t)i * 8, LFb, (LAS float*)lds, gw, NGW, lane, tid);
            else norm_phase<0>(A.out, A.norm_mix + (size_t)l * DM, HN, nullptr, nullptr, nullptr, nullptr, nullptr, gw, NGW, lane, tid);
        } else if ((k == 4 && even) || (k == 6 && !even)) {
            const int ng = even ? 2 : 3;
            for (int j = 0; j < ng; ++j) {
                pg8::Gemm g; pg8::EpiBf16S E;
                if (even) {
                    if (j == 0) { g = pg8::Gemm{HN, (const bf16_t*)(ws + WS_W + W_IN), T, 1536, DM}; E = pg8::EpiBf16S{R1, 1536, 512, 1024, 0.125f * LOG2E}; }
                    else { g = pg8::Gemm{(const bf16_t*)(ws + WS_W + W_V), HN, 512, T, DM}; E = pg8::EpiBf16S{VT, T, 0, 0, 1.0f}; }
                } else {
                    if (j == 0) { g = pg8::Gemm{(const bf16_t*)(ws + WS_R1 + R_CQN), (const bf16_t*)(ws + WS_W + W_QB), T, 1536, 256}; E = pg8::EpiBf16S{R1, 1536, 0, 1536, 0.10206207261596577f * LOG2E}; }
                    else if (j == 1) { g = pg8::Gemm{(const bf16_t*)(ws + WS_R1 + R_CKVN), (const bf16_t*)(ws + WS_W + W_KNW), T, 1024, 256}; E = pg8::EpiBf16S{KN, 1024, 0, 0, 1.0f}; }
                    else { g = pg8::Gemm{(const bf16_t*)(ws + WS_W + W_VVW), (const bf16_t*)(ws + WS_R1 + R_CKVN), 1024, T, 256}; E = pg8::EpiBf16S{VT, T, 0, 0, 1.0f}; }
                }
                pg8::StaticOrder S; S.init(g.M, g.N, G, bx);
                if (EN(5)) pg8::gemm_phase<pg8::EpiBf16S, pg8::StaticOrder, true, true>(lds, g, S, E);
                __syncthreads();
            }
        } else if (k == 5) {
            if (!EN(6)) {} else if (even) scan_pool(A, i, lds, gw, NGW, lane, tid, wave);
            else mla_small(A, i, gw, NGW, lane);
        } else if (k == 7) {
            if (even) {
                for (int p = vcu; p < 16 * 32; p += G) { const int bh = p >> 5, s = p & 31, b = bh >> 3, h = bh & 7;
                    for (int z = 0; z < 2; ++z) { const int qb = z ? s : 63 - s;
                        if (EN(7)) attn_unit<64, true>(lds, R1 + (size_t)(b * SEQ) * 1536 + 512 + 64 * h, 1536, R1 + (size_t)(b * SEQ) * 1536 + 1024 + 64 * h, 1536, nullptr,
                                            VT + (size_t)(64 * h) * T + (size_t)b * SEQ, Fb + (size_t)bh * SEQ, nullptr, Yb + (size_t)(b * SEQ) * DM + 512 + 64 * h, qb * 256, tid); } }
            } else {
                for (int p = vcu; p < 32 * 32; p += G) { const int bh = p >> 5, s = p & 31, b = bh >> 4, h = bh & 15;
                    for (int z = 0; z < 2; ++z) { const int qb = z ? s : 63 - s;
                        if (EN(8)) attn_unit<96, false>(lds, R1 + (size_t)(b * SEQ) * 1536 + 96 * h, 1536, KN + (size_t)(b * SEQ) * 1024 + 64 * h, 1024, (const bf16_t*)(ws + WS_R1 + R_KR) + (size_t)(b * SEQ) * 32,
                                             VT + (size_t)(64 * h) * T + (size_t)b * SEQ, nullptr, CS + (size_t)(b * SEQ) * 32, Yb + (size_t)(b * SEQ) * DM + 64 * h, qb * 256, tid); } }
            }
        } else did = false;
        if (did && ph + 1 < ph_hi) { if (do_sync) cg::this_grid().sync(); }
    }
}

extern "C" void kernel_launch(void* const* d_in, const int* in_sizes, int n_in, void* d_out, int out_size, void* d_ws, size_t ws_size, hipStream_t stream) {
    static int grid = 0;
    if (grid == 0) {
        if (n_in != 19 || out_size != T * DM || ws_size < WS_END) { fprintf(stderr, "kernel_launch: unexpected shapes (n_in %d out %d ws %zu)\n", n_in, out_size, ws_size); grid = -1; return; }
        int dev = 0, cus = 0, per_cu = 0;
        hipGetDevice(&dev); hipDeviceGetAttribute(&cus, hipDeviceAttributeMultiprocessorCount, dev);
        if (hipFuncSetAttribute((const void*)fwd_mega, hipFuncAttributeMaxDynamicSharedMemorySize, LDS_BYTES) != hipSuccess) { fprintf(stderr, "kernel_launch: hipFuncSetAttribute failed\n"); grid = -1; return; }
        if (hipOccupancyMaxActiveBlocksPerMultiprocessor(&per_cu, (const void*)fwd_mega, 512, LDS_BYTES) != hipSuccess || per_cu < 1) { fprintf(stderr, "kernel_launch: occupancy query says %d\n", per_cu); per_cu = 1; }
        (void)hipGetLastError();
        grid = cus * 1;
    }
    if (grid < 0) return;
    Args a{};
    a.x = (const float*)d_in[0]; a.pos = (const int*)d_in[1]; a.norm_ffn = (const float*)d_in[2]; a.norm_mix = (const float*)d_in[3]; a.norm_final = (const float*)d_in[4];
    a.w_gate = (const float*)d_in[5]; a.w_up = (const float*)d_in[6]; a.w_down = (const float*)d_in[7];
    a.ab_w_in = (const float*)d_in[8]; a.ab_b_forget = (const float*)d_in[9]; a.pool_w = (const float*)d_in[10]; a.pool_scale = (const float*)d_in[11]; a.ab_w_out = (const float*)d_in[12];
    a.mla_w_in = (const float*)d_in[13]; a.mla_q_norm = (const float*)d_in[14]; a.mla_kv_norm = (const float*)d_in[15]; a.mla_w_q_b = (const float*)d_in[16]; a.mla_w_kv_b = (const float*)d_in[17]; a.mla_w_out = (const float*)d_in[18];
    a.out = (float*)d_out; a.ws = (unsigned char*)d_ws; a.pad = 0;
#if ONE_LAUNCH
    a.ph_lo = 0; a.ph_hi = NPH; a.do_sync = 1;
    void* args[] = {&a};
    hipError_t e = hipLaunchCooperativeKernel((const void*)fwd_mega, dim3(grid), dim3(512), args, LDS_BYTES, stream);
    if (e != hipSuccess) fprintf(stderr, "cooperative launch failed: %s (grid %d)\n", hipGetErrorString(e), grid);
#else
    for (int ph = 0; ph < NPH; ++ph) {
        const int l = ph / 12, k = ph % 12; if (ph != NPH - 1 && k == 6 && !(l & 1)) continue;
        a.ph_lo = ph; a.ph_hi = ph + 1; a.do_sync = 0;
        hipLaunchKernelGGL(fwd_mega, dim3(grid), dim3(512), LDS_BYTES, stream, a);
    }
#endif
}
```

```cpp
#include <hip/hip_runtime.h>
#include <hip/hip_cooperative_groups.h>
#include <cstdio>
#include <cstdint>
namespace cg = cooperative_groups;
#ifndef ONE_LAUNCH
#define ONE_LAUNCH 1
#endif
namespace pg8 {
#define PG8_LAS __attribute__((address_space(3)))
typedef unsigned short bf16_t;
typedef short bf16x8 __attribute__((ext_vector_type(8)));
typedef float f32x4 __attribute__((ext_vector_type(4)));
typedef unsigned u32x4 __attribute__((ext_vector_type(4)));
constexpr int BM = 256, BK = 64, HALF = 128, HTB = HALF * BK * 2  , STAGE_BYTES = 8 * HTB, NXCD = 8, WGM = 8;

__host__ __device__ __forceinline__ int lds_byte(int r, int c) { const int st = (r >> 4) * 2 + (c >> 5), rr = r & 15, cc = c & 31, ob = rr * 64 + cc * 2; return st * 1024 + (ob ^ (((ob >> 9) & 1) << 5)); }
__host__ __device__ __forceinline__ void stage_rc(int b, int& R, int& C) { const int st = b / 1024, sb = b % 1024, swz = sb ^ (((sb >> 9) & 1) << 5); R = (st >> 1) * 16 + swz / 64; C = (st & 1) * 32 + (swz % 64) / 2; }
__host__ __device__ __forceinline__ int perm32(int rho) { const int n = rho >> 4, i = rho & 15; return 8 * (i >> 2) + 4 * n + (i & 3); }

struct Unit { int pm, pn; };
struct Gemm { const bf16_t* A; const bf16_t* Bt; int M, N, K; };

struct StaticOrder {
    int nM, nN, nwg, G, c;
    __host__ __device__ void init(int M, int N, int G_, int c_) { nM = M / BM; nN = N / BM; nwg = nM * nN; G = G_; c = c_; }
    __host__ __device__ bool next(int i, Unit& u) const {
        const long L = (long)i * G + c; if (L >= nwg) return false;
        int wgid = (int)L; { const int q = nwg / NXCD, r = nwg % NXCD, xcd = wgid % NXCD, off = wgid / NXCD; wgid = (xcd < r ? xcd * (q + 1) : r * (q + 1) + (xcd - r) * q) + off; }
        const int nig = WGM * nN, gid = wgid / nig, fm = gid * WGM, gsz = (nM - fm) < WGM ? (nM - fm) : WGM;
        u.pm = fm + ((wgid % nig) % gsz); u.pn = (wgid % nig) / gsz; return true;
    }
    __device__ __forceinline__ void a_ready(const Unit&) const {}
    __device__ __forceinline__ void done(const Unit&) const {}
};
__device__ __forceinline__ unsigned cvt_pk_bf16(float lo, float hi) { unsigned r; asm volatile("v_cvt_pk_bf16_f32 %0, %1, %2" : "=v"(r) : "v"(lo), "v"(hi)); return r; }
typedef float f32x2 __attribute__((ext_vector_type(2)));
struct EpiBf16S {
    static constexpr bool PERM = true, AFTER_DRAIN = false;
    bf16_t* O; int ldc; int sc_lo, sc_hi; float scale;
    __device__ __forceinline__ void operator()(const f32x4 (&acc)[2][2][4][2], const Unit& u, int wr, int wc, int fr, int fq) const {
        const int row0 = u.pm * BM + wr * 64 + fr; const int colt = u.pn * BM;
        const float sc = (colt >= sc_lo && colt < sc_hi) ? scale : 1.f;
        const int col0 = colt + wc * 32 + 8 * fq;
#pragma unroll
        for (int ai = 0; ai < 2; ++ai)
#pragma unroll
            for (int m = 0; m < 4; ++m) { bf16_t* rowp = O + (size_t)(row0 + ai * HALF + m * 16) * ldc + col0;
#pragma unroll
                for (int bj = 0; bj < 2; ++bj) { const f32x4 v0 = acc[ai][bj][m][0] * sc, v1 = acc[ai][bj][m][1] * sc;
                    u32x4 w; w.x = cvt_pk_bf16(v0[0], v0[1]); w.y = cvt_pk_bf16(v0[2], v0[3]); w.z = cvt_pk_bf16(v1[0], v1[1]); w.w = cvt_pk_bf16(v1[2], v1[3]);
                    *(u32x4*)(rowp + bj * HALF) = w; } }
    }
};
struct EpiSwiglu {
    static constexpr bool PERM = true, AFTER_DRAIN = false;
    bf16_t* O; int ldc;
    __device__ __forceinline__ void operator()(const f32x4 (&acc)[2][2][4][2], const Unit& u, int wr, int wc, int fr, int fq) const {
        const int row0 = u.pm * BM + wr * 64 + fr; const int col0 = u.pn * HALF + wc * 32 + 8 * fq;
#pragma unroll
        for (int ai = 0; ai < 2; ++ai)
#pragma unroll
            for (int m = 0; m < 4; ++m) { bf16_t* rowp = O + (size_t)(row0 + ai * HALF + m * 16) * ldc + col0;
                float a[8];
#pragma unroll
                for (int n = 0; n < 2; ++n)
#pragma unroll
                    for (int e = 0; e < 4; ++e) { const float g = acc[ai][0][m][n][e], up = acc[ai][1][m][n][e];
                        const float sg = g * __builtin_amdgcn_rcpf(1.0f + __builtin_amdgcn_exp2f(-1.4426950408889634f * g)); a[n * 4 + e] = sg * up; }
                u32x4 w; w.x = cvt_pk_bf16(a[0], a[1]); w.y = cvt_pk_bf16(a[2], a[3]); w.z = cvt_pk_bf16(a[4], a[5]); w.w = cvt_pk_bf16(a[6], a[7]);
                *(u32x4*)rowp = w; }
    }
};
struct EpiResF32 {
    static constexpr bool PERM = false, AFTER_DRAIN = false;
    const float* base; float* out; int ldc; float alpha;
    __device__ __forceinline__ void operator()(const f32x4 (&acc)[2][2][4][2], const Unit& u, int wr, int wc, int fr, int fq) const {
        const int col0 = u.pn * BM + wc * 32 + 4 * fq;
#pragma unroll
        for (int ai = 0; ai < 2; ++ai)
#pragma unroll
            for (int m = 0; m < 4; ++m) { const int r = u.pm * BM + ai * HALF + wr * 64 + m * 16 + fr; const size_t off = (size_t)r * ldc + col0;
#pragma unroll
                for (int bj = 0; bj < 2; ++bj)
#pragma unroll
                    for (int n = 0; n < 2; ++n) { f32x4 o = acc[ai][bj][m][n] * alpha;
                        if (base) o = o + *(const f32x4*)(base + off + bj * HALF + n * 16);
                        *(f32x4*)(out + off + bj * HALF + n * 16) = o; } }
    }
};

template <class Epi, class Sched, bool ALIGN_EPI = false, bool SP2 = false>
__device__ __forceinline__ void gemm_phase(PG8_LAS unsigned char* lds, const Gemm g, const Sched& S, const Epi& E) {
    int tid_l = threadIdx.x; asm volatile("" : "+v"(tid_l));
    const int tid = tid_l, wid = __builtin_amdgcn_readfirstlane(tid >> 6), lane = tid & 63, wr = wid >> 2, wc = wid & 3, fr = lane & 15, fq = lane >> 4;
    const int K = g.K, nt = K / BK;
    unsigned voffA[2], voffB[2];
#pragma unroll
    for (int i = 0; i < 2; ++i) { int R, C; stage_rc(tid * 16 + i * 8192, R, C); const int Rb = Epi::PERM ? ((R & ~31) + perm32(R & 31)) : R;
        voffA[i] = (unsigned)(R * K + C) * 2u; voffB[i] = (unsigned)(Rb * K + C) * 2u; }
    const size_t kstep = (size_t)(BK * 2);
    const size_t hstep = (size_t)HALF * K * 2;
    const size_t tstep = 2 * hstep;
    const unsigned ldsw = (unsigned)wid * 1024u;
    const int aoff = lds_byte(wr * 64 + fr, fq * 8), boff = lds_byte(wc * 32 + fr, fq * 8);
#define PG8_SA(b, h) (((b) * 2 + (h)) * HTB)
#define PG8_SB(b, h) ((4 + (b) * 2 + (h)) * HTB)
#define PG8_STAGE(bufoff, gbase, voff) do { _Pragma("unroll") for (int _i = 0; _i < 2; ++_i) \
        __builtin_amdgcn_global_load_lds((const unsigned*)((const char*)(gbase) + (voff)[_i]), (PG8_LAS unsigned*)(lds + (bufoff) + ldsw + _i * 8192), 16, 0, 0); } while (0)
#define PG8_LDA(dst, b, h) do { _Pragma("unroll") for (int m = 0; m < 4; ++m) _Pragma("unroll") for (int k = 0; k < 2; ++k) dst[m][k] = *(const PG8_LAS bf16x8*)(lds + PG8_SA(b, h) + aoff + m * 2048 + k * 1024); } while (0)
#define PG8_LDB(dst, b, h) do { _Pragma("unroll") for (int n = 0; n < 2; ++n) _Pragma("unroll") for (int k = 0; k < 2; ++k) dst[n][k] = *(const PG8_LAS bf16x8*)(lds + PG8_SB(b, h) + boff + n * 2048 + k * 1024); } while (0)
#define PG8_MMA(ai, bj, At, Bt) do { __builtin_amdgcn_s_setprio(1); _Pragma("unroll") for (int m = 0; m < 4; ++m) _Pragma("unroll") for (int n = 0; n < 2; ++n) _Pragma("unroll") for (int k = 0; k < 2; ++k) \
        acc[ai][bj][m][n] = __builtin_amdgcn_mfma_f32_16x16x32_bf16(Bt[n][k], At[m][k], acc[ai][bj][m][n], 0, 0, 0); __builtin_amdgcn_s_setprio(0); } while (0)
#define PG8_WAIT_V(n) asm volatile("s_waitcnt vmcnt(" #n ")" ::: "memory")
#define PG8_WAIT_L(n) asm volatile("s_waitcnt lgkmcnt(" #n ")" ::: "memory")
#define PG8_BAR __builtin_amdgcn_s_barrier()
#define PG8_SCHED __builtin_amdgcn_sched_barrier(0)
    Unit cur, nxt; int ui = 0;
    if (!S.next(0, cur)) return;
    f32x4 acc[2][2][4][2];
#pragma unroll
    for (int a = 0; a < 2; ++a)
#pragma unroll
        for (int b = 0; b < 2; ++b)
#pragma unroll
            for (int m = 0; m < 4; ++m)
#pragma unroll
                for (int n = 0; n < 2; ++n) acc[a][b][m][n] = (f32x4){0.f, 0.f, 0.f, 0.f};
    bf16x8 At[4][2], B0[2][2], B1[2][2];
    const char* cA = (const char*)g.A + (size_t)cur.pm * tstep; const char* cB = (const char*)g.Bt + (size_t)cur.pn * tstep;
    S.a_ready(cur);
    if constexpr (SP2) {
        PG8_STAGE(PG8_SB(0, 0), cB, voffB); PG8_STAGE(PG8_SB(0, 1), cB + hstep, voffB); PG8_STAGE(PG8_SA(0, 0), cA, voffA); PG8_STAGE(PG8_SA(0, 1), cA + hstep, voffA);
        if (wr == 1) PG8_BAR;
        PG8_WAIT_V(2); PG8_BAR;
        PG8_STAGE(PG8_SB(1, 0), cB + kstep, voffB); PG8_STAGE(PG8_SA(1, 0), cA + kstep, voffA); PG8_STAGE(PG8_SB(1, 1), cB + hstep + kstep, voffB);
        PG8_WAIT_V(6); PG8_BAR;
    } else {
        PG8_STAGE(PG8_SB(0, 0), cB, voffB); PG8_STAGE(PG8_SA(0, 0), cA, voffA); PG8_STAGE(PG8_SB(0, 1), cB + hstep, voffB); PG8_STAGE(PG8_SA(0, 1), cA + hstep, voffA);
        if (wr == 1) PG8_BAR;
        PG8_WAIT_V(4); PG8_BAR;
        PG8_STAGE(PG8_SB(1, 0), cB + kstep, voffB); PG8_STAGE(PG8_SA(1, 0), cA + kstep, voffA); PG8_STAGE(PG8_SB(1, 1), cB + hstep + kstep, voffB);
        PG8_WAIT_V(6); PG8_BAR;
    }
    for (;;) {
        const bool has_next = S.next(ui + 1, nxt);
        const char* nA = has_next ? (const char*)g.A + (size_t)nxt.pm * tstep : cA; const char* nB = has_next ? (const char*)g.Bt + (size_t)nxt.pn * tstep : cB;
        for (int t = 0; t < nt; t += 2) {
            const bool last = (t == nt - 2);
            const char* a1 = cA + (size_t)(t + 1) * kstep;
            const char* a2 = last ? nA : cA + (size_t)(t + 2) * kstep; const char* b2 = last ? nB : cB + (size_t)(t + 2) * kstep;
            const char* a3 = a2 + kstep; const char* b3 = b2 + kstep;
            if (last && has_next) S.a_ready(nxt);
            if constexpr (SP2) {
            PG8_LDB(B0, 0, 0); PG8_LDB(B1, 0, 1); PG8_SCHED; PG8_LDA(At, 0, 0); PG8_STAGE(PG8_SA(1, 1), a1 + hstep, voffA);
            PG8_WAIT_V(8); PG8_WAIT_L(0); PG8_BAR; PG8_MMA(0, 0, At, B0); PG8_MMA(0, 1, At, B1); PG8_BAR; PG8_SCHED;
            PG8_LDA(At, 0, 1); PG8_STAGE(PG8_SB(0, 0), b2, voffB); PG8_STAGE(PG8_SB(0, 1), b2 + hstep, voffB); PG8_STAGE(PG8_SA(0, 0), a2, voffA);
            PG8_WAIT_V(8); PG8_WAIT_L(0); PG8_BAR; PG8_MMA(1, 0, At, B0); PG8_MMA(1, 1, At, B1); PG8_BAR; PG8_SCHED;
            PG8_LDB(B0, 1, 0); PG8_LDB(B1, 1, 1); PG8_SCHED; PG8_LDA(At, 1, 0); PG8_STAGE(PG8_SA(0, 1), a2 + hstep, voffA);
            PG8_WAIT_V(8); PG8_WAIT_L(0); PG8_BAR; PG8_MMA(0, 0, At, B0); PG8_MMA(0, 1, At, B1); PG8_BAR; PG8_SCHED;
            PG8_LDA(At, 1, 1); PG8_STAGE(PG8_SB(1, 0), b3, voffB); PG8_STAGE(PG8_SB(1, 1), b3 + hstep, voffB); PG8_STAGE(PG8_SA(1, 0), a3, voffA);
            PG8_WAIT_V(8); PG8_WAIT_L(0); PG8_BAR; PG8_MMA(1, 0, At, B0); PG8_MMA(1, 1, At, B1); PG8_BAR; PG8_SCHED;
            } else {
            PG8_LDB(B0, 0, 0); PG8_SCHED; PG8_LDA(At, 0, 0); PG8_STAGE(PG8_SA(1, 1), a1 + hstep, voffA);
            PG8_WAIT_L(8); PG8_BAR; PG8_WAIT_L(0); PG8_MMA(0, 0, At, B0); PG8_BAR; PG8_SCHED;
            PG8_LDB(B1, 0, 1); PG8_STAGE(PG8_SB(0, 0), b2, voffB);
            PG8_BAR; PG8_WAIT_L(0); PG8_MMA(0, 1, At, B1); PG8_BAR;
            PG8_LDA(At, 0, 1); PG8_STAGE(PG8_SA(0, 0), a2, voffA);
            PG8_BAR; PG8_WAIT_L(0); PG8_MMA(1, 0, At, B0); PG8_BAR; PG8_SCHED;
            PG8_STAGE(PG8_SB(0, 1), b2 + hstep, voffB);
            PG8_WAIT_V(6); PG8_BAR; PG8_MMA(1, 1, At, B1); PG8_BAR;
            PG8_LDB(B0, 1, 0); PG8_SCHED; PG8_LDA(At, 1, 0); PG8_STAGE(PG8_SA(0, 1), a2 + hstep, voffA);
            PG8_WAIT_L(8); PG8_BAR; PG8_WAIT_L(0); PG8_MMA(0, 0, At, B0); PG8_BAR; PG8_SCHED;
            PG8_LDB(B1, 1, 1); PG8_STAGE(PG8_SB(1, 0), b3, voffB);
            PG8_BAR; PG8_WAIT_L(0); PG8_MMA(0, 1, At, B1); PG8_BAR;
            PG8_LDA(At, 1, 1); PG8_STAGE(PG8_SA(1, 0), a3, voffA);
            PG8_BAR; PG8_WAIT_L(0); PG8_MMA(1, 0, At, B0); PG8_BAR; PG8_SCHED;
            PG8_STAGE(PG8_SB(1, 1), b3 + hstep, voffB);
            PG8_WAIT_V(6); PG8_BAR; PG8_MMA(1, 1, At, B1); PG8_BAR;
            }
        }
        if constexpr (ALIGN_EPI) { if (wr == 0) PG8_BAR; }
        if constexpr (!Epi::AFTER_DRAIN) { E(acc, cur, wr, wc, fr, fq); S.done(cur); }
        if (!has_next) break;
#pragma unroll
        for (int a = 0; a < 2; ++a)
#pragma unroll
            for (int b = 0; b < 2; ++b)
#pragma unroll
                for (int m = 0; m < 4; ++m)
#pragma unroll
                    for (int n = 0; n < 2; ++n) acc[a][b][m][n] = (f32x4){0.f, 0.f, 0.f, 0.f};
        cur = nxt; cA = nA; cB = nB; ++ui;
        if constexpr (ALIGN_EPI) { if (wr == 1) PG8_BAR; }
    }
    PG8_WAIT_V(0);
    if constexpr (!ALIGN_EPI) { if (wr == 0) PG8_BAR; }
    PG8_BAR;
    if constexpr (Epi::AFTER_DRAIN) { E.fused(acc, cur, wr, wc, fr, fq, lds, wid, lane); S.done(cur); }
#undef PG8_SA
#undef PG8_SB
#undef PG8_STAGE
#undef PG8_LDA
#undef PG8_LDB
#undef PG8_MMA
#undef PG8_WAIT_V
#undef PG8_WAIT_L
#undef PG8_BAR
#undef PG8_SCHED
}
}
#define LAS __attribute__((address_space(3)))
typedef unsigned short bf16_t;
typedef short bf16x8 __attribute__((ext_vector_type(8)));
typedef float f32x4 __attribute__((ext_vector_type(4)));
typedef float f32x16 __attribute__((ext_vector_type(16)));
typedef unsigned u32x4 __attribute__((ext_vector_type(4)));
typedef unsigned u32x2 __attribute__((ext_vector_type(2)));

constexpr int SEQ = 16384, NB = 2, T = NB * SEQ, DM = 1024, FF = 2816;
constexpr size_t MiB = 1u << 20;
constexpr size_t WS_W = 0, WS_HN = 48 * MiB, WS_Y = 112 * MiB, WS_R1 = 176 * MiB, WS_VT = 352 * MiB, WS_KN = 416 * MiB, WS_SM = 480 * MiB, WS_END = 488 * MiB;
constexpr size_t W_GU0 = 0, W_D0 = 11 * MiB, W_GU1 = 17 * MiB, W_D1 = 28 * MiB, W_MIX = 34 * MiB;
constexpr size_t W_IN = W_MIX, W_V = W_MIX + 3 * MiB, W_OUT = W_MIX + 4 * MiB, W_P = W_MIX + 6 * MiB;
constexpr size_t W_MIN = W_MIX, W_QB = W_MIX + 1 * MiB, W_KNW = W_MIX + 2 * MiB, W_VVW = W_MIX + 2 * MiB + 512 * 1024;
constexpr size_t R_Q = 0, R_CQN = 96 * MiB, R_CKVN = 112 * MiB, R_KR = 128 * MiB;
constexpr size_t SM_LF = 0, SM_F = 1 * MiB, SM_KQ = 3 * MiB, SM_CTR = 3 * MiB + 1024, SM_CS = 4 * MiB;
constexpr int LDS_BYTES = 147456;
constexpr float LOG2E = 1.4426950408889634f;
constexpr int NPH = 49;
#ifndef EN_MASK
#define EN_MASK 0xFFFF
#endif
#define EN(b) ((EN_MASK >> (b)) & 1)

struct Args {
    const float* x; const int* pos; const float* norm_ffn; const float* norm_mix; const float* norm_final;
    const float* w_gate; const float* w_up; const float* w_down;
    const float* ab_w_in; const float* ab_b_forget; const float* pool_w; const float* pool_scale; const float* ab_w_out;
    const float* mla_w_in; const float* mla_q_norm; const float* mla_kv_norm; const float* mla_w_q_b; const float* mla_w_kv_b; const float* mla_w_out;
    float* out; unsigned char* ws; int ph_lo, ph_hi; int do_sync, pad;
};

__device__ __forceinline__ float wave_sum(float v) {
#pragma unroll
    for (int o = 1; o < 64; o <<= 1) v += __shfl_xor(v, o);
    return v;
}
typedef float f32x2_t __attribute__((ext_vector_type(2))); typedef __bf16 bf16x2_t __attribute__((ext_vector_type(2)));
__device__ __forceinline__ unsigned pk2(float lo, float hi) { f32x2_t v = {lo, hi}; bf16x2_t b = __builtin_convertvector(v, bf16x2_t); return __builtin_bit_cast(unsigned, b); }
__device__ __forceinline__ float bflo(unsigned w) { return __uint_as_float(w << 16); }
__device__ __forceinline__ float bfhi(unsigned w) { return __uint_as_float(w & 0xffff0000u); }
__device__ __forceinline__ float max3f(float a, float b, float c) { float r; asm("v_max3_f32 %0, %1, %2, %3" : "=v"(r) : "v"(a), "v"(b), "v"(c)); return r; }
#define LDS_FENCE() asm volatile("s_waitcnt lgkmcnt(0)" ::: "memory")
#define LBAR() do { asm volatile("s_waitcnt lgkmcnt(0)" ::: "memory"); __builtin_amdgcn_s_barrier(); asm volatile("" ::: "memory"); } while (0)

__device__ __forceinline__ void transpose_item(const float* __restrict__ src, int ld, int k0, bf16_t* __restrict__ dst, int ldd, LAS float* scr, int lane) {
#pragma unroll 8
    for (int i = 0; i < 32; ++i) { const int kk = 2 * i + (lane >> 5); scr[kk * 33 + (lane & 31)] = src[(size_t)(k0 + kk) * ld + (lane & 31)]; }
    LDS_FENCE();
    const int c = lane & 7;
#pragma unroll
    for (int j = 0; j < 4; ++j) { const int n = (lane >> 3) + 8 * j; const LAS float* s = scr + (8 * c) * 33 + n;
        u32x4 o; o.x = pk2(s[0 * 33], s[1 * 33]); o.y = pk2(s[2 * 33], s[3 * 33]); o.z = pk2(s[4 * 33], s[5 * 33]); o.w = pk2(s[6 * 33], s[7 * 33]);
        *(u32x4*)(dst + (size_t)n * ldd + k0 + 8 * c) = o; }
    LDS_FENCE();
}

__device__ __forceinline__ void convert_layer(const Args& A, int l, LAS float* scr, int gw, int NGW, int lane) {
    const int i = l >> 1; const bool even = !(l & 1);
    constexpr int NF = 1408;
    unsigned char* W = A.ws + WS_W;
    const int total = 6 * NF + (even ? (768 + 256 + 512 + 32) : (208 + 192 + 128 + 512));
    for (int it = gw; it < total; it += NGW) {
        int r = it;
        if (r < 6 * NF) {
            const int f = r / (3 * NF), r2 = r % (3 * NF), kind = r2 / NF, q = r2 % NF;
            const size_t wo = (size_t)(l * 2 + f) * DM * FF;
            if (kind < 2) { const int kb = q / 88, nb = q % 88; const float* src = (kind == 0 ? A.w_gate : A.w_up) + wo + 32 * nb;
                bf16_t* dst = (bf16_t*)(W + (f ? W_GU1 : W_GU0)) + (size_t)((nb >> 2) * 256 + (nb & 3) * 32 + kind * 128) * DM;
                transpose_item(src, FF, 64 * kb, dst, DM, scr, lane); }
            else { const int kb = q / 32, nb = q % 32; const float* src = A.w_down + wo + 32 * nb;
                bf16_t* dst = (bf16_t*)(W + (f ? W_D1 : W_D0)) + (size_t)(32 * nb) * FF;
                transpose_item(src, DM, 64 * kb, dst, FF, scr, lane); }
            continue;
        }
        r -= 6 * NF;
        if (even) {
            const float* win = A.ab_w_in + (size_t)i * DM * 2056;
            if (r < 768) { const int kb = r / 48, nb = r % 48; transpose_item(win + 32 * nb, 2056, 64 * kb, (bf16_t*)(W + W_IN) + (size_t)(32 * nb) * DM, DM, scr, lane); continue; } r -= 768;
            if (r < 256) { const int kb = r / 16, nb = r % 16; transpose_item(win + 1536 + 32 * nb, 2056, 64 * kb, (bf16_t*)(W + W_V) + (size_t)(32 * nb) * DM, DM, scr, lane); continue; } r -= 256;
            if (r < 512) { const int kb = r / 32, nb = r % 32; transpose_item(A.ab_w_out + (size_t)i * DM * DM + 32 * nb, DM, 64 * kb, (bf16_t*)(W + W_OUT) + (size_t)(32 * nb) * DM, DM, scr, lane); continue; } r -= 512;
            { const int g = r >> 3, kb = (r & 7) >> 2, nb = r & 3; transpose_item(A.pool_w + (size_t)(i * 4 + g) * 16384 + 32 * nb, 128, 64 * kb, (bf16_t*)(W + W_P) + (size_t)g * 16384 + (size_t)(32 * nb) * 128, 128, scr, lane); }
        } else {
            if (r < 208) { const int kb = r / 13, nb = r % 13; transpose_item(A.mla_w_in + (size_t)i * DM * 416 + 32 * nb, 416, 64 * kb, (bf16_t*)(W + W_MIN) + (size_t)(32 * nb) * DM, DM, scr, lane); continue; } r -= 208;
            if (r < 192) { const int kb = r / 48, nb = r % 48; transpose_item(A.mla_w_q_b + (size_t)i * 256 * 1536 + 32 * nb, 1536, 64 * kb, (bf16_t*)(W + W_QB) + (size_t)(32 * nb) * 256, 256, scr, lane); continue; } r -= 192;
            if (r < 128) { const int kb = r / 64, nb = r % 64; const int col0 = 32 * nb, head = col0 >> 7, within = col0 & 127;
                bf16_t* dst = (within < 64) ? (bf16_t*)(W + W_KNW) + (size_t)(64 * head + within) * 256 : (bf16_t*)(W + W_VVW) + (size_t)(64 * head + within - 64) * 256;
                transpose_item(A.mla_w_kv_b + (size_t)i * 128 * 2048 + col0, 2048, 64 * kb, dst, 256, scr, lane); continue; } r -= 128;
            { const int kb = r / 32, nb = r % 32; transpose_item(A.mla_w_out + (size_t)i * DM * DM + 32 * nb, DM, 64 * kb, (bf16_t*)(W + W_OUT) + (size_t)(32 * nb) * DM, DM, scr, lane); }
        }
    }
    if (!even) {
        const int gt = gw * 64 + lane, NT_ = NGW * 64;
        for (int idx = gt; idx < 2048 * 16; idx += NT_) { const int row = idx >> 4, c = idx & 15;
            *(u32x4*)((bf16_t*)(W + W_KNW) + (size_t)row * 256 + 128 + 8 * c) = (u32x4){0u, 0u, 0u, 0u}; }
    }
}

__constant__ float ROPE_INVF[16] = {(float)1.0, (float)0.5623413251903491, (float)0.31622776601683794, (float)0.1778279410038923, (float)0.1, (float)0.05623413251903491, (float)0.031622776601683794, (float)0.01778279410038923,
    (float)0.01, (float)0.005623413251903491, (float)0.0031622776601683794, (float)0.001778279410038923, (float)0.001, (float)0.0005623413251903491, (float)0.00031622776601683794, (float)0.0001778279410038923};
__device__ __forceinline__ void rope_table(const Args& A, int gw, int NGW, int lane) {
    float* CS = (float*)(A.ws + WS_SM + SM_CS);
    const int gt = gw * 64 + lane, NT_ = NGW * 64;
    for (int idx = gt; idx < T * 16; idx += NT_) {
        const int t = idx >> 4, j = idx & 15;
        const float invf = ROPE_INVF[j];
        const float ang = (float)A.pos[t] * invf;
        const double rev = (double)ang * 0.15915494309189535;
        const float fr = (float)(rev - __builtin_rint(rev));
        CS[(size_t)t * 32 + j] = __builtin_amdgcn_cosf(fr);
        CS[(size_t)t * 32 + 16 + j] = __builtin_amdgcn_sinf(fr);
    }
}

template <int MODE>
__device__ __forceinline__ void norm_phase(const float* src, const float* __restrict__ g, bf16_t* dst16, float* dst32,
                                           const float* __restrict__ wfsrc, const float* __restrict__ bforget, float* LF, LAS float* wfT, int gw, int NGW, int lane, int tid) {
    if (MODE == 1) {
        for (int idx = tid; idx < 8192; idx += 512) { const int k = idx >> 3, f = idx & 7; wfT[f * 1024 + k] = wfsrc[(size_t)k * 2056 + 2048 + f]; }
        LDS_FENCE(); __syncthreads();
    }
    f32x4 gv[4];
#pragma unroll
    for (int j = 0; j < 4; ++j) gv[j] = *(const f32x4*)(g + 4 * lane + 256 * j);
    for (int m = gw; m < T; m += NGW) {
        const f32x4* xr = (const f32x4*)(src + (size_t)m * DM) + lane;
        f32x4 v[4]; float ss = 0.f;
#pragma unroll
        for (int j = 0; j < 4; ++j) { v[j] = xr[64 * j]; ss += (v[j].x * v[j].x + v[j].y * v[j].y) + (v[j].z * v[j].z + v[j].w * v[j].w); }
        ss = wave_sum(ss);
        const float rstd = 1.0f / sqrtf(ss * (1.0f / DM) + 1e-6f);
#pragma unroll
        for (int j = 0; j < 4; ++j) v[j] = v[j] * rstd * gv[j];
        if (MODE == 2) {
            f32x4* o = (f32x4*)(dst32 + (size_t)m * DM) + lane;
#pragma unroll
            for (int j = 0; j < 4; ++j) o[64 * j] = v[j];
        } else {
            u32x2* o = (u32x2*)(dst16 + (size_t)m * DM) + lane;
#pragma unroll
            for (int j = 0; j < 4; ++j) { u32x2 w; w.x = pk2(v[j].x, v[j].y); w.y = pk2(v[j].z, v[j].w); o[64 * j] = w; }
        }
        if (MODE == 1) {
            float mine = 0.f;
#pragma unroll
            for (int f = 0; f < 8; ++f) { float a = 0.f;
#pragma unroll
                for (int j = 0; j < 4; ++j) { const f32x4 w = *(const LAS f32x4*)(wfT + f * 1024 + 4 * lane + 256 * j); a += (v[j].x * w.x + v[j].y * w.y) + (v[j].z * w.z + v[j].w * w.w); }
                a = wave_sum(a); mine = (lane == f) ? a : mine; }
            if (lane < 8) { const float xx = mine + bforget[lane];
                const float ls = xx < 0.f ? xx - log1pf(expf(xx)) : -log1pf(expf(-xx));
                const int b = m / SEQ, t = m % SEQ; LF[(size_t)(b * 8 + lane) * SEQ + t] = ls; }
        }
    }
}

__device__ __forceinline__ void mla_small(const Args& A, int i, int gw, int NGW, int lane) {
    const float* PROJ = (const float*)(A.ws + WS_Y);
    bf16_t* CQN = (bf16_t*)(A.ws + WS_R1 + R_CQN); bf16_t* CKVN = (bf16_t*)(A.ws + WS_R1 + R_CKVN); bf16_t* KR = (bf16_t*)(A.ws + WS_R1 + R_KR);
    const float* CS = (const float*)(A.ws + WS_SM + SM_CS);
    const f32x4 gq = *(const f32x4*)(A.mla_q_norm + (size_t)i * 256 + 4 * lane);
    const f32x4 gk = *(const f32x4*)(A.mla_kv_norm + (size_t)i * 128 + 4 * (lane & 31));
    for (int m = gw; m < T; m += NGW) {
        const float* row = PROJ + (size_t)m * 512;
        const f32x4 a = *(const f32x4*)(row + 4 * lane);
        f32x4 b = (f32x4){0.f, 0.f, 0.f, 0.f};
        if (lane < 40) b = *(const f32x4*)(row + 256 + 4 * lane);
        const float sq = wave_sum((a.x * a.x + a.y * a.y) + (a.z * a.z + a.w * a.w));
        const float skv = wave_sum(lane < 32 ? (b.x * b.x + b.y * b.y) + (b.z * b.z + b.w * b.w) : 0.f);
        const float rq = 1.0f / sqrtf(sq * (1.0f / 256.0f) + 1e-6f), rkv = 1.0f / sqrtf(skv * (1.0f / 128.0f) + 1e-6f);
        { const f32x4 y = a * rq * gq; u32x2 w; w.x = pk2(y.x, y.y); w.y = pk2(y.z, y.w); *(u32x2*)(CQN + (size_t)m * 256 + 4 * lane) = w; }
        { const f32x4 y = b * rkv * gk; u32x2 w; w.x = pk2(y.x, y.y); w.y = pk2(y.z, y.w); if (lane >= 32) { w.x = 0u; w.y = 0u; }
          *(u32x2*)(CKVN + (size_t)m * 256 + 4 * lane) = w; }
        f32x4 p; p.x = __shfl_xor(b.x, 4); p.y = __shfl_xor(b.y, 4); p.z = __shfl_xor(b.z, 4); p.w = __shfl_xor(b.w, 4);
        if (lane >= 32 && lane < 40) { const int i0 = 4 * ((lane - 32) & 3);
            const f32x4 c = *(const f32x4*)(CS + (size_t)m * 32 + i0), s = *(const f32x4*)(CS + (size_t)m * 32 + 16 + i0);
            f32x4 o; if (lane < 36) o = b * c - p * s; else o = b * c + p * s;
            u32x2 w; w.x = pk2(o.x, o.y); w.y = pk2(o.z, o.w); *(u32x2*)(KR + (size_t)m * 32 + 4 * (lane - 32)) = w; }
    }
}

__device__ __forceinline__ void scan_pool(const Args& A, int i, LAS unsigned char* lds, int gw, int NGW, int lane, int tid, int wave) {
    if (blockIdx.x < 16) {
        const int bh = blockIdx.x; const float* lf = (const float*)(A.ws + WS_SM + SM_LF) + (size_t)bh * SEQ + tid * 32; double* Fo = (double*)(A.ws + WS_SM + SM_F) + (size_t)bh * SEQ + tid * 32;
        f32x4 v[8]; double tot = 0.0;
#pragma unroll
        for (int e = 0; e < 8; ++e) { v[e] = *(const f32x4*)(lf + 4 * e); tot += ((double)v[e].x + (double)v[e].y) + ((double)v[e].z + (double)v[e].w); }
        double incl = tot;
#pragma unroll
        for (int o = 1; o < 64; o <<= 1) { const double n = __shfl_up(incl, o); if (lane >= o) incl += n; }
        LAS double* wt = (LAS double*)lds;
        if (lane == 63) wt[wave] = incl;
        LDS_FENCE(); __syncthreads();
        double run = incl - tot;
        for (int j = 0; j < wave; ++j) run += wt[j];
#pragma unroll
        for (int e = 0; e < 8; ++e) { double o0, o1, o2, o3; run += (double)v[e].x; o0 = run; run += (double)v[e].y; o1 = run; run += (double)v[e].z; o2 = run; run += (double)v[e].w; o3 = run;
            Fo[4 * e + 0] = o0; Fo[4 * e + 1] = o1; Fo[4 * e + 2] = o2; Fo[4 * e + 3] = o3; }
        __syncthreads();
    }
    { const bf16_t* Pq = (const bf16_t*)(A.ws + WS_R1); unsigned* KQ = (unsigned*)(A.ws + WS_SM + SM_KQ);
      float mq = 0.f, mk = 0.f;
      for (int j = 0; j < 16; ++j) { const size_t m = (size_t)gw * 16 + j;
          const u32x4 q = *(const u32x4*)(Pq + m * 1536 + 512 + 8 * lane), k = *(const u32x4*)(Pq + m * 1536 + 1024 + 8 * lane);
          float sq = bflo(q.x) * bflo(q.x) + bfhi(q.x) * bfhi(q.x) + bflo(q.y) * bflo(q.y) + bfhi(q.y) * bfhi(q.y) + bflo(q.z) * bflo(q.z) + bfhi(q.z) * bfhi(q.z) + bflo(q.w) * bflo(q.w) + bfhi(q.w) * bfhi(q.w);
          float sk = bflo(k.x) * bflo(k.x) + bfhi(k.x) * bfhi(k.x) + bflo(k.y) * bflo(k.y) + bfhi(k.y) * bfhi(k.y) + bflo(k.z) * bflo(k.z) + bfhi(k.z) * bfhi(k.z) + bflo(k.w) * bflo(k.w) + bfhi(k.w) * bfhi(k.w);
          sq += __shfl_xor(sq, 1); sq += __shfl_xor(sq, 2); sq += __shfl_xor(sq, 4); sk += __shfl_xor(sk, 1); sk += __shfl_xor(sk, 2); sk += __shfl_xor(sk, 4);
          mq = fmaxf(mq, sq); mk = fmaxf(mk, sk); }
      if (gw * 16 < T && (lane & 7) == 0) { const int b = (gw * 16) / SEQ, bh = b * 8 + (lane >> 3); atomicMax(KQ + 2 * bh, __float_as_uint(mq)); atomicMax(KQ + 2 * bh + 1, __float_as_uint(mk)); } }
    const bf16_t* P = (const bf16_t*)(A.ws + WS_R1); bf16_t* Y = (bf16_t*)(A.ws + WS_Y); const bf16_t* WP = (const bf16_t*)(A.ws + WS_W + W_P);
    const float* psc = A.pool_scale + (size_t)i * 512;
    const int r32 = lane & 31, hi = lane >> 5;
    for (int u = gw; u < 4096; u += NGW) {
        const int g = u & 3, rb = u >> 2, wnd = 2 << g;
        const int tg = 32 * rb + r32, t = tg & (SEQ - 1);
        const int cnt = (t + 1 < wnd) ? (t + 1) : wnd; const float inv = 1.0f / (float)cnt;
        const bf16_t* up = P + (size_t)tg * 1536 + 128 * g + 8 * hi;
        const bf16_t* wp = WP + (size_t)g * 16384 + (size_t)r32 * 128 + 8 * hi;
        f32x16 acc0 = {}, acc1 = {}, acc2 = {}, acc3 = {};
#pragma unroll 1
        for (int kk = 0; kk < 8; ++kk) {
            const u32x4 cur = *(const u32x4*)(up + 16 * kk);
            float s0 = bflo(cur.x), s1 = bfhi(cur.x), s2 = bflo(cur.y), s3 = bfhi(cur.y), s4 = bflo(cur.z), s5 = bfhi(cur.z), s6 = bflo(cur.w), s7 = bfhi(cur.w);
            const float c0 = s0, c1 = s1, c2 = s2, c3 = s3, c4 = s4, c5 = s5, c6 = s6, c7 = s7;
            for (int j = 1; j < cnt; ++j) { const u32x4 w = *(const u32x4*)(up - (size_t)j * 1536 + 16 * kk);
                s0 += bflo(w.x); s1 += bfhi(w.x); s2 += bflo(w.y); s3 += bfhi(w.y); s4 += bflo(w.z); s5 += bfhi(w.z); s6 += bflo(w.w); s7 += bfhi(w.w); }
            u32x4 o; o.x = pk2(s0 * inv - c0, s1 * inv - c1); o.y = pk2(s2 * inv - c2, s3 * inv - c3); o.z = pk2(s4 * inv - c4, s5 * inv - c5); o.w = pk2(s6 * inv - c6, s7 * inv - c7);
            const bf16x8 af = __builtin_bit_cast(bf16x8, o);
            acc0 = __builtin_amdgcn_mfma_f32_32x32x16_bf16(af, *(const bf16x8*)(wp + 16 * kk), acc0, 0, 0, 0);
            acc1 = __builtin_amdgcn_mfma_f32_32x32x16_bf16(af, *(const bf16x8*)(wp + 32 * 128 + 16 * kk), acc1, 0, 0, 0);
            acc2 = __builtin_amdgcn_mfma_f32_32x32x16_bf16(af, *(const bf16x8*)(wp + 64 * 128 + 16 * kk), acc2, 0, 0, 0);
            acc3 = __builtin_amdgcn_mfma_f32_32x32x16_bf16(af, *(const bf16x8*)(wp + 96 * 128 + 16 * kk), acc3, 0, 0, 0);
        }
        bf16_t* yb = Y + (size_t)(32 * rb + 4 * hi) * DM + 128 * g + r32;
        const float sc0 = psc[128 * g + r32], sc1 = psc[128 * g + 32 + r32], sc2 = psc[128 * g + 64 + r32], sc3 = psc[128 * g + 96 + r32];
#pragma unroll
        for (int r = 0; r < 16; ++r) { bf16_t* yr = yb + (size_t)((r & 3) + 8 * (r >> 2)) * DM;
            yr[0] = (bf16_t)(pk2(acc0[r] * sc0, 0.f) & 0xffffu); yr[32] = (bf16_t)(pk2(acc1[r] * sc1, 0.f) & 0xffffu);
            yr[64] = (bf16_t)(pk2(acc2[r] * sc2, 0.f) & 0xffffu); yr[96] = (bf16_t)(pk2(acc3[r] * sc3, 0.f) & 0xffffu); }
    }
}

template <int DK, bool FOX>
__device__ __forceinline__ void attn_unit(LAS unsigned char* lds, const bf16_t* __restrict__ Qp, int ldq, const bf16_t* __restrict__ Kp, int ldk, const bf16_t* __restrict__ Kr,
                                          const bf16_t* __restrict__ VTp, const double* __restrict__ F, const float* __restrict__ CS, bf16_t* Yp, int q0, int tid_in, float acp_thr) {
    int tid = tid_in;
    constexpr int KSTR = DK * 2 + 16, VSTR = 144, KBYTES = 64 * KSTR, VBYTES = 64 * VSTR;
    constexpr int OFF_K = 0, OFF_V = 2 * KBYTES, OFF_FK = OFF_V + 3 * VBYTES, OFF_WS = OFF_FK + 512;
    constexpr int ND = DK / 16;
    asm volatile("" : "+v"(tid));
    const int lane = tid & 63, r32 = lane & 31, hi = lane >> 5, w = __builtin_amdgcn_readfirstlane(tid >> 6);
    const int wrow0 = q0 + 32 * w, trow = wrow0 + r32;
    bf16x8 qf[ND];
#pragma unroll
    for (int d0 = 0; d0 < ND; ++d0) qf[d0] = *(const bf16x8*)(Qp + (size_t)trow * ldq + 16 * d0 + 8 * hi);
    if (!FOX) {
        const u32x4 a = __builtin_bit_cast(u32x4, qf[ND - 2]), b = __builtin_bit_cast(u32x4, qf[ND - 1]);
        const float* cs = CS + (size_t)trow * 32 + 8 * hi;
        const f32x4 c0 = *(const f32x4*)cs, c1 = *(const f32x4*)(cs + 4), s0 = *(const f32x4*)(cs + 16), s1 = *(const f32x4*)(cs + 20);
        const float x1[8] = {bflo(a.x), bfhi(a.x), bflo(a.y), bfhi(a.y), bflo(a.z), bfhi(a.z), bflo(a.w), bfhi(a.w)};
        const float x2[8] = {bflo(b.x), bfhi(b.x), bflo(b.y), bfhi(b.y), bflo(b.z), bfhi(b.z), bflo(b.w), bfhi(b.w)};
        const float cc[8] = {c0.x, c0.y, c0.z, c0.w, c1.x, c1.y, c1.z, c1.w}, sn[8] = {s0.x, s0.y, s0.z, s0.w, s1.x, s1.y, s1.z, s1.w};
        u32x4 oa, ob;
        oa.x = pk2(x1[0] * cc[0] - x2[0] * sn[0], x1[1] * cc[1] - x2[1] * sn[1]); oa.y = pk2(x1[2] * cc[2] - x2[2] * sn[2], x1[3] * cc[3] - x2[3] * sn[3]);
        oa.z = pk2(x1[4] * cc[4] - x2[4] * sn[4], x1[5] * cc[5] - x2[5] * sn[5]); oa.w = pk2(x1[6] * cc[6] - x2[6] * sn[6], x1[7] * cc[7] - x2[7] * sn[7]);
        ob.x = pk2(x2[0] * cc[0] + x1[0] * sn[0], x2[1] * cc[1] + x1[1] * sn[1]); ob.y = pk2(x2[2] * cc[2] + x1[2] * sn[2], x2[3] * cc[3] + x1[3] * sn[3]);
        ob.z = pk2(x2[4] * cc[4] + x1[4] * sn[4], x2[5] * cc[5] + x1[5] * sn[5]); ob.w = pk2(x2[6] * cc[6] + x1[6] * sn[6], x2[7] * cc[7] + x1[7] * sn[7]);
        qf[ND - 2] = __builtin_bit_cast(bf16x8, oa); qf[ND - 1] = __builtin_bit_cast(bf16x8, ob);
    }
    float fq2 = 0.f; double Fref = 0.0;
    if (FOX) { Fref = F[q0]; fq2 = (float)((F[trow] - Fref) * (double)LOG2E); }
    f32x16 o0 = {}, o1 = {}; float mrun = 0.f, lrun = 0.f;
    const int ktmax = (q0 >> 6) + 3, wkt = wrow0 >> 6;
    int kt_lo = 0;
    if (FOX) { const int nq = q0 >> 6; int cnt = 0;
#pragma unroll
        for (int j = 0; j < 4; ++j) { const int kk = lane + 64 * j; bool c = false; if (kk < nq) c = (Fref - F[64 * kk + 63]) * (double)LOG2E < -(double)acp_thr; cnt += __popcll(__ballot(c)); }
        kt_lo = __builtin_amdgcn_readfirstlane(cnt); }
    const int krow = tid >> 3, kch = tid & 7, rrow = (tid >> 2) & 63, rch = tid & 3;
    const unsigned koff = (unsigned)(krow * ldk + kch * 8) * 2u, voff = (unsigned)(krow * T + kch * 8) * 2u, roff = (unsigned)(rrow * 32 + rch * 8) * 2u;
    u32x4 kreg, vreg, rreg = {}; float fkreg = 0.f;
#define AT_GLOAD(kt) do { kreg = *(const u32x4*)((const char*)(Kp + (size_t)(kt) * 64 * ldk) + koff); vreg = *(const u32x4*)((const char*)(VTp + (size_t)(kt) * 64) + voff); \
        if (!FOX && tid < 256) rreg = *(const u32x4*)((const char*)(Kr + (size_t)(kt) * 64 * 32) + roff); \
        if (FOX && tid < 64) fkreg = -(float)((F[(kt) * 64 + tid] - Fref) * (double)LOG2E); } while (0)
#define AT_LWRITE(KT) do { *(LAS u32x4*)(lds + OFF_K + ((KT) & 1) * KBYTES + krow * KSTR + kch * 16) = kreg; *(LAS u32x4*)(lds + OFF_V + ((KT) % 3) * VBYTES + krow * VSTR + kch * 16) = vreg; \
        if (!FOX && tid < 256) *(LAS u32x4*)(lds + OFF_K + ((KT) & 1) * KBYTES + rrow * KSTR + 128 + rch * 16) = rreg; \
        if (FOX && tid < 64) *(LAS float*)(lds + OFF_FK + ((KT) & 1) * 256 + tid * 4) = fkreg; } while (0)
    LAS float* wsf = (LAS float*)(lds + OFF_WS) + w * 64;
    const int sig = (r32 & 0x13) | ((r32 & 4) << 1) | ((r32 & 8) >> 1);
#define AT_KFH(KT, H) _Pragma("unroll") for (int d0 = (H) * (ND / 2); d0 < ((H) + 1) * (ND / 2); ++d0) { kf[2 * d0] = *(const LAS bf16x8*)(kb_ + d0 * 32); kf[2 * d0 + 1] = *(const LAS bf16x8*)(kb_ + 32 * KSTR + d0 * 32); }
#define AT_KB(KT) const LAS unsigned char* kb_ = lds + OFF_K + ((KT) & 1) * KBYTES + sig * KSTR + hi * 16; bf16x8 kf[2 * ND];
#define AT_VF(SLOT) const LAS unsigned char* vb_ = lds + OFF_V + (SLOT) * VBYTES + r32 * VSTR + hi * 16; bf16x8 vf[8]; \
    _Pragma("unroll") for (int c = 0; c < 4; ++c) { vf[2 * c] = *(const LAS bf16x8*)(vb_ + 32 * c); vf[2 * c + 1] = *(const LAS bf16x8*)(vb_ + 32 * VSTR + 32 * c); }
#define AT_CINIT(SC0, SC1, KT) do { if (FOX) { const LAS float* fk = (const LAS float*)(lds + OFF_FK + ((KT) & 1) * 256) + 8 * hi; const float cq = fq2 - mrun; \
        const f32x4 a0 = *(const LAS f32x4*)(fk), a1 = *(const LAS f32x4*)(fk + 4), a2 = *(const LAS f32x4*)(fk + 16), a3 = *(const LAS f32x4*)(fk + 20); \
        const f32x4 b0 = *(const LAS f32x4*)(fk + 32), b1 = *(const LAS f32x4*)(fk + 36), b2 = *(const LAS f32x4*)(fk + 48), b3 = *(const LAS f32x4*)(fk + 52); \
        _Pragma("unroll") for (int e = 0; e < 4; ++e) { SC0[e] = a0[e] + cq; SC0[4 + e] = a1[e] + cq; SC0[8 + e] = a2[e] + cq; SC0[12 + e] = a3[e] + cq; \
                                                      SC1[e] = b0[e] + cq; SC1[4 + e] = b1[e] + cq; SC1[8 + e] = b2[e] + cq; SC1[12 + e] = b3[e] + cq; } \
    } else { SC0 = (f32x16){}; SC1 = (f32x16){}; } } while (0)
#define AT_QKH(SC0, SC1, H) do { _Pragma("unroll") for (int d0 = (H) * (ND / 2); d0 < ((H) + 1) * (ND / 2); ++d0) { \
        SC0 = __builtin_amdgcn_mfma_f32_32x32x16_bf16(kf[2 * d0], qf[d0], SC0, 0, 0, 0); SC1 = __builtin_amdgcn_mfma_f32_32x32x16_bf16(kf[2 * d0 + 1], qf[d0], SC1, 0, 0, 0); } } while (0)
#define AT_EXPH(SP) _Pragma("unroll") for (int r = 0; r < 16; ++r) { SP[r] = __builtin_amdgcn_exp2f(SP[r]); ls_ += SP[r]; }
#define AT_PACK(SP0, SP1) u32x4 p0, p1, p2, p3; \
    p0.x = pk2(SP0[0], SP0[1]); p0.y = pk2(SP0[2], SP0[3]); p0.z = pk2(SP0[4], SP0[5]); p0.w = pk2(SP0[6], SP0[7]); \
    p1.x = pk2(SP0[8], SP0[9]); p1.y = pk2(SP0[10], SP0[11]); p1.z = pk2(SP0[12], SP0[13]); p1.w = pk2(SP0[14], SP0[15]); \
    p2.x = pk2(SP1[0], SP1[1]); p2.y = pk2(SP1[2], SP1[3]); p2.z = pk2(SP1[4], SP1[5]); p2.w = pk2(SP1[6], SP1[7]); \
    p3.x = pk2(SP1[8], SP1[9]); p3.y = pk2(SP1[10], SP1[11]); p3.z = pk2(SP1[12], SP1[13]); p3.w = pk2(SP1[14], SP1[15]); \

#define AT_PV() do { const bf16x8 pa0 = __builtin_bit_cast(bf16x8, p0), pa1 = __builtin_bit_cast(bf16x8, p1), pa2 = __builtin_bit_cast(bf16x8, p2), pa3 = __builtin_bit_cast(bf16x8, p3); \
    o0 = __builtin_amdgcn_mfma_f32_32x32x16_bf16(pa0, vf[0], o0, 0, 0, 0); o1 = __builtin_amdgcn_mfma_f32_32x32x16_bf16(pa0, vf[1], o1, 0, 0, 0); \
    o0 = __builtin_amdgcn_mfma_f32_32x32x16_bf16(pa1, vf[2], o0, 0, 0, 0); o1 = __builtin_amdgcn_mfma_f32_32x32x16_bf16(pa1, vf[3], o1, 0, 0, 0); \
    o0 = __builtin_amdgcn_mfma_f32_32x32x16_bf16(pa2, vf[4], o0, 0, 0, 0); o1 = __builtin_amdgcn_mfma_f32_32x32x16_bf16(pa2, vf[5], o1, 0, 0, 0); \
    o0 = __builtin_amdgcn_mfma_f32_32x32x16_bf16(pa3, vf[6], o0, 0, 0, 0); o1 = __builtin_amdgcn_mfma_f32_32x32x16_bf16(pa3, vf[7], o1, 0, 0, 0); } while (0)
#define AT_REL(SC0, SC1) do { if (!FOX) { if (__any(mrun != 0.f)) { _Pragma("unroll") for (int r = 0; r < 16; ++r) { SC0[r] -= mrun; SC1[r] -= mrun; } } } } while (0)
#define AT_MAX(SC0, SC1) float mloc; { float ma = max3f(SC0[0], SC0[1], SC1[0]), mb = max3f(SC0[2], SC0[3], SC1[1]); ma = max3f(ma, SC1[2], SC1[3]); \
        _Pragma("unroll") for (int r = 4; r < 16; r += 4) { ma = max3f(ma, SC0[r], SC0[r + 1]); mb = max3f(mb, SC0[r + 2], SC0[r + 3]); ma = max3f(ma, SC1[r], SC1[r + 1]); mb = max3f(mb, SC1[r + 2], SC1[r + 3]); } \
        mloc = max3f(ma, mb, mb); mloc = max3f(mloc, __shfl_xor(mloc, 32), mloc); }
#define AT_DEC(SC0, SC1) do { if (__any(mloc > 12.0f)) { \
        const float dl = fmaxf(mloc, 0.f); mrun += dl; const float alpha = __builtin_amdgcn_exp2f(-dl); lrun *= alpha; \
        _Pragma("unroll") for (int r = 0; r < 16; ++r) { SC0[r] -= dl; SC1[r] -= dl; } \
        if (hi == 0) wsf[r32] = alpha; \
        LDS_FENCE(); \
        _Pragma("unroll") for (int r4 = 0; r4 < 4; ++r4) { const f32x4 al = *(const LAS f32x4*)(wsf + 8 * r4 + 4 * hi); \
            _Pragma("unroll") for (int e = 0; e < 4; ++e) { o0[4 * r4 + e] *= al[e]; o1[4 * r4 + e] *= al[e]; } } \
        LDS_FENCE(); } } while (0)
#define AT_FIRST(SC0, SC1, KT) do { AT_KB(KT); AT_KFH(KT, 0); AT_KFH(KT, 1); AT_CINIT(SC0, SC1, KT); __builtin_amdgcn_sched_barrier(0); AT_QKH(SC0, SC1, 0); AT_QKH(SC0, SC1, 1); \
        AT_REL(SC0, SC1); \
        if (FOX) { const int kv0 = 64 * (KT) + 8 * hi; \
            _Pragma("unroll") for (int r = 0; r < 16; ++r) { const int kv = kv0 + 16 * (r >> 3) + (r & 7); if (kv > trow) SC0[r] = -INFINITY; if (kv + 32 > trow) SC1[r] = -INFINITY; } } \
        AT_MAX(SC0, SC1); AT_DEC(SC0, SC1); } while (0)
#define AT_STEADY(SC0, SC1, SP0, SP1, KT) do { AT_KB(KT); AT_KFH(KT, 0); AT_CINIT(SC0, SC1, KT); float ls_ = 0.f; __builtin_amdgcn_sched_barrier(0); \
        AT_QKH(SC0, SC1, 0); AT_KFH(KT, 1); AT_EXPH(SP0); asm volatile("" : "+v"(SP0), "+v"(ls_)); AT_SGB_QK(); __builtin_amdgcn_sched_barrier(0); \
        AT_QKH(SC0, SC1, 1); AT_VF(((KT) + 1) % 3); AT_EXPH(SP1); lrun += ls_; AT_PACK(SP0, SP1); asm volatile("" : "+v"(p0), "+v"(p1), "+v"(p2), "+v"(p3), "+v"(lrun)); AT_SGB_QK(); __builtin_amdgcn_sched_barrier(0); \
        AT_REL(SC0, SC1); \
        AT_PV(); AT_MAX(SC0, SC1); AT_SGB_PV(); __builtin_amdgcn_sched_barrier(0); AT_DEC(SC0, SC1); } while (0)
#define AT_DRAIN(SP0, SP1) do { AT_VF(kt_lo % 3); float ls_ = 0.f; AT_EXPH(SP0); AT_EXPH(SP1); lrun += ls_; AT_PACK(SP0, SP1); AT_PV(); } while (0)
#ifndef AT_HINTS
#define AT_HINTS 1
#endif
#if AT_HINTS
#define AT_SGB_QK() do { _Pragma("unroll") for (int i_ = 0; i_ < ND; ++i_) { __builtin_amdgcn_sched_group_barrier(0x008, 1, 0); __builtin_amdgcn_sched_group_barrier(0x002, (DK == 96 ? 7 : 10), 0); } } while (0)
#define AT_SGB_PV() do { _Pragma("unroll") for (int i_ = 0; i_ < 8; ++i_) { __builtin_amdgcn_sched_group_barrier(0x008, 1, 0); __builtin_amdgcn_sched_group_barrier(0x002, 2, 0); } } while (0)
#else
#define AT_SGB_QK() do {} while (0)
#define AT_SGB_PV() do {} while (0)
#endif
#define AT_STEP_STEADY(SC0, SC1, SP0, SP1, KT) do { const int kt_ = (KT); if (kt_ > kt_lo) AT_GLOAD(kt_ - 1); AT_STEADY(SC0, SC1, SP0, SP1, kt_); if (kt_ > kt_lo) AT_LWRITE(kt_ - 1); LBAR(); } while (0)
    f32x16 sA0 = {}, sA1 = {}, sB0 = {}, sB1 = {};
    AT_GLOAD(ktmax); AT_LWRITE(ktmax); LBAR();
    for (int kt = ktmax; kt > wkt; --kt) { AT_GLOAD(kt - 1); AT_LWRITE(kt - 1); LBAR(); }
    { if (wkt > kt_lo) AT_GLOAD(wkt - 1); AT_FIRST(sA0, sA1, wkt); if (wkt > kt_lo) AT_LWRITE(wkt - 1); LBAR(); }
    int kt = wkt - 1;
    for (; kt >= kt_lo + 1; kt -= 2) {
        AT_STEP_STEADY(sB0, sB1, sA0, sA1, kt);
        AT_STEP_STEADY(sA0, sA1, sB0, sB1, kt - 1);
    }
    if (kt == kt_lo) { AT_STEP_STEADY(sB0, sB1, sA0, sA1, kt_lo); AT_DRAIN(sB0, sB1); LBAR(); }
    else { AT_DRAIN(sA0, sA1); LBAR(); }
#undef AT_GLOAD
#undef AT_LWRITE
#undef AT_KFH
#undef AT_KB
#undef AT_QKH
#undef AT_EXPH
#undef AT_PACK
#undef AT_REL
#undef AT_STEP_STEADY
#undef AT_VF
#undef AT_CINIT
#undef AT_QK
#undef AT_SOFT
#undef AT_PV
#undef AT_MAX
#undef AT_DEC
#undef AT_FIRST
#undef AT_STEADY
#undef AT_DRAIN
#undef AT_STEP
    lrun += __shfl_xor(lrun, 32);
    if (hi == 0) wsf[32 + r32] = lrun;
    LDS_FENCE();
#pragma unroll
    for (int r4 = 0; r4 < 4; ++r4) { const f32x4 lv = *(const LAS f32x4*)(wsf + 32 + 8 * r4 + 4 * hi);
#pragma unroll
        for (int e = 0; e < 4; ++e) { const float inv = 1.0f / lv[e]; const int row = wrow0 + e + 8 * r4 + 4 * hi;
            Yp[(size_t)row * DM + r32] = (bf16_t)(pk2(o0[4 * r4 + e] * inv, 0.f) & 0xffffu);
            Yp[(size_t)row * DM + 32 + r32] = (bf16_t)(pk2(o1[4 * r4 + e] * inv, 0.f) & 0xffffu); } }
    LDS_FENCE();
}

__global__ void __launch_bounds__(512, 2) fwd_mega(Args Akern) {
    extern __shared__ __attribute__((aligned(16))) unsigned char lds_raw[];
    LAS unsigned char* lds = (LAS unsigned char*)lds_raw;
    const int G = gridDim.x, bx = blockIdx.x;
    const int vcu = (G % 8 == 0) ? (bx % 8) * (G / 8) + bx / 8 : bx;
    const int NGW = G * 8;
    const int ph_lo = Akern.ph_lo, ph_hi = Akern.ph_hi, do_sync = Akern.do_sync;
#if defined(__HIP_DEVICE_COMPILE__)
    const __attribute__((address_space(4))) Args* Ak = (const __attribute__((address_space(4))) Args*)__builtin_amdgcn_kernarg_segment_ptr();
#else
    const Args* Ak = &Akern;
#endif

    for (int ph = ph_lo; ph < ph_hi; ++ph) {
        asm volatile("" : "+s"(Ak));
        const Args A = *Ak;
        int tid = threadIdx.x; asm volatile("" : "+v"(tid));
        const int lane = tid & 63, wave = __builtin_amdgcn_readfirstlane(tid >> 6), gw = vcu * 8 + wave;
        unsigned char* ws = A.ws;
        bf16_t* HN = (bf16_t*)(ws + WS_HN); bf16_t* Yb = (bf16_t*)(ws + WS_Y); bf16_t* R1 = (bf16_t*)(ws + WS_R1); bf16_t* VT = (bf16_t*)(ws + WS_VT); bf16_t* KN = (bf16_t*)(ws + WS_KN);
        float* LFb = (float*)(ws + WS_SM + SM_LF); const double* Fb = (const double*)(ws + WS_SM + SM_F); const float* CS = (const float*)(ws + WS_SM + SM_CS);
        const int l = ph / 12, k = ph % 12, i = l >> 1; const bool even = !(l & 1);
        bool did = true;
        if (ph == NPH - 1) {
            if (EN(0)) norm_phase<2>(A.out, A.norm_final, nullptr, A.out, nullptr, nullptr, nullptr, nullptr, gw, NGW, lane, tid);
        } else if (k == 0 || k == 9) {
            const int f = (k == 0) ? 0 : 1;
            if (EN(1)) if (k == 0) { convert_layer(A, l, (LAS float*)(lds + wave * 16384), gw, NGW, lane); if (l == 0) rope_table(A, gw, NGW, lane); }
            if (EN(0)) norm_phase<0>((l == 0 && k == 0) ? A.x : A.out, A.norm_ffn + (size_t)(l * 2 + f) * DM, HN, nullptr, nullptr, nullptr, nullptr, nullptr, gw, NGW, lane, tid);
        } else if (k == 1 || k == 10) {
            const int f = (k == 1) ? 0 : 1;
            pg8::Gemm g{HN, (const bf16_t*)(ws + WS_W + (f ? W_GU1 : W_GU0)), T, 2 * FF, DM}; pg8::StaticOrder S; S.init(T, 2 * FF, G, bx);
            pg8::EpiSwiglu E{R1, FF};
            if (EN(2)) pg8::gemm_phase<pg8::EpiSwiglu, pg8::StaticOrder, true, true>(lds, g, S, E);
        } else if (k == 2 || k == 11 || k == 8 || (k == 4 && !even)) {
            pg8::Gemm g; pg8::EpiResF32 E;
            if (k == 2 || k == 11) { const int f = (k == 2) ? 0 : 1; g = pg8::Gemm{R1, (const bf16_t*)(ws + WS_W + (f ? W_D1 : W_D0)), T, DM, FF};
                E = pg8::EpiResF32{(l == 0 && k == 2) ? A.x : A.out, A.out, DM, 0.5f}; }
            else if (k == 8) { g = pg8::Gemm{Yb, (const bf16_t*)(ws + WS_W + W_OUT), T, DM, DM}; E = pg8::EpiResF32{A.out, A.out, DM, 1.0f}; }
            else { g = pg8::Gemm{HN, (const bf16_t*)(ws + WS_W + W_MIN), T, 512, DM}; E = pg8::EpiResF32{nullptr, (float*)(ws + WS_Y), 512, 1.0f}; }
            pg8::StaticOrder S; S.init(g.M, g.N, G, bx);
            if (EN(3)) pg8::gemm_phase<pg8::EpiResF32, pg8::StaticOrder, true, true>(lds, g, S, E);
        } else if (k == 3) {
            if (even && bx == 0 && tid < 64) { ((unsigned*)(ws + WS_SM + SM_KQ))[tid] = 0u; if (tid == 0) *(unsigned*)(ws + WS_SM + SM_CTR) = 0u; }
            if (!EN(4)) {} else if (even) norm_phase<1>(A.out, A.norm_mix + (size_t)l * DM, HN, nullptr, A.ab_w_in + (size_t)i * DM * 2056, A.ab_b_forget + (size_t)i * 8, LFb, (LAS float*)lds, gw, NGW, lane, tid);
            else norm_phase<0>(A.out, A.norm_mix + (size_t)l * DM, HN, nullptr, nullptr, nullptr, nullptr, nullptr, gw, NGW, lane, tid);
        } else if ((k == 4 && even) || (k == 6 && !even)) {
            const int ng = even ? 2 : 3;
            for (int j = 0; j < ng; ++j) {
                pg8::Gemm g; pg8::EpiBf16S E;
                if (even) {
                    if (j == 0) { g = pg8::Gemm{HN, (const bf16_t*)(ws + WS_W + W_IN), T, 1536, DM}; E = pg8::EpiBf16S{R1, 1536, 512, 1024, 0.125f * LOG2E}; }
                    else { g = pg8::Gemm{(const bf16_t*)(ws + WS_W + W_V), HN, 512, T, DM}; E = pg8::EpiBf16S{VT, T, 0, 0, 1.0f}; }
                } else {
                    if (j == 0) { g = pg8::Gemm{(const bf16_t*)(ws + WS_R1 + R_CQN), (const bf16_t*)(ws + WS_W + W_QB), T, 1536, 256}; E = pg8::EpiBf16S{R1, 1536, 0, 1536, 0.10206207261596577f * LOG2E}; }
                    else if (j == 1) { g = pg8::Gemm{(const bf16_t*)(ws + WS_R1 + R_CKVN), (const bf16_t*)(ws + WS_W + W_KNW), T, 1024, 256}; E = pg8::EpiBf16S{KN, 1024, 0, 0, 1.0f}; }
                    else { g = pg8::Gemm{(const bf16_t*)(ws + WS_W + W_VVW), (const bf16_t*)(ws + WS_R1 + R_CKVN), 1024, T, 256}; E = pg8::EpiBf16S{VT, T, 0, 0, 1.0f}; }
                }
                pg8::StaticOrder S; S.init(g.M, g.N, G, bx);
                if (EN(5)) pg8::gemm_phase<pg8::EpiBf16S, pg8::StaticOrder, true, true>(lds, g, S, E);
                __syncthreads();
            }
        } else if (k == 5) {
            if (!EN(6)) {} else if (even) scan_pool(A, i, lds, gw, NGW, lane, tid, wave);
            else mla_small(A, i, gw, NGW, lane);
        } else if (k == 7) {
            if (even) {
                unsigned* ctr = (unsigned*)(ws + WS_SM + SM_CTR); const unsigned* KQ = (const unsigned*)(ws + WS_SM + SM_KQ);
                LAS unsigned* qslot = (LAS unsigned*)(lds + 65536);
                for (;;) {
                    if (tid == 0) qslot[0] = atomicAdd(ctr, 1u);
                    LBAR(); const unsigned u = qslot[0]; LBAR();
                    if (u >= 1024u) break;
                    const int qb = 63 - (int)(u >> 4), bh = (int)(u & 15u), b = bh >> 3, h = bh & 7;
                    const float thr = 2.0f * sqrtf(__uint_as_float(KQ[2 * bh]) * __uint_as_float(KQ[2 * bh + 1])) + 48.0f;
                    if (EN(7)) attn_unit<64, true>(lds, R1 + (size_t)(b * SEQ) * 1536 + 512 + 64 * h, 1536, R1 + (size_t)(b * SEQ) * 1536 + 1024 + 64 * h, 1536, nullptr,
                                        VT + (size_t)(64 * h) * T + (size_t)b * SEQ, Fb + (size_t)bh * SEQ, nullptr, Yb + (size_t)(b * SEQ) * DM + 512 + 64 * h, qb * 256, tid, thr);
                }
            } else {
                for (int p = vcu; p < 32 * 32; p += G) { const int bh = p >> 5, s = p & 31, b = bh >> 4, h = bh & 15;
                    for (int z = 0; z < 2; ++z) { const int qb = z ? s : 63 - s;
                        if (EN(8)) attn_unit<96, false>(lds, R1 + (size_t)(b * SEQ) * 1536 + 96 * h, 1536, KN + (size_t)(b * SEQ) * 1024 + 64 * h, 1024, (const bf16_t*)(ws + WS_R1 + R_KR) + (size_t)(b * SEQ) * 32,
                                             VT + (size_t)(64 * h) * T + (size_t)b * SEQ, nullptr, CS + (size_t)(b * SEQ) * 32, Yb + (size_t)(b * SEQ) * DM + 64 * h, qb * 256, tid, 0.f); } }
            }
        } else did = false;
        if (did && ph + 1 < ph_hi) { if (do_sync) cg::this_grid().sync(); }
    }
}

extern "C" void kernel_launch(void* const* d_in, const int* in_sizes, int n_in, void* d_out, int out_size, void* d_ws, size_t ws_size, hipStream_t stream) {
    static int grid = 0;
    if (grid == 0) {
        if (n_in != 19 || out_size != T * DM || ws_size < WS_END) { fprintf(stderr, "kernel_launch: unexpected shapes (n_in %d out %d ws %zu)\n", n_in, out_size, ws_size); grid = -1; return; }
        int dev = 0, cus = 0, per_cu = 0;
        hipGetDevice(&dev); hipDeviceGetAttribute(&cus, hipDeviceAttributeMultiprocessorCount, dev);
        if (hipFuncSetAttribute((const void*)fwd_mega, hipFuncAttributeMaxDynamicSharedMemorySize, LDS_BYTES) != hipSuccess) { fprintf(stderr, "kernel_launch: hipFuncSetAttribute failed\n"); grid = -1; return; }
        if (hipOccupancyMaxActiveBlocksPerMultiprocessor(&per_cu, (const void*)fwd_mega, 512, LDS_BYTES) != hipSuccess || per_cu < 1) { fprintf(stderr, "kernel_launch: occupancy query says %d\n", per_cu); per_cu = 1; }
        (void)hipGetLastError();
        grid = cus * 1;
    }
    if (grid < 0) return;
    Args a{};
    a.x = (const float*)d_in[0]; a.pos = (const int*)d_in[1]; a.norm_ffn = (const float*)d_in[2]; a.norm_mix = (const float*)d_in[3]; a.norm_final = (const float*)d_in[4];
    a.w_gate = (const float*)d_in[5]; a.w_up = (const float*)d_in[6]; a.w_down = (const float*)d_in[7];
    a.ab_w_in = (const float*)d_in[8]; a.ab_b_forget = (const float*)d_in[9]; a.pool_w = (const float*)d_in[10]; a.pool_scale = (const float*)d_in[11]; a.ab_w_out = (const float*)d_in[12];
    a.mla_w_in = (const float*)d_in[13]; a.mla_q_norm = (const float*)d_in[14]; a.mla_kv_norm = (const float*)d_in[15]; a.mla_w_q_b = (const float*)d_in[16]; a.mla_w_kv_b = (const float*)d_in[17]; a.mla_w_out = (const float*)d_in[18];
    a.out = (float*)d_out; a.ws = (unsigned char*)d_ws; a.pad = 0;
#if ONE_LAUNCH
    a.ph_lo = 0; a.ph_hi = NPH; a.do_sync = 1;
    void* args[] = {&a};
    hipError_t e = hipLaunchCooperativeKernel((const void*)fwd_mega, dim3(grid), dim3(512), args, LDS_BYTES, stream);
    if (e != hipSuccess) fprintf(stderr, "cooperative launch failed: %s (grid %d)\n", hipGetErrorString(e), grid);
#else
    for (int ph = 0; ph < NPH; ++ph) {
        const int l = ph / 12, k = ph % 12; if (ph != NPH - 1 && k == 6 && !(l & 1)) continue;
        a.ph_lo = ph; a.ph_hi = ph + 1; a.do_sync = 0;
        hipLaunchKernelGGL(fwd_mega, dim3(grid), dim3(512), LDS_BYTES, stream, a);
    }
#endif
}
```

```cpp
#include <hip/hip_runtime.h>
#include <hip/hip_cooperative_groups.h>
#include <cstdio>
#include <cstdint>
namespace cg = cooperative_groups;
#ifndef ONE_LAUNCH
#define ONE_LAUNCH 1
#endif
namespace pg8 {
#define PG8_LAS __attribute__((address_space(3)))
typedef unsigned short bf16_t;
typedef short bf16x8 __attribute__((ext_vector_type(8)));
typedef float f32x4 __attribute__((ext_vector_type(4)));
typedef unsigned u32x4 __attribute__((ext_vector_type(4)));
constexpr int BM = 256, BK = 64, HALF = 128, HTB = HALF * BK * 2  , STAGE_BYTES = 8 * HTB, NXCD = 8, WGM = 8;

__host__ __device__ __forceinline__ int lds_byte(int r, int c) { const int st = (r >> 4) * 2 + (c >> 5), rr = r & 15, cc = c & 31, ob = rr * 64 + cc * 2; return st * 1024 + (ob ^ (((ob >> 9) & 1) << 5)); }
__host__ __device__ __forceinline__ void stage_rc(int b, int& R, int& C) { const int st = b / 1024, sb = b % 1024, swz = sb ^ (((sb >> 9) & 1) << 5); R = (st >> 1) * 16 + swz / 64; C = (st & 1) * 32 + (swz % 64) / 2; }
__host__ __device__ __forceinline__ int perm32(int rho) { const int n = rho >> 4, i = rho & 15; return 8 * (i >> 2) + 4 * n + (i & 3); }

struct Unit { int pm, pn; };
struct Gemm { const bf16_t* A; const bf16_t* Bt; int M, N, K; int a_blk = 0; };

struct StaticOrder {
    int nM, nN, nwg, G, c;
    __host__ __device__ void init(int M, int N, int G_, int c_) { nM = M / BM; nN = N / BM; nwg = nM * nN; G = G_; c = c_; }
    __host__ __device__ bool next(int i, Unit& u) const {
        const long L = (long)i * G + c; if (L >= nwg) return false;
        int wgid = (int)L; { const int q = nwg / NXCD, r = nwg % NXCD, xcd = wgid % NXCD, off = wgid / NXCD; wgid = (xcd < r ? xcd * (q + 1) : r * (q + 1) + (xcd - r) * q) + off; }
        const int nig = WGM * nN, gid = wgid / nig, fm = gid * WGM, gsz = (nM - fm) < WGM ? (nM - fm) : WGM;
        u.pm = fm + ((wgid % nig) % gsz); u.pn = (wgid % nig) / gsz; return true;
    }
    __device__ __forceinline__ void a_ready(const Unit&) const {}
    __device__ __forceinline__ void done(const Unit&) const {}
};
__device__ __forceinline__ unsigned cvt_pk_bf16(float lo, float hi) { unsigned r; asm volatile("v_cvt_pk_bf16_f32 %0, %1, %2" : "=v"(r) : "v"(lo), "v"(hi)); return r; }
typedef float f32x2 __attribute__((ext_vector_type(2)));
struct EpiBf16S {
    static constexpr bool PERM = true, AFTER_DRAIN = false;
    bf16_t* O; int ldc; int sc_lo, sc_hi; float scale;
    __device__ __forceinline__ void operator()(const f32x4 (&acc)[2][2][4][2], const Unit& u, int wr, int wc, int fr, int fq) const {
        const int row0 = u.pm * BM + wr * 64 + fr; const int colt = u.pn * BM;
        const float sc = (colt >= sc_lo && colt < sc_hi) ? scale : 1.f;
        const int col0 = colt + wc * 32 + 8 * fq;
#pragma unroll
        for (int ai = 0; ai < 2; ++ai)
#pragma unroll
            for (int m = 0; m < 4; ++m) { bf16_t* rowp = O + (size_t)(row0 + ai * HALF + m * 16) * ldc + col0;
#pragma unroll
                for (int bj = 0; bj < 2; ++bj) { const f32x4 v0 = acc[ai][bj][m][0] * sc, v1 = acc[ai][bj][m][1] * sc;
                    u32x4 w; w.x = cvt_pk_bf16(v0[0], v0[1]); w.y = cvt_pk_bf16(v0[2], v0[3]); w.z = cvt_pk_bf16(v1[0], v1[1]); w.w = cvt_pk_bf16(v1[2], v1[3]);
                    *(u32x4*)(rowp + bj * HALF) = w; } }
    }
};
struct EpiSwiglu {
    static constexpr bool PERM = true, AFTER_DRAIN = false;
    bf16_t* O; int ldc;
    __device__ __forceinline__ void operator()(const f32x4 (&acc)[2][2][4][2], const Unit& u, int wr, int wc, int fr, int fq) const {
        const int row0 = u.pm * BM + wr * 64 + fr; const int col0 = u.pn * HALF + wc * 32 + 8 * fq;
#pragma unroll
        for (int ai = 0; ai < 2; ++ai)
#pragma unroll
            for (int m = 0; m < 4; ++m) { bf16_t* rowp = O + (((size_t)u.pm * (ldc / BK) + (col0 >> 6)) * BM + (wr * 64 + fr + ai * HALF + m * 16)) * BK + (col0 & 63);
                float a[8];
#pragma unroll
                for (int n = 0; n < 2; ++n)
#pragma unroll
                    for (int e = 0; e < 4; ++e) { const float g = acc[ai][0][m][n][e], up = acc[ai][1][m][n][e];
                        const float sg = g * __builtin_amdgcn_rcpf(1.0f + __builtin_amdgcn_exp2f(-1.4426950408889634f * g)); a[n * 4 + e] = sg * up; }
                u32x4 w; w.x = cvt_pk_bf16(a[0], a[1]); w.y = cvt_pk_bf16(a[2], a[3]); w.z = cvt_pk_bf16(a[4], a[5]); w.w = cvt_pk_bf16(a[6], a[7]);
                *(u32x4*)rowp = w; }
    }
};
struct EpiResF32 {
    static constexpr bool PERM = false, AFTER_DRAIN = false;
    const float* base; float* out; int ldc; float alpha;
    __device__ __forceinline__ void operator()(const f32x4 (&acc)[2][2][4][2], const Unit& u, int wr, int wc, int fr, int fq) const {
        const int col0 = u.pn * BM + wc * 32 + 4 * fq;
#pragma unroll
        for (int ai = 0; ai < 2; ++ai)
#pragma unroll
            for (int m = 0; m < 4; ++m) { const int r = u.pm * BM + ai * HALF + wr * 64 + m * 16 + fr; const size_t off = (size_t)r * ldc + col0;
#pragma unroll
                for (int bj = 0; bj < 2; ++bj)
#pragma unroll
                    for (int n = 0; n < 2; ++n) { f32x4 o = acc[ai][bj][m][n] * alpha;
                        if (base) o = o + *(const f32x4*)(base + off + bj * HALF + n * 16);
                        *(f32x4*)(out + off + bj * HALF + n * 16) = o; } }
    }
};

struct EpiMlaIn {
    static constexpr bool PERM = false, AFTER_DRAIN = true;
    bf16_t* cqn; bf16_t* ckvn; bf16_t* kr; const float* qn; const float* kvn; const float* cs;
    __device__ __forceinline__ void fused(f32x4 (&acc)[2][2][4][2], const Unit& u, int wr, int wc, int fr, int fq, PG8_LAS unsigned char* lds, int wid, int lane) const {
        typedef unsigned u32x2_t __attribute__((ext_vector_type(2)));
        PG8_LAS float* P = (PG8_LAS float*)lds;
        const bool isq = (u.pn == 0);
#pragma unroll
        for (int ai = 0; ai < 2; ++ai)
#pragma unroll
            for (int m = 0; m < 4; ++m) { float s = 0.f;
#pragma unroll
                for (int n = 0; n < 2; ++n) { const f32x4 x = acc[ai][0][m][n]; s += (x[0] * x[0] + x[1] * x[1]) + (x[2] * x[2] + x[3] * x[3]); }
                if (isq) {
#pragma unroll
                    for (int n = 0; n < 2; ++n) { const f32x4 x = acc[ai][1][m][n]; s += (x[0] * x[0] + x[1] * x[1]) + (x[2] * x[2] + x[3] * x[3]); } }
                s += __shfl_xor(s, 16); s += __shfl_xor(s, 32);
                if (fq == 0) P[(ai * HALF + wr * 64 + m * 16 + fr) * 4 + wc] = s; }
        asm volatile("s_waitcnt lgkmcnt(0)" ::: "memory"); __builtin_amdgcn_s_barrier(); asm volatile("" ::: "memory");
#pragma unroll
        for (int ai = 0; ai < 2; ++ai)
#pragma unroll
            for (int m = 0; m < 4; ++m) { const int rl = ai * HALF + wr * 64 + m * 16 + fr; const size_t r = (size_t)u.pm * BM + rl;
                const f32x4 p4 = *(const PG8_LAS f32x4*)(P + rl * 4); const float ss = (p4[0] + p4[1]) + (p4[2] + p4[3]);
                if (isq) { const float rstd = 1.0f / sqrtf(ss * (1.0f / 256.0f) + 1e-6f);
#pragma unroll
                    for (int bj = 0; bj < 2; ++bj)
#pragma unroll
                        for (int n = 0; n < 2; ++n) { const int c = bj * HALF + wc * 32 + n * 16 + 4 * fq; const f32x4 g4 = *(const f32x4*)(qn + c); const f32x4 y = acc[ai][bj][m][n] * rstd * g4;
                            u32x2_t w; w.x = cvt_pk_bf16(y[0], y[1]); w.y = cvt_pk_bf16(y[2], y[3]); *(u32x2_t*)(cqn + r * 256 + c) = w; }
                } else { const float rstd = 1.0f / sqrtf(ss * (1.0f / 128.0f) + 1e-6f);
#pragma unroll
                    for (int n = 0; n < 2; ++n) { const int c = wc * 32 + n * 16 + 4 * fq; const f32x4 g4 = *(const f32x4*)(kvn + c); const f32x4 y = acc[ai][0][m][n] * rstd * g4;
                        u32x2_t w; w.x = cvt_pk_bf16(y[0], y[1]); w.y = cvt_pk_bf16(y[2], y[3]); *(u32x2_t*)(ckvn + r * 256 + c) = w;
                        u32x2_t z; z.x = 0u; z.y = 0u; *(u32x2_t*)(ckvn + r * 256 + HALF + c) = z; }
                    if (wc == 0) { const int i0 = 4 * fq; const f32x4 x1 = acc[ai][1][m][0], x2 = acc[ai][1][m][1];
                        const f32x4 c4 = *(const f32x4*)(cs + r * 32 + i0), s4 = *(const f32x4*)(cs + r * 32 + 16 + i0);
                        const f32x4 o1 = x1 * c4 - x2 * s4, o2 = x2 * c4 + x1 * s4;
                        u32x2_t w1, w2; w1.x = cvt_pk_bf16(o1[0], o1[1]); w1.y = cvt_pk_bf16(o1[2], o1[3]); w2.x = cvt_pk_bf16(o2[0], o2[1]); w2.y = cvt_pk_bf16(o2[2], o2[3]);
                        *(u32x2_t*)(kr + r * 32 + i0) = w1; *(u32x2_t*)(kr + r * 32 + 16 + i0) = w2; } } }
        asm volatile("s_waitcnt lgkmcnt(0)" ::: "memory"); __builtin_amdgcn_s_barrier(); asm volatile("" ::: "memory");
    }
};

template <class Epi, class Sched, bool ALIGN_EPI = false, bool SP2 = false>
__device__ __forceinline__ void gemm_phase(PG8_LAS unsigned char* lds, const Gemm g, const Sched& S, const Epi& E) {
    int tid_l = threadIdx.x; asm volatile("" : "+v"(tid_l));
    const int tid = tid_l, wid = __builtin_amdgcn_readfirstlane(tid >> 6), lane = tid & 63, wr = wid >> 2, wc = wid & 3, fr = lane & 15, fq = lane >> 4;
    const int K = g.K, nt = K / BK;
    unsigned voffA[2], voffB[2];
#pragma unroll
    for (int i = 0; i < 2; ++i) { int R, C; stage_rc(tid * 16 + i * 8192, R, C); const int Rb = Epi::PERM ? ((R & ~31) + perm32(R & 31)) : R;
        voffA[i] = g.a_blk ? (unsigned)(R * BK + C) * 2u : (unsigned)(R * K + C) * 2u; voffB[i] = (unsigned)(Rb * K + C) * 2u; }
    const size_t kstepB = (size_t)(BK * 2);
    const size_t hstepB = (size_t)HALF * K * 2;
    const size_t tstepB = 2 * hstepB;
    const size_t kstepA = g.a_blk ? (size_t)(BM * BK * 2) : kstepB, hstepA = g.a_blk ? (size_t)(HALF * BK * 2) : hstepB, tstepA = g.a_blk ? (size_t)(K / BK) * (BM * BK * 2) : tstepB;
    const unsigned ldsw = (unsigned)wid * 1024u;
    const int aoff = lds_byte(wr * 64 + fr, fq * 8), boff = lds_byte(wc * 32 + fr, fq * 8);
#define PG8_SA(b, h) (((b) * 2 + (h)) * HTB)
#define PG8_SB(b, h) ((4 + (b) * 2 + (h)) * HTB)
#define PG8_STAGE(bufoff, gbase, voff) do { _Pragma("unroll") for (int _i = 0; _i < 2; ++_i) \
        __builtin_amdgcn_global_load_lds((const unsigned*)((const char*)(gbase) + (voff)[_i]), (PG8_LAS unsigned*)(lds + (bufoff) + ldsw + _i * 8192), 16, 0, 0); } while (0)
#define PG8_LDA(dst, b, h) do { _Pragma("unroll") for (int m = 0; m < 4; ++m) _Pragma("unroll") for (int k = 0; k < 2; ++k) dst[m][k] = *(const PG8_LAS bf16x8*)(lds + PG8_SA(b, h) + aoff + m * 2048 + k * 1024); } while (0)
#define PG8_LDB(dst, b, h) do { _Pragma("unroll") for (int n = 0; n < 2; ++n) _Pragma("unroll") for (int k = 0; k < 2; ++k) dst[n][k] = *(const PG8_LAS bf16x8*)(lds + PG8_SB(b, h) + boff + n * 2048 + k * 1024); } while (0)
#define PG8_MMA(ai, bj, At, Bt) do { __builtin_amdgcn_s_setprio(1); _Pragma("unroll") for (int m = 0; m < 4; ++m) _Pragma("unroll") for (int n = 0; n < 2; ++n) _Pragma("unroll") for (int k = 0; k < 2; ++k) \
        acc[ai][bj][m][n] = __builtin_amdgcn_mfma_f32_16x16x32_bf16(Bt[n][k], At[m][k], acc[ai][bj][m][n], 0, 0, 0); __builtin_amdgcn_s_setprio(0); } while (0)
#define PG8_WAIT_V(n) asm volatile("s_waitcnt vmcnt(" #n ")" ::: "memory")
#define PG8_WAIT_L(n) asm volatile("s_waitcnt lgkmcnt(" #n ")" ::: "memory")
#define PG8_BAR __builtin_amdgcn_s_barrier()
#define PG8_SCHED __builtin_amdgcn_sched_barrier(0)
    Unit cur, nxt; int ui = 0;
    if (!S.next(0, cur)) return;
    f32x4 acc[2][2][4][2];
#pragma unroll
    for (int a = 0; a < 2; ++a)
#pragma unroll
        for (int b = 0; b < 2; ++b)
#pragma unroll
            for (int m = 0; m < 4; ++m)
#pragma unroll
                for (int n = 0; n < 2; ++n) acc[a][b][m][n] = (f32x4){0.f, 0.f, 0.f, 0.f};
    bf16x8 At[4][2], B0[2][2], B1[2][2];
    const char* cA = (const char*)g.A + (size_t)cur.pm * tstepA; const char* cB = (const char*)g.Bt + (size_t)cur.pn * tstepB;
    S.a_ready(cur);
    if constexpr (SP2) {
        PG8_STAGE(PG8_SB(0, 0), cB, voffB); PG8_STAGE(PG8_SB(0, 1), cB + hstepB, voffB); PG8_STAGE(PG8_SA(0, 0), cA, voffA); PG8_STAGE(PG8_SA(0, 1), cA + hstepA, voffA);
        if (wr == 1) PG8_BAR;
        PG8_WAIT_V(2); PG8_BAR;
        PG8_STAGE(PG8_SB(1, 0), cB + kstepB, voffB); PG8_STAGE(PG8_SA(1, 0), cA + kstepA, voffA); PG8_STAGE(PG8_SB(1, 1), cB + hstepB + kstepB, voffB);
        PG8_WAIT_V(6); PG8_BAR;
    } else {
        PG8_STAGE(PG8_SB(0, 0), cB, voffB); PG8_STAGE(PG8_SA(0, 0), cA, voffA); PG8_STAGE(PG8_SB(0, 1), cB + hstepB, voffB); PG8_STAGE(PG8_SA(0, 1), cA + hstepA, voffA);
        if (wr == 1) PG8_BAR;
        PG8_WAIT_V(4); PG8_BAR;
        PG8_STAGE(PG8_SB(1, 0), cB + kstepB, voffB); PG8_STAGE(PG8_SA(1, 0), cA + kstepA, voffA); PG8_STAGE(PG8_SB(1, 1), cB + hstepB + kstepB, voffB);
        PG8_WAIT_V(6); PG8_BAR;
    }
    for (;;) {
        const bool has_next = S.next(ui + 1, nxt);
        const char* nA = has_next ? (const char*)g.A + (size_t)nxt.pm * tstepA : cA; const char* nB = has_next ? (const char*)g.Bt + (size_t)nxt.pn * tstepB : cB;
        for (int t = 0; t < nt; t += 2) {
            const bool last = (t == nt - 2);
            const char* a1 = cA + (size_t)(t + 1) * kstepA;
            const char* a2 = last ? nA : cA + (size_t)(t + 2) * kstepA; const char* b2 = last ? nB : cB + (size_t)(t + 2) * kstepB;
            const char* a3 = a2 + kstepA; const char* b3 = b2 + kstepB;
            if (last && has_next) S.a_ready(nxt);
            if constexpr (SP2) {
            PG8_LDB(B0, 0, 0); PG8_LDB(B1, 0, 1); PG8_SCHED; PG8_LDA(At, 0, 0); PG8_STAGE(PG8_SA(1, 1), a1 + hstepA, voffA);
            PG8_WAIT_V(8); PG8_WAIT_L(0); PG8_BAR; PG8_MMA(0, 0, At, B0); PG8_MMA(0, 1, At, B1); PG8_BAR; PG8_SCHED;
            PG8_LDA(At, 0, 1); PG8_STAGE(PG8_SB(0, 0), b2, voffB); PG8_STAGE(PG8_SB(0, 1), b2 + hstepB, voffB); PG8_STAGE(PG8_SA(0, 0), a2, voffA);
            PG8_WAIT_V(8); PG8_WAIT_L(0); PG8_BAR; PG8_MMA(1, 0, At, B0); PG8_MMA(1, 1, At, B1); PG8_BAR; PG8_SCHED;
            PG8_LDB(B0, 1, 0); PG8_LDB(B1, 1, 1); PG8_SCHED; PG8_LDA(At, 1, 0); PG8_STAGE(PG8_SA(0, 1), a2 + hstepA, voffA);
            PG8_WAIT_V(8); PG8_WAIT_L(0); PG8_BAR; PG8_MMA(0, 0, At, B0); PG8_MMA(0, 1, At, B1); PG8_BAR; PG8_SCHED;
            PG8_LDA(At, 1, 1); PG8_STAGE(PG8_SB(1, 0), b3, voffB); PG8_STAGE(PG8_SB(1, 1), b3 + hstepB, voffB); PG8_STAGE(PG8_SA(1, 0), a3, voffA);
            PG8_WAIT_V(8); PG8_WAIT_L(0); PG8_BAR; PG8_MMA(1, 0, At, B0); PG8_MMA(1, 1, At, B1); PG8_BAR; PG8_SCHED;
            } else {
            PG8_LDB(B0, 0, 0); PG8_SCHED; PG8_LDA(At, 0, 0); PG8_STAGE(PG8_SA(1, 1), a1 + hstepA, voffA);
            PG8_WAIT_L(8); PG8_BAR; PG8_WAIT_L(0); PG8_MMA(0, 0, At, B0); PG8_BAR; PG8_SCHED;
            PG8_LDB(B1, 0, 1); PG8_STAGE(PG8_SB(0, 0), b2, voffB);
            PG8_BAR; PG8_WAIT_L(0); PG8_MMA(0, 1, At, B1); PG8_BAR;
            PG8_LDA(At, 0, 1); PG8_STAGE(PG8_SA(0, 0), a2, voffA);
            PG8_BAR; PG8_WAIT_L(0); PG8_MMA(1, 0, At, B0); PG8_BAR; PG8_SCHED;
            PG8_STAGE(PG8_SB(0, 1), b2 + hstepB, voffB);
            PG8_WAIT_V(6); PG8_BAR; PG8_MMA(1, 1, At, B1); PG8_BAR;
            PG8_LDB(B0, 1, 0); PG8_SCHED; PG8_LDA(At, 1, 0); PG8_STAGE(PG8_SA(0, 1), a2 + hstepA, voffA);
            PG8_WAIT_L(8); PG8_BAR; PG8_WAIT_L(0); PG8_MMA(0, 0, At, B0); PG8_BAR; PG8_SCHED;
            PG8_LDB(B1, 1, 1); PG8_STAGE(PG8_SB(1, 0), b3, voffB);
            PG8_BAR; PG8_WAIT_L(0); PG8_MMA(0, 1, At, B1); PG8_BAR;
            PG8_LDA(At, 1, 1); PG8_STAGE(PG8_SA(1, 0), a3, voffA);
            PG8_BAR; PG8_WAIT_L(0); PG8_MMA(1, 0, At, B0); PG8_BAR; PG8_SCHED;
            PG8_STAGE(PG8_SB(1, 1), b3 + hstepB, voffB);
            PG8_WAIT_V(6); PG8_BAR; PG8_MMA(1, 1, At, B1); PG8_BAR;
            }
        }
        if constexpr (ALIGN_EPI) { if (wr == 0) PG8_BAR; }
        if constexpr (!Epi::AFTER_DRAIN) { E(acc, cur, wr, wc, fr, fq); S.done(cur); }
        if (!has_next) break;
#pragma unroll
        for (int a = 0; a < 2; ++a)
#pragma unroll
            for (int b = 0; b < 2; ++b)
#pragma unroll
                for (int m = 0; m < 4; ++m)
#pragma unroll
                    for (int n = 0; n < 2; ++n) acc[a][b][m][n] = (f32x4){0.f, 0.f, 0.f, 0.f};
        cur = nxt; cA = nA; cB = nB; ++ui;
        if constexpr (ALIGN_EPI) { if (wr == 1) PG8_BAR; }
    }
    PG8_WAIT_V(0);
    if constexpr (!ALIGN_EPI) { if (wr == 0) PG8_BAR; }
    PG8_BAR;
    if constexpr (Epi::AFTER_DRAIN) { E.fused(acc, cur, wr, wc, fr, fq, lds, wid, lane); S.done(cur); }
#undef PG8_SA
#undef PG8_SB
#undef PG8_STAGE
#undef PG8_LDA
#undef PG8_LDB
#undef PG8_MMA
#undef PG8_WAIT_V
#undef PG8_WAIT_L
#undef PG8_BAR
#undef PG8_SCHED
}
}
#define LAS __attribute__((address_space(3)))
typedef unsigned short bf16_t;
typedef short bf16x8 __attribute__((ext_vector_type(8)));
typedef float f32x4 __attribute__((ext_vector_type(4)));
typedef float f32x16 __attribute__((ext_vector_type(16)));
typedef unsigned u32x4 __attribute__((ext_vector_type(4)));
typedef unsigned u32x2 __attribute__((ext_vector_type(2)));

constexpr int SEQ = 16384, NB = 2, T = NB * SEQ, DM = 1024, FF = 2816;
constexpr size_t MiB = 1u << 20;
constexpr size_t WS_W = 0, WS_HN = 48 * MiB, WS_Y = 112 * MiB, WS_R1 = 176 * MiB, WS_VT = 352 * MiB, WS_KN = 416 * MiB, WS_SM = 480 * MiB, WS_END = 488 * MiB;
constexpr size_t W_GU0 = 0, W_D0 = 11 * MiB, W_GU1 = 17 * MiB, W_D1 = 28 * MiB, W_MIX = 34 * MiB;
constexpr size_t W_IN = W_MIX, W_V = W_MIX + 3 * MiB, W_OUT = W_MIX + 4 * MiB, W_P = W_MIX + 6 * MiB;
constexpr size_t W_MIN = W_MIX, W_QB = W_MIX + 1 * MiB, W_KNW = W_MIX + 2 * MiB, W_VVW = W_MIX + 2 * MiB + 512 * 1024;
constexpr size_t R_Q = 0, R_CQN = 96 * MiB, R_CKVN = 112 * MiB, R_KR = 128 * MiB;
constexpr size_t SM_LF = 0, SM_F = 1 * MiB, SM_KQ = 3 * MiB, SM_CTR = 3 * MiB + 1024, SM_BAR = 3 * MiB + 65536, SM_KQP = 3 * MiB + 131072, SM_CS = 4 * MiB;
constexpr int LDS_BYTES = 147456;
constexpr float LOG2E = 1.4426950408889634f;
constexpr int NPH = 49;
#ifndef PROBE_KMASK
#define PROBE_KMASK 0
#endif
#ifndef EN_MASK
#define EN_MASK 0xFFFF
#endif
#define EN(b) ((EN_MASK >> (b)) & 1)

struct Args {
    const float* x; const int* pos; const float* norm_ffn; const float* norm_mix; const float* norm_final;
    const float* w_gate; const float* w_up; const float* w_down;
    const float* ab_w_in; const float* ab_b_forget; const float* pool_w; const float* pool_scale; const float* ab_w_out;
    const float* mla_w_in; const float* mla_q_norm; const float* mla_kv_norm; const float* mla_w_q_b; const float* mla_w_kv_b; const float* mla_w_out;
    float* out; unsigned char* ws; int ph_lo, ph_hi; int do_sync, pad;
};

__device__ __forceinline__ float wave_sum(float v) {
#pragma unroll
    for (int o = 1; o < 64; o <<= 1) v += __shfl_xor(v, o);
    return v;
}
typedef float f32x2_t __attribute__((ext_vector_type(2))); typedef __bf16 bf16x2_t __attribute__((ext_vector_type(2)));
__device__ __forceinline__ unsigned pk2(float lo, float hi) { f32x2_t v = {lo, hi}; bf16x2_t b = __builtin_convertvector(v, bf16x2_t); return __builtin_bit_cast(unsigned, b); }
__device__ __forceinline__ float bflo(unsigned w) { return __uint_as_float(w << 16); }
__device__ __forceinline__ float bfhi(unsigned w) { return __uint_as_float(w & 0xffff0000u); }
__device__ __forceinline__ float max3f(float a, float b, float c) { float r; asm("v_max3_f32 %0, %1, %2, %3" : "=v"(r) : "v"(a), "v"(b), "v"(c)); return r; }
#define LDS_FENCE() asm volatile("s_waitcnt lgkmcnt(0)" ::: "memory")
#define LBAR() do { asm volatile("s_waitcnt lgkmcnt(0)" ::: "memory"); __builtin_amdgcn_s_barrier(); asm volatile("" ::: "memory"); } while (0)

__device__ __forceinline__ void transpose_item(const float* __restrict__ src, int ld, int k0, bf16_t* __restrict__ dst, int ldd, LAS float* scr, int lane) {
#pragma unroll 8
    for (int i = 0; i < 32; ++i) { const int kk = 2 * i + (lane >> 5); scr[kk * 33 + (lane & 31)] = src[(size_t)(k0 + kk) * ld + (lane & 31)]; }
    LDS_FENCE();
    const int c = lane & 7;
#pragma unroll
    for (int j = 0; j < 4; ++j) { const int n = (lane >> 3) + 8 * j; const LAS float* s = scr + (8 * c) * 33 + n;
        u32x4 o; o.x = pk2(s[0 * 33], s[1 * 33]); o.y = pk2(s[2 * 33], s[3 * 33]); o.z = pk2(s[4 * 33], s[5 * 33]); o.w = pk2(s[6 * 33], s[7 * 33]);
        *(u32x4*)(dst + (size_t)n * ldd + k0 + 8 * c) = o; }
    LDS_FENCE();
}

__device__ __forceinline__ void convert_layer(const Args& A, int l, LAS float* scr, int gw, int NGW, int lane) {
    const int i = l >> 1; const bool even = !(l & 1);
    constexpr int NF = 1408;
    unsigned char* W = A.ws + WS_W;
    const int total = 6 * NF + (even ? (768 + 256 + 512 + 32) : (208 + 192 + 128 + 512));
    for (int it = gw; it < total; it += NGW) {
        int r = it;
        if (r < 6 * NF) {
            const int f = r / (3 * NF), r2 = r % (3 * NF), kind = r2 / NF, q = r2 % NF;
            const size_t wo = (size_t)(l * 2 + f) * DM * FF;
            if (kind < 2) { const int kb = q / 88, nb = q % 88; const float* src = (kind == 0 ? A.w_gate : A.w_up) + wo + 32 * nb;
                bf16_t* dst = (bf16_t*)(W + (f ? W_GU1 : W_GU0)) + (size_t)((nb >> 2) * 256 + (nb & 3) * 32 + kind * 128) * DM;
                transpose_item(src, FF, 64 * kb, dst, DM, scr, lane); }
            else { const int kb = q / 32, nb = q % 32; const float* src = A.w_down + wo + 32 * nb;
                bf16_t* dst = (bf16_t*)(W + (f ? W_D1 : W_D0)) + (size_t)(32 * nb) * FF;
                transpose_item(src, DM, 64 * kb, dst, FF, scr, lane); }
            continue;
        }
        r -= 6 * NF;
        if (even) {
            const float* win = A.ab_w_in + (size_t)i * DM * 2056;
            if (r < 768) { const int kb = r / 48, nb = r % 48; transpose_item(win + 32 * nb, 2056, 64 * kb, (bf16_t*)(W + W_IN) + (size_t)(32 * nb) * DM, DM, scr, lane); continue; } r -= 768;
            if (r < 256) { const int kb = r / 16, nb = r % 16; transpose_item(win + 1536 + 32 * nb, 2056, 64 * kb, (bf16_t*)(W + W_V) + (size_t)(32 * nb) * DM, DM, scr, lane); continue; } r -= 256;
            if (r < 512) { const int kb = r / 32, nb = r % 32; transpose_item(A.ab_w_out + (size_t)i * DM * DM + 32 * nb, DM, 64 * kb, (bf16_t*)(W + W_OUT) + (size_t)(32 * nb) * DM, DM, scr, lane); continue; } r -= 512;
            { const int g = r >> 3, kb = (r & 7) >> 2, nb = r & 3; transpose_item(A.pool_w + (size_t)(i * 4 + g) * 16384 + 32 * nb, 128, 64 * kb, (bf16_t*)(W + W_P) + (size_t)g * 16384 + (size_t)(32 * nb) * 128, 128, scr, lane); }
        } else {
            if (r < 208) { const int kb = r / 13, nb = r % 13; transpose_item(A.mla_w_in + (size_t)i * DM * 416 + 32 * nb, 416, 64 * kb, (bf16_t*)(W + W_MIN) + (size_t)(32 * nb) * DM, DM, scr, lane); continue; } r -= 208;
            if (r < 192) { const int kb = r / 48, nb = r % 48; transpose_item(A.mla_w_q_b + (size_t)i * 256 * 1536 + 32 * nb, 1536, 64 * kb, (bf16_t*)(W + W_QB) + (size_t)(32 * nb) * 256, 256, scr, lane); continue; } r -= 192;
            if (r < 128) { const int kb = r / 64, nb = r % 64; const int col0 = 32 * nb, head = col0 >> 7, within = col0 & 127;
                bf16_t* dst = (within < 64) ? (bf16_t*)(W + W_KNW) + (size_t)(64 * head + within) * 256 : (bf16_t*)(W + W_VVW) + (size_t)(64 * head + within - 64) * 256;
                transpose_item(A.mla_w_kv_b + (size_t)i * 128 * 2048 + col0, 2048, 64 * kb, dst, 256, scr, lane); continue; } r -= 128;
            { const int kb = r / 32, nb = r % 32; transpose_item(A.mla_w_out + (size_t)i * DM * DM + 32 * nb, DM, 64 * kb, (bf16_t*)(W + W_OUT) + (size_t)(32 * nb) * DM, DM, scr, lane); }
        }
    }
    if (!even) {
        const int gt = gw * 64 + lane, NT_ = NGW * 64;
        for (int idx = gt; idx < 2048 * 16; idx += NT_) { const int row = idx >> 4, c = idx & 15;
            *(u32x4*)((bf16_t*)(W + W_KNW) + (size_t)row * 256 + 128 + 8 * c) = (u32x4){0u, 0u, 0u, 0u}; }
    }
}

__constant__ float ROPE_INVF[16] = {(float)1.0, (float)0.5623413251903491, (float)0.31622776601683794, (float)0.1778279410038923, (float)0.1, (float)0.05623413251903491, (float)0.031622776601683794, (float)0.01778279410038923,
    (float)0.01, (float)0.005623413251903491, (float)0.0031622776601683794, (float)0.001778279410038923, (float)0.001, (float)0.0005623413251903491, (float)0.00031622776601683794, (float)0.0001778279410038923};
__device__ __forceinline__ void rope_table(const Args& A, int gw, int NGW, int lane) {
    float* CS = (float*)(A.ws + WS_SM + SM_CS);
    const int gt = gw * 64 + lane, NT_ = NGW * 64;
    for (int idx = gt; idx < T * 16; idx += NT_) {
        const int t = idx >> 4, j = idx & 15;
        const float invf = ROPE_INVF[j];
        const float ang = (float)A.pos[t] * invf;
        const double rev = (double)ang * 0.15915494309189535;
        const float fr = (float)(rev - __builtin_rint(rev));
        CS[(size_t)t * 32 + j] = __builtin_amdgcn_cosf(fr);
        CS[(size_t)t * 32 + 16 + j] = __builtin_amdgcn_sinf(fr);
    }
}

template <int MODE>
__device__ __forceinline__ void norm_phase(const float* src, const float* __restrict__ g, bf16_t* dst16, float* dst32,
                                           const float* __restrict__ wfsrc, const float* __restrict__ bforget, float* LF, LAS float* wfT, int gw, int NGW, int lane, int tid) {
    if (MODE == 1) {
        for (int idx = tid; idx < 8192; idx += 512) { const int k = idx >> 3, f = idx & 7; wfT[f * 1024 + k] = wfsrc[(size_t)k * 2056 + 2048 + f]; }
        LDS_FENCE(); __syncthreads();
    }
    f32x4 gv[4];
#pragma unroll
    for (int j = 0; j < 4; ++j) gv[j] = *(const f32x4*)(g + 4 * lane + 256 * j);
    constexpr int NR = (MODE == 1) ? 2 : 4;
    for (int mb = gw * NR; mb < T; mb += NGW * NR) {
        f32x4 v[NR][4]; float ss[NR];
#pragma unroll
        for (int r = 0; r < NR; ++r) { const f32x4* xr = (const f32x4*)(src + (size_t)(mb + r) * DM) + lane;
#pragma unroll
            for (int j = 0; j < 4; ++j) v[r][j] = xr[64 * j]; }
#pragma unroll
        for (int r = 0; r < NR; ++r) { float a = 0.f;
#pragma unroll
            for (int j = 0; j < 4; ++j) a += (v[r][j].x * v[r][j].x + v[r][j].y * v[r][j].y) + (v[r][j].z * v[r][j].z + v[r][j].w * v[r][j].w);
            ss[r] = a; }
#pragma unroll
        for (int o = 1; o < 64; o <<= 1) {
#pragma unroll
            for (int r = 0; r < NR; ++r) ss[r] += __shfl_xor(ss[r], o); }
#pragma unroll
        for (int r = 0; r < NR; ++r) {
            const int m = mb + r;
            const float rstd = 1.0f / sqrtf(ss[r] * (1.0f / DM) + 1e-6f);
#pragma unroll
            for (int j = 0; j < 4; ++j) v[r][j] = v[r][j] * rstd * gv[j];
            if (MODE == 2) {
                f32x4* o = (f32x4*)(dst32 + (size_t)m * DM) + lane;
#pragma unroll
                for (int j = 0; j < 4; ++j) o[64 * j] = v[r][j];
            } else {
                u32x2* o = (u32x2*)(dst16 + (size_t)m * DM) + lane;
#pragma unroll
                for (int j = 0; j < 4; ++j) { u32x2 w; w.x = pk2(v[r][j].x, v[r][j].y); w.y = pk2(v[r][j].z, v[r][j].w); o[64 * j] = w; }
            }
            if (MODE == 1) {
                float mine = 0.f;
#pragma unroll
                for (int f = 0; f < 8; ++f) { float a = 0.f;
#pragma unroll
                    for (int j = 0; j < 4; ++j) { const f32x4 w = *(const LAS f32x4*)(wfT + f * 1024 + 4 * lane + 256 * j); a += (v[r][j].x * w.x + v[r][j].y * w.y) + (v[r][j].z * w.z + v[r][j].w * w.w); }
                    a = wave_sum(a); mine = (lane == f) ? a : mine; }
                if (lane < 8) { const float xx = mine + bforget[lane];
                    const float ax = fabsf(xx); const float sp = __builtin_amdgcn_logf(1.0f + __builtin_amdgcn_exp2f(-ax * LOG2E)) * 0.6931471805599453f;
                    const float ls = (xx < 0.f ? xx : 0.f) - sp;
                    const int b = m / SEQ, t = m % SEQ; LF[(size_t)(b * 8 + lane) * SEQ + t] = ls; }
            }
        }
    }
}

__device__ __forceinline__ void mla_small(const Args& A, int i, int gw, int NGW, int lane) {
    const float* PROJ = (const float*)(A.ws + WS_Y);
    bf16_t* CQN = (bf16_t*)(A.ws + WS_R1 + R_CQN); bf16_t* CKVN = (bf16_t*)(A.ws + WS_R1 + R_CKVN); bf16_t* KR = (bf16_t*)(A.ws + WS_R1 + R_KR);
    const float* CS = (const float*)(A.ws + WS_SM + SM_CS);
    const f32x4 gq = *(const f32x4*)(A.mla_q_norm + (size_t)i * 256 + 4 * lane);
    const f32x4 gk = *(const f32x4*)(A.mla_kv_norm + (size_t)i * 128 + 4 * (lane & 31));
    for (int mb = gw * 4; mb < T; mb += NGW * 4) {
        f32x4 av[4], bv[4];
#pragma unroll
        for (int r = 0; r < 4; ++r) { const float* row = PROJ + (size_t)(mb + r) * 512; av[r] = *(const f32x4*)(row + 4 * lane); bv[r] = (f32x4){0.f, 0.f, 0.f, 0.f}; if (lane < 40) bv[r] = *(const f32x4*)(row + 256 + 4 * lane); }
#pragma unroll
        for (int r = 0; r < 4; ++r) {
            const int m = mb + r; const f32x4 a = av[r], b = bv[r];
            const float sq = wave_sum((a.x * a.x + a.y * a.y) + (a.z * a.z + a.w * a.w));
            const float skv = wave_sum(lane < 32 ? (b.x * b.x + b.y * b.y) + (b.z * b.z + b.w * b.w) : 0.f);
            const float rq = 1.0f / sqrtf(sq * (1.0f / 256.0f) + 1e-6f), rkv = 1.0f / sqrtf(skv * (1.0f / 128.0f) + 1e-6f);
            { const f32x4 y = a * rq * gq; u32x2 w; w.x = pk2(y.x, y.y); w.y = pk2(y.z, y.w); *(u32x2*)(CQN + (size_t)m * 256 + 4 * lane) = w; }
            { const f32x4 y = b * rkv * gk; u32x2 w; w.x = pk2(y.x, y.y); w.y = pk2(y.z, y.w); if (lane >= 32) { w.x = 0u; w.y = 0u; }
              *(u32x2*)(CKVN + (size_t)m * 256 + 4 * lane) = w; }
            f32x4 p; p.x = __shfl_xor(b.x, 4); p.y = __shfl_xor(b.y, 4); p.z = __shfl_xor(b.z, 4); p.w = __shfl_xor(b.w, 4);
            if (lane >= 32 && lane < 40) { const int i0 = 4 * ((lane - 32) & 3);
                const f32x4 c = *(const f32x4*)(CS + (size_t)m * 32 + i0), sn = *(const f32x4*)(CS + (size_t)m * 32 + 16 + i0);
                f32x4 o; if (lane < 36) o = b * c - p * sn; else o = b * c + p * sn;
                u32x2 w; w.x = pk2(o.x, o.y); w.y = pk2(o.z, o.w); *(u32x2*)(KR + (size_t)m * 32 + 4 * (lane - 32)) = w; }
        }
    }
}

template <int WND>
__device__ __forceinline__ void pool_unit(const bf16_t* __restrict__ P, bf16_t* __restrict__ Y, const bf16_t* __restrict__ WP, const float* __restrict__ psc, int g, int rb, int r32, int hi) {
    const int tg = 32 * rb + r32, t = tg & (SEQ - 1);
    const int cnt = (t + 1 < WND) ? (t + 1) : WND; const float inv = 1.0f / (float)cnt;
    const bf16_t* up = P + (size_t)tg * 1536 + 128 * g + 8 * hi;
    const bf16_t* wp = WP + (size_t)g * 16384 + (size_t)r32 * 128 + 8 * hi;
    f32x16 acc0 = {}, acc1 = {}, acc2 = {}, acc3 = {};
#pragma unroll 2
    for (int kk = 0; kk < 8; ++kk) {
        u32x4 w[WND];
#pragma unroll
        for (int j = 0; j < WND; ++j) { w[j] = (u32x4){0u, 0u, 0u, 0u}; if (j < cnt) w[j] = *(const u32x4*)(up - (size_t)j * 1536 + 16 * kk); }
        float s0 = 0.f, s1 = 0.f, s2 = 0.f, s3 = 0.f, s4 = 0.f, s5 = 0.f, s6 = 0.f, s7 = 0.f;
#pragma unroll
        for (int j = 0; j < WND; ++j) { s0 += bflo(w[j].x); s1 += bfhi(w[j].x); s2 += bflo(w[j].y); s3 += bfhi(w[j].y); s4 += bflo(w[j].z); s5 += bfhi(w[j].z); s6 += bflo(w[j].w); s7 += bfhi(w[j].w); }
        u32x4 o; o.x = pk2(s0 * inv - bflo(w[0].x), s1 * inv - bfhi(w[0].x)); o.y = pk2(s2 * inv - bflo(w[0].y), s3 * inv - bfhi(w[0].y));
        o.z = pk2(s4 * inv - bflo(w[0].z), s5 * inv - bfhi(w[0].z)); o.w = pk2(s6 * inv - bflo(w[0].w), s7 * inv - bfhi(w[0].w));
        const bf16x8 af = __builtin_bit_cast(bf16x8, o);
        acc0 = __builtin_amdgcn_mfma_f32_32x32x16_bf16(af, *(const bf16x8*)(wp + 16 * kk), acc0, 0, 0, 0);
        acc1 = __builtin_amdgcn_mfma_f32_32x32x16_bf16(af, *(const bf16x8*)(wp + 32 * 128 + 16 * kk), acc1, 0, 0, 0);
        acc2 = __builtin_amdgcn_mfma_f32_32x32x16_bf16(af, *(const bf16x8*)(wp + 64 * 128 + 16 * kk), acc2, 0, 0, 0);
        acc3 = __builtin_amdgcn_mfma_f32_32x32x16_bf16(af, *(const bf16x8*)(wp + 96 * 128 + 16 * kk), acc3, 0, 0, 0);
    }
    bf16_t* yb = Y + (size_t)(32 * rb + 4 * hi) * DM + 128 * g + r32;
    const float sc0 = psc[128 * g + r32], sc1 = psc[128 * g + 32 + r32], sc2 = psc[128 * g + 64 + r32], sc3 = psc[128 * g + 96 + r32];
#pragma unroll
    for (int r = 0; r < 16; ++r) { bf16_t* yr = yb + (size_t)((r & 3) + 8 * (r >> 2)) * DM;
        yr[0] = (bf16_t)(pk2(acc0[r] * sc0, 0.f) & 0xffffu); yr[32] = (bf16_t)(pk2(acc1[r] * sc1, 0.f) & 0xffffu);
        yr[64] = (bf16_t)(pk2(acc2[r] * sc2, 0.f) & 0xffffu); yr[96] = (bf16_t)(pk2(acc3[r] * sc3, 0.f) & 0xffffu); }
}

__device__ __forceinline__ void scan_pool(const Args& A, int i, LAS unsigned char* lds, int gw, int NGW, int lane, int tid, int wave) {
    for (int item = blockIdx.x; item < 256; item += gridDim.x) {
        const int bh = item >> 4, seg = item & 15;
        const float* lf = (const float*)(A.ws + WS_SM + SM_LF) + (size_t)bh * SEQ; double* Fo = (double*)(A.ws + WS_SM + SM_F) + (size_t)bh * SEQ + seg * 1024;
        LAS double* wt = (LAS double*)lds;
        double pre = 0.0;
        { f32x4 pv[8];
#pragma unroll
          for (int q = 0; q < 8; ++q) { const int c = q * 512 + tid; pv[q] = (f32x4){0.f, 0.f, 0.f, 0.f}; if (c < seg * 256) pv[q] = *(const f32x4*)(lf + 4 * c); }
#pragma unroll
          for (int q = 0; q < 8; ++q) pre += ((double)pv[q].x + (double)pv[q].y) + ((double)pv[q].z + (double)pv[q].w); }
#pragma unroll
        for (int o = 1; o < 64; o <<= 1) pre += __shfl_xor(pre, o);
        const float v0 = lf[seg * 1024 + 2 * tid], v1 = lf[seg * 1024 + 2 * tid + 1];
        const double tot = (double)v0 + (double)v1; double incl = tot;
#pragma unroll
        for (int o = 1; o < 64; o <<= 1) { const double n = __shfl_up(incl, o); if (lane >= o) incl += n; }
        if (lane == 63) { wt[wave] = pre; wt[8 + wave] = incl; }
        LDS_FENCE(); __syncthreads();
        double run = incl - tot;
#pragma unroll
        for (int j = 0; j < 8; ++j) { run += wt[j]; if (j < wave) run += wt[8 + j]; }
        const double o0 = run + (double)v0, o1 = o0 + (double)v1;
        Fo[2 * tid] = o0; Fo[2 * tid + 1] = o1;
        __syncthreads();
    }
    { const bf16_t* Pq = (const bf16_t*)(A.ws + WS_R1); float* KQP = (float*)(A.ws + WS_SM + SM_KQP);
      float mq0 = 0.f, mk0 = 0.f, mq1 = 0.f, mk1 = 0.f;
      for (int mb16 = gw * 16; mb16 < T; mb16 += NGW * 16) {
      float mq = 0.f, mk = 0.f;
#pragma unroll 4
      for (int j = 0; j < 16; ++j) { const size_t m = (size_t)mb16 + j;
          const u32x4 q = *(const u32x4*)(Pq + m * 1536 + 512 + 8 * lane), k = *(const u32x4*)(Pq + m * 1536 + 1024 + 8 * lane);
          float sq = bflo(q.x) * bflo(q.x) + bfhi(q.x) * bfhi(q.x) + bflo(q.y) * bflo(q.y) + bfhi(q.y) * bfhi(q.y) + bflo(q.z) * bflo(q.z) + bfhi(q.z) * bfhi(q.z) + bflo(q.w) * bflo(q.w) + bfhi(q.w) * bfhi(q.w);
          float sk = bflo(k.x) * bflo(k.x) + bfhi(k.x) * bfhi(k.x) + bflo(k.y) * bflo(k.y) + bfhi(k.y) * bfhi(k.y) + bflo(k.z) * bflo(k.z) + bfhi(k.z) * bfhi(k.z) + bflo(k.w) * bflo(k.w) + bfhi(k.w) * bfhi(k.w);
          sq += __shfl_xor(sq, 1); sq += __shfl_xor(sq, 2); sq += __shfl_xor(sq, 4); sk += __shfl_xor(sk, 1); sk += __shfl_xor(sk, 2); sk += __shfl_xor(sk, 4);
          mq = fmaxf(mq, sq); mk = fmaxf(mk, sk); }
      if (mb16 < SEQ) { mq0 = fmaxf(mq0, mq); mk0 = fmaxf(mk0, mk); } else { mq1 = fmaxf(mq1, mq); mk1 = fmaxf(mk1, mk); } }
      LAS float* wm = (LAS float*)lds + 64;
      if ((lane & 7) == 0) { const int h = lane >> 3; wm[wave * 32 + h * 2] = mq0; wm[wave * 32 + h * 2 + 1] = mk0; wm[wave * 32 + 16 + h * 2] = mq1; wm[wave * 32 + 16 + h * 2 + 1] = mk1; }
      LDS_FENCE(); __syncthreads();
      if (tid < 32) { float v = wm[tid];
#pragma unroll
          for (int wv = 1; wv < 8; ++wv) v = fmaxf(v, wm[wv * 32 + tid]);
          KQP[(size_t)blockIdx.x * 32 + tid] = v; }
      __syncthreads(); }
    const bf16_t* P = (const bf16_t*)(A.ws + WS_R1); bf16_t* Y = (bf16_t*)(A.ws + WS_Y); const bf16_t* WP = (const bf16_t*)(A.ws + WS_W + W_P);
    const float* psc = A.pool_scale + (size_t)i * 512;
    const int r32 = lane & 31, hi = lane >> 5;
    for (int u = gw; u < 4096; u += NGW) {
        const int g = (u + (u >> 11)) & 3, rb = u >> 2;
        if (g == 0) pool_unit<2>(P, Y, WP, psc, g, rb, r32, hi);
        else if (g == 1) pool_unit<4>(P, Y, WP, psc, g, rb, r32, hi);
        else if (g == 2) pool_unit<8>(P, Y, WP, psc, g, rb, r32, hi);
        else pool_unit<16>(P, Y, WP, psc, g, rb, r32, hi);
    }
}

template <int DK, bool FOX, bool TRACK>
__device__ __forceinline__ bool attn_unit(LAS unsigned char* lds, const bf16_t* __restrict__ Qp, int ldq, const bf16_t* __restrict__ Kp, int ldk, const bf16_t* __restrict__ Kr,
                                          const bf16_t* __restrict__ VTp, const double* __restrict__ F, const float* __restrict__ CS, bf16_t* Yp, int q0, int tid_in, float acp_thr) {
    int tid = tid_in;
    constexpr int KSTR = DK * 2 + 16, VSTR = 144, KBYTES = 64 * KSTR, VBYTES = 64 * VSTR;
    constexpr int OFF_K = 0, OFF_V = 3 * KBYTES, OFF_FK = OFF_V + 4 * VBYTES, OFF_WS = OFF_FK + 768;
    constexpr int ND = DK / 16;
    asm volatile("" : "+v"(tid));
    const int lane = tid & 63, r32 = lane & 31, hi = lane >> 5, w = __builtin_amdgcn_readfirstlane(tid >> 6);
    const int wrow0 = q0 + 32 * w, trow = wrow0 + r32;
    bf16x8 qf[ND];
#pragma unroll
    for (int d0 = 0; d0 < ND; ++d0) qf[d0] = *(const bf16x8*)(Qp + (size_t)trow * ldq + 16 * d0 + 8 * hi);
    if (!FOX) {
        const u32x4 a = __builtin_bit_cast(u32x4, qf[ND - 2]), b = __builtin_bit_cast(u32x4, qf[ND - 1]);
        const float* cs = CS + (size_t)trow * 32 + 8 * hi;
        const f32x4 c0 = *(const f32x4*)cs, c1 = *(const f32x4*)(cs + 4), s0 = *(const f32x4*)(cs + 16), s1 = *(const f32x4*)(cs + 20);
        const float x1[8] = {bflo(a.x), bfhi(a.x), bflo(a.y), bfhi(a.y), bflo(a.z), bfhi(a.z), bflo(a.w), bfhi(a.w)};
        const float x2[8] = {bflo(b.x), bfhi(b.x), bflo(b.y), bfhi(b.y), bflo(b.z), bfhi(b.z), bflo(b.w), bfhi(b.w)};
        const float cc[8] = {c0.x, c0.y, c0.z, c0.w, c1.x, c1.y, c1.z, c1.w}, sn[8] = {s0.x, s0.y, s0.z, s0.w, s1.x, s1.y, s1.z, s1.w};
        u32x4 oa, ob;
        oa.x = pk2(x1[0] * cc[0] - x2[0] * sn[0], x1[1] * cc[1] - x2[1] * sn[1]); oa.y = pk2(x1[2] * cc[2] - x2[2] * sn[2], x1[3] * cc[3] - x2[3] * sn[3]);
        oa.z = pk2(x1[4] * cc[4] - x2[4] * sn[4], x1[5] * cc[5] - x2[5] * sn[5]); oa.w = pk2(x1[6] * cc[6] - x2[6] * sn[6], x1[7] * cc[7] - x2[7] * sn[7]);
        ob.x = pk2(x2[0] * cc[0] + x1[0] * sn[0], x2[1] * cc[1] + x1[1] * sn[1]); ob.y = pk2(x2[2] * cc[2] + x1[2] * sn[2], x2[3] * cc[3] + x1[3] * sn[3]);
        ob.z = pk2(x2[4] * cc[4] + x1[4] * sn[4], x2[5] * cc[5] + x1[5] * sn[5]); ob.w = pk2(x2[6] * cc[6] + x1[6] * sn[6], x2[7] * cc[7] + x1[7] * sn[7]);
        qf[ND - 2] = __builtin_bit_cast(bf16x8, oa); qf[ND - 1] = __builtin_bit_cast(bf16x8, ob);
    }
    float fq2 = 0.f; double Fref = 0.0;
    if (FOX) { Fref = F[q0]; fq2 = (float)((F[trow] - Fref) * (double)LOG2E); }
    f32x16 o0 = {}, o1 = {}; float mrun = 0.f, lrun = 0.f;
    const int ktmax = (q0 >> 6) + 3, wkt = wrow0 >> 6;
    int kt_lo = 0;
    if (FOX) { const int nq = q0 >> 6; int cnt = 0;
#pragma unroll
        for (int j = 0; j < 4; ++j) { const int kk = lane + 64 * j; bool c = false; if (kk < nq) c = (Fref - F[64 * kk + 63]) * (double)LOG2E < -(double)acp_thr; cnt += __popcll(__ballot(c)); }
        kt_lo = __builtin_amdgcn_readfirstlane(cnt); }
    const int krow = tid >> 3, kch = tid & 7, rrow = (tid >> 2) & 63, rch = tid & 3;
    const unsigned koff = (unsigned)(krow * ldk + kch * 8) * 2u, voff = (unsigned)(krow * T + kch * 8) * 2u, roff = (unsigned)(rrow * 32 + rch * 8) * 2u;
    u32x4 kreg, vreg, rreg = {}, kregB, vregB, rregB = {}; float fkreg = 0.f, fkregB = 0.f;
#define AT_GLOAD_S(kt, KR, VR, RR, FK) do { KR = *(const u32x4*)((const char*)(Kp + (size_t)(kt) * 64 * ldk) + koff); VR = *(const u32x4*)((const char*)(VTp + (size_t)(kt) * 64) + voff); \
        if (!FOX && tid < 256) RR = *(const u32x4*)((const char*)(Kr + (size_t)(kt) * 64 * 32) + roff); \
        if (FOX && tid < 64) FK = -(float)((F[(kt) * 64 + tid] - Fref) * (double)LOG2E); } while (0)
#define AT_LWRITE_S(KT, KR, VR, RR, FK) do { *(LAS u32x4*)(lds + OFF_K + ((KT) % 3) * KBYTES + krow * KSTR + kch * 16) = KR; *(LAS u32x4*)(lds + OFF_V + ((KT) & 3) * VBYTES + krow * VSTR + kch * 16) = VR; \
        if (!FOX && tid < 256) *(LAS u32x4*)(lds + OFF_K + ((KT) % 3) * KBYTES + rrow * KSTR + 128 + rch * 16) = RR; \
        if (FOX && tid < 64) *(LAS float*)(lds + OFF_FK + ((KT) % 3) * 256 + tid * 4) = FK; } while (0)
#define AT_GLOAD(kt) AT_GLOAD_S(kt, kreg, vreg, rreg, fkreg)
#define AT_LWRITE(KT) AT_LWRITE_S(KT, kreg, vreg, rreg, fkreg)
#define AT_STAGE(KT) do { if ((KT) - 2 >= kt_lo) AT_LWRITE((KT) - 2); if ((KT) - 3 >= kt_lo) AT_GLOAD((KT) - 3); } while (0)
    LAS float* wsf = (LAS float*)(lds + OFF_WS) + w * 64;
    const int sig = (r32 & 0x13) | ((r32 & 4) << 1) | ((r32 & 8) >> 1);
#define AT_KFH(KT, H) _Pragma("unroll") for (int d0 = (H) * (ND / 2); d0 < ((H) + 1) * (ND / 2); ++d0) { kf[2 * d0] = *(const LAS bf16x8*)(kb_ + d0 * 32); kf[2 * d0 + 1] = *(const LAS bf16x8*)(kb_ + 32 * KSTR + d0 * 32); }
#define AT_KB(KT) const LAS unsigned char* kb_ = lds + OFF_K + ((KT) % 3) * KBYTES + sig * KSTR + hi * 16; bf16x8 kf[2 * ND];
#define AT_VF(SLOT) const LAS unsigned char* vb_ = lds + OFF_V + (SLOT) * VBYTES + r32 * VSTR + hi * 16; bf16x8 vf[8]; \
    _Pragma("unroll") for (int c = 0; c < 4; ++c) { vf[2 * c] = *(const LAS bf16x8*)(vb_ + 32 * c); vf[2 * c + 1] = *(const LAS bf16x8*)(vb_ + 32 * VSTR + 32 * c); }
#define AT_CINIT(SC0, SC1, KT) do { if (FOX) { const LAS float* fk = (const LAS float*)(lds + OFF_FK + ((KT) % 3) * 256) + 8 * hi; const float cq = fq2 - mrun; \
        const f32x4 a0 = *(const LAS f32x4*)(fk), a1 = *(const LAS f32x4*)(fk + 4), a2 = *(const LAS f32x4*)(fk + 16), a3 = *(const LAS f32x4*)(fk + 20); \
        const f32x4 b0 = *(const LAS f32x4*)(fk + 32), b1 = *(const LAS f32x4*)(fk + 36), b2 = *(const LAS f32x4*)(fk + 48), b3 = *(const LAS f32x4*)(fk + 52); \
        _Pragma("unroll") for (int e = 0; e < 4; ++e) { SC0[e] = a0[e] + cq; SC0[4 + e] = a1[e] + cq; SC0[8 + e] = a2[e] + cq; SC0[12 + e] = a3[e] + cq; \
                                                      SC1[e] = b0[e] + cq; SC1[4 + e] = b1[e] + cq; SC1[8 + e] = b2[e] + cq; SC1[12 + e] = b3[e] + cq; } \
    } else { SC0 = (f32x16){}; SC1 = (f32x16){}; } } while (0)
#define AT_QKH(SC0, SC1, H) do { _Pragma("unroll") for (int d0 = (H) * (ND / 2); d0 < ((H) + 1) * (ND / 2); ++d0) { \
        SC0 = __builtin_amdgcn_mfma_f32_32x32x16_bf16(kf[2 * d0], qf[d0], SC0, 0, 0, 0); SC1 = __builtin_amdgcn_mfma_f32_32x32x16_bf16(kf[2 * d0 + 1], qf[d0], SC1, 0, 0, 0); } } while (0)
#define AT_EXPH(SP) _Pragma("unroll") for (int r = 0; r < 16; ++r) { SP[r] = __builtin_amdgcn_exp2f(SP[r]); ls_ += SP[r]; }
#define AT_PACK(SP0, SP1) u32x4 p0, p1, p2, p3; \
    p0.x = pk2(SP0[0], SP0[1]); p0.y = pk2(SP0[2], SP0[3]); p0.z = pk2(SP0[4], SP0[5]); p0.w = pk2(SP0[6], SP0[7]); \
    p1.x = pk2(SP0[8], SP0[9]); p1.y = pk2(SP0[10], SP0[11]); p1.z = pk2(SP0[12], SP0[13]); p1.w = pk2(SP0[14], SP0[15]); \
    p2.x = pk2(SP1[0], SP1[1]); p2.y = pk2(SP1[2], SP1[3]); p2.z = pk2(SP1[4], SP1[5]); p2.w = pk2(SP1[6], SP1[7]); \
    p3.x = pk2(SP1[8], SP1[9]); p3.y = pk2(SP1[10], SP1[11]); p3.z = pk2(SP1[12], SP1[13]); p3.w = pk2(SP1[14], SP1[15]); \

#define AT_PV() do { const bf16x8 pa0 = __builtin_bit_cast(bf16x8, p0), pa1 = __builtin_bit_cast(bf16x8, p1), pa2 = __builtin_bit_cast(bf16x8, p2), pa3 = __builtin_bit_cast(bf16x8, p3); \
    o0 = __builtin_amdgcn_mfma_f32_32x32x16_bf16(pa0, vf[0], o0, 0, 0, 0); o1 = __builtin_amdgcn_mfma_f32_32x32x16_bf16(pa0, vf[1], o1, 0, 0, 0); \
    o0 = __builtin_amdgcn_mfma_f32_32x32x16_bf16(pa1, vf[2], o0, 0, 0, 0); o1 = __builtin_amdgcn_mfma_f32_32x32x16_bf16(pa1, vf[3], o1, 0, 0, 0); \
    o0 = __builtin_amdgcn_mfma_f32_32x32x16_bf16(pa2, vf[4], o0, 0, 0, 0); o1 = __builtin_amdgcn_mfma_f32_32x32x16_bf16(pa2, vf[5], o1, 0, 0, 0); \
    o0 = __builtin_amdgcn_mfma_f32_32x32x16_bf16(pa3, vf[6], o0, 0, 0, 0); o1 = __builtin_amdgcn_mfma_f32_32x32x16_bf16(pa3, vf[7], o1, 0, 0, 0); } while (0)
#define AT_REL(SC0, SC1) do { if (TRACK && !FOX) { if (__any(mrun != 0.f)) { _Pragma("unroll") for (int r = 0; r < 16; ++r) { SC0[r] -= mrun; SC1[r] -= mrun; } } } } while (0)
#define AT_MAX(SC0, SC1) float mloc; { float ma = max3f(SC0[0], SC0[1], SC1[0]), mb = max3f(SC0[2], SC0[3], SC1[1]); ma = max3f(ma, SC1[2], SC1[3]); \
        _Pragma("unroll") for (int r = 4; r < 16; r += 4) { ma = max3f(ma, SC0[r], SC0[r + 1]); mb = max3f(mb, SC0[r + 2], SC0[r + 3]); ma = max3f(ma, SC1[r], SC1[r + 1]); mb = max3f(mb, SC1[r + 2], SC1[r + 3]); } \
        mloc = max3f(ma, mb, mb); mloc = max3f(mloc, __shfl_xor(mloc, 32), mloc); }
#define AT_DEC(SC0, SC1) do { if (__any(mloc > 12.0f)) { \
        const float dl = fmaxf(mloc, 0.f); mrun += dl; const float alpha = __builtin_amdgcn_exp2f(-dl); lrun *= alpha; \
        _Pragma("unroll") for (int r = 0; r < 16; ++r) { SC0[r] -= dl; SC1[r] -= dl; } \
        if (hi == 0) wsf[r32] = alpha; \
        LDS_FENCE(); \
        _Pragma("unroll") for (int r4 = 0; r4 < 4; ++r4) { const f32x4 al = *(const LAS f32x4*)(wsf + 8 * r4 + 4 * hi); \
            _Pragma("unroll") for (int e = 0; e < 4; ++e) { o0[4 * r4 + e] *= al[e]; o1[4 * r4 + e] *= al[e]; } } \
        LDS_FENCE(); } } while (0)
#define AT_FIRST(SC0, SC1, KT) do { AT_KB(KT); AT_KFH(KT, 0); AT_KFH(KT, 1); AT_CINIT(SC0, SC1, KT); __builtin_amdgcn_sched_barrier(0); AT_QKH(SC0, SC1, 0); AT_QKH(SC0, SC1, 1); __builtin_amdgcn_sched_barrier(0); AT_STAGE(KT); __builtin_amdgcn_sched_barrier(0); \
        AT_REL(SC0, SC1); \
        if (FOX) { const int kv0 = 64 * (KT) + 8 * hi; \
            _Pragma("unroll") for (int r = 0; r < 16; ++r) { const int kv = kv0 + 16 * (r >> 3) + (r & 7); if (kv > trow) SC0[r] = -INFINITY; if (kv + 32 > trow) SC1[r] = -INFINITY; } } \
        if (TRACK) { AT_MAX(SC0, SC1); AT_DEC(SC0, SC1); } } while (0)
#define AT_STEADY(SC0, SC1, SP0, SP1, KT) do { AT_KB(KT); AT_KFH(KT, 0); AT_CINIT(SC0, SC1, KT); float ls_ = 0.f; __builtin_amdgcn_sched_barrier(0); \
        AT_QKH(SC0, SC1, 0); AT_KFH(KT, 1); AT_EXPH(SP0); asm volatile("" : "+v"(SP0), "+v"(ls_)); AT_SGB_QK(); __builtin_amdgcn_sched_barrier(0); AT_STAGE(KT); __builtin_amdgcn_sched_barrier(0); \
        AT_QKH(SC0, SC1, 1); AT_VF(((KT) + 1) & 3); AT_EXPH(SP1); lrun += ls_; AT_PACK(SP0, SP1); asm volatile("" : "+v"(p0), "+v"(p1), "+v"(p2), "+v"(p3), "+v"(lrun)); AT_SGB_QK(); __builtin_amdgcn_sched_barrier(0); \
        AT_REL(SC0, SC1); \
        if (TRACK) { AT_PV(); AT_MAX(SC0, SC1); AT_SGB_PV(); __builtin_amdgcn_sched_barrier(0); AT_DEC(SC0, SC1); } else { AT_PV(); } } while (0)
#define AT_DRAIN(SP0, SP1) do { AT_VF(kt_lo & 3); float ls_ = 0.f; AT_EXPH(SP0); AT_EXPH(SP1); lrun += ls_; AT_PACK(SP0, SP1); AT_PV(); } while (0)
#ifndef AT_HINTS
#define AT_HINTS 1
#endif
#if AT_HINTS
#define AT_SGB_QK() do { _Pragma("unroll") for (int i_ = 0; i_ < ND; ++i_) { __builtin_amdgcn_sched_group_barrier(0x008, 1, 0); __builtin_amdgcn_sched_group_barrier(0x002, (DK == 96 ? 7 : 10), 0); } } while (0)
#define AT_SGB_PV() do { _Pragma("unroll") for (int i_ = 0; i_ < 8; ++i_) { __builtin_amdgcn_sched_group_barrier(0x008, 1, 0); __builtin_amdgcn_sched_group_barrier(0x002, 2, 0); } } while (0)
#else
#define AT_SGB_QK() do {} while (0)
#define AT_SGB_PV() do {} while (0)
#endif
#define AT_STEP_STEADY(SC0, SC1, SP0, SP1, KT) do { const int kt_ = (KT); AT_STEADY(SC0, SC1, SP0, SP1, kt_); LBAR(); } while (0)
    f32x16 sA0 = {}, sA1 = {}, sB0 = {}, sB1 = {};
    LAS unsigned* uflag = (LAS unsigned*)(lds + 100016);
    if (!TRACK && tid == 0) *uflag = 0u;
    AT_GLOAD(ktmax); AT_GLOAD_S(ktmax - 1, kregB, vregB, rregB, fkregB); AT_LWRITE(ktmax); AT_LWRITE_S(ktmax - 1, kregB, vregB, rregB, fkregB); AT_GLOAD(ktmax - 2); LBAR();
    for (int kt = ktmax; kt > wkt; --kt) { AT_STAGE(kt); LBAR(); }
    { AT_FIRST(sA0, sA1, wkt); LBAR(); }
    int kt = wkt - 1;
    for (; kt >= kt_lo + 1; kt -= 2) {
        AT_STEP_STEADY(sB0, sB1, sA0, sA1, kt);
        AT_STEP_STEADY(sA0, sA1, sB0, sB1, kt - 1);
    }
    if (kt == kt_lo) { AT_STEP_STEADY(sB0, sB1, sA0, sA1, kt_lo); AT_DRAIN(sB0, sB1); LBAR(); }
    else { AT_DRAIN(sA0, sA1); LBAR(); }
#undef AT_GLOAD
#undef AT_LWRITE
#undef AT_GLOAD_S
#undef AT_LWRITE_S
#undef AT_STAGE
#undef AT_KFH
#undef AT_KB
#undef AT_QKH
#undef AT_EXPH
#undef AT_PACK
#undef AT_REL
#undef AT_STEP_STEADY
#undef AT_VF
#undef AT_CINIT
#undef AT_QK
#undef AT_SOFT
#undef AT_PV
#undef AT_MAX
#undef AT_DEC
#undef AT_FIRST
#undef AT_STEADY
#undef AT_DRAIN
#undef AT_STEP
    lrun += __shfl_xor(lrun, 32);
    if (hi == 0) wsf[32 + r32] = lrun;
    LDS_FENCE();
#pragma unroll
    for (int r4 = 0; r4 < 4; ++r4) { const f32x4 lv = *(const LAS f32x4*)(wsf + 32 + 8 * r4 + 4 * hi);
#pragma unroll
        for (int e = 0; e < 4; ++e) { const float inv = 1.0f / lv[e]; const int row = wrow0 + e + 8 * r4 + 4 * hi;
            Yp[(size_t)row * DM + r32] = (bf16_t)(pk2(o0[4 * r4 + e] * inv, 0.f) & 0xffffu);
            Yp[(size_t)row * DM + 32 + r32] = (bf16_t)(pk2(o1[4 * r4 + e] * inv, 0.f) & 0xffffu); } }
    LDS_FENCE();
    if (!TRACK) {
        const bool bad = !(lrun > 1e-30f && lrun < 1e30f);
        if (__any(bad)) { if (lane == 0) atomicOr((unsigned*)uflag, 1u); }
        LBAR(); const unsigned f_ = *uflag; LBAR();
        return f_ == 0u;
    }
    return true;
}

#define XB_TMO      128
#define XB_XCNT(j)  (256  + 64 * (j))
#define XB_XSUB(j)  (1280 + 64 * (j))
#define XB_XGEN(j)  (2304 + 64 * (j))
#define XB_TOP      3328
#define XB_TOPGEN   3392
#define XCD_BAR_WORDS 3456
#define XB_SPIN_CAP (1u << 18)

__device__ __forceinline__ unsigned xb_ld(unsigned* p)              { return __hip_atomic_load(p, __ATOMIC_RELAXED, __HIP_MEMORY_SCOPE_AGENT); }
__device__ __forceinline__ unsigned xb_add(unsigned* p, unsigned v) { return __hip_atomic_fetch_add(p, v, __ATOMIC_RELAXED, __HIP_MEMORY_SCOPE_AGENT); }
__device__ __forceinline__ unsigned xb_xcc_id() { return (unsigned)__builtin_amdgcn_s_getreg((3 << 11) | 20) & 0xFu; }
#define XB_SPIN(cond, bar) do { unsigned _sp = 0; while (cond) { __builtin_amdgcn_s_sleep(1); \
    if ((++_sp & 255u) == 0u) { if (xb_ld(&(bar)[XB_TMO])) break; if (_sp > XB_SPIN_CAP) { atomicAdd(&(bar)[XB_TMO], 1u); break; } } } } while (0)

struct XcdBarrier {
    unsigned* bar; unsigned x;
    volatile LAS unsigned* st;
};

__device__ __forceinline__ XcdBarrier xcd_barrier_post(unsigned* bar, volatile LAS unsigned* st) {
    XcdBarrier b; b.bar = bar; b.x = xb_xcc_id(); b.st = st;
    if (threadIdx.x == 0) (void)xb_add(&bar[XB_XCNT(b.x)], 1u);
    return b;
}
__device__ __forceinline__ void xcd_barrier_complete(unsigned* bar, unsigned x, unsigned& nloc, unsigned& nx) {
    const unsigned G = gridDim.x * gridDim.y * gridDim.z;
    unsigned sum, cnt, mine, sp = 0u;
    for (;;) {
        sum = 0u; cnt = 0u; mine = 0u;
#pragma unroll
        for (unsigned j = 0; j < 16; ++j) { const unsigned c = xb_ld(&bar[XB_XCNT(j)]); sum += c; cnt += (c > 0u) ? 1u : 0u; mine = (j == x) ? c : mine; }
        if (sum == G) break;
        __builtin_amdgcn_s_sleep(1);
        if ((++sp & 255u) == 0u) { if (xb_ld(&bar[XB_TMO])) break; if (sp > XB_SPIN_CAP) { atomicAdd(&bar[XB_TMO], 1u); break; } }
    }
    nloc = mine > 0u ? mine : 1u; nx = cnt > 0u ? cnt : 1u;
}

__device__ __forceinline__ void xcd_barrier(const XcdBarrier& b) {
    asm volatile("s_waitcnt vmcnt(0)" ::: "memory");
    __syncthreads();
    if (threadIdx.x == 0) {
        unsigned* bar = b.bar;
        __builtin_amdgcn_s_waitcnt(0);
        unsigned nloc = b.st[0], nx = b.st[1];
        if (nloc == 0u) { xcd_barrier_complete(bar, b.x, nloc, nx); b.st[0] = nloc; b.st[1] = nx; }
        const unsigned old = xb_add(&bar[XB_XSUB(b.x)], 1u);
        const unsigned gen = old / nloc;
        if (old + 1u == (gen + 1u) * nloc) {
            __builtin_amdgcn_fence(__ATOMIC_RELEASE, "agent");
            asm volatile("s_waitcnt vmcnt(0)" ::: "memory");
            const unsigned og = xb_add(&bar[XB_TOP], 1u);
            const unsigned tg = og / nx;
            if (og + 1u == (tg + 1u) * nx) xb_add(&bar[XB_TOPGEN], 1u);
            else XB_SPIN(xb_ld(&bar[XB_TOPGEN]) == tg, bar);
            __builtin_amdgcn_fence(__ATOMIC_ACQUIRE, "agent");
            xb_add(&bar[XB_XGEN(b.x)], 1u);
            asm volatile("s_waitcnt vmcnt(0)" ::: "memory");
        } else {
            XB_SPIN(xb_ld(&bar[XB_XGEN(b.x)]) == gen, bar);
            __builtin_amdgcn_fence(__ATOMIC_ACQUIRE, "agent");
            asm volatile("s_waitcnt vmcnt(0)" ::: "memory");
        }
    }
    __syncthreads();
}

__global__ void __launch_bounds__(512, 2) fwd_mega(Args Akern) {
    extern __shared__ __attribute__((aligned(16))) unsigned char lds_raw[];
    LAS unsigned char* lds = (LAS unsigned char*)lds_raw;
    const int G = gridDim.x, bx = blockIdx.x;
    const int vcu = (G % 8 == 0) ? (bx % 8) * (G / 8) + bx / 8 : bx;
    const int NGW = G * 8;
    const int ph_lo = Akern.ph_lo, ph_hi = Akern.ph_hi, do_sync = Akern.do_sync;
    volatile LAS unsigned* bar_st = (volatile LAS unsigned*)(lds + 140000);
    if (threadIdx.x < 2) bar_st[threadIdx.x] = 0u;
    __syncthreads();
    XcdBarrier xbar; xbar.bar = (unsigned*)(Akern.ws + WS_SM + SM_BAR); xbar.x = 0; xbar.st = nullptr;
    if (do_sync) xbar = xcd_barrier_post((unsigned*)(Akern.ws + WS_SM + SM_BAR), bar_st);
    bool first_sync = true;
#if defined(__HIP_DEVICE_COMPILE__)
    const __attribute__((address_space(4))) Args* Ak = (const __attribute__((address_space(4))) Args*)__builtin_amdgcn_kernarg_segment_ptr();
#else
    const Args* Ak = &Akern;
#endif

#if PROBE_KMASK
    unsigned long long t_acc = 0ull;
#endif
    for (int ph = ph_lo; ph < ph_hi; ++ph) {
#if PROBE_KMASK
        const unsigned long long t_ph0 = __builtin_amdgcn_s_memrealtime();
#endif
        asm volatile("" : "+s"(Ak));
        const Args A = *Ak;
        int tid = threadIdx.x; asm volatile("" : "+v"(tid));
        const int lane = tid & 63, wave = __builtin_amdgcn_readfirstlane(tid >> 6), gw = vcu * 8 + wave;
        unsigned char* ws = A.ws;
        bf16_t* HN = (bf16_t*)(ws + WS_HN); bf16_t* Yb = (bf16_t*)(ws + WS_Y); bf16_t* R1 = (bf16_t*)(ws + WS_R1); bf16_t* VT = (bf16_t*)(ws + WS_VT); bf16_t* KN = (bf16_t*)(ws + WS_KN);
        float* LFb = (float*)(ws + WS_SM + SM_LF); const double* Fb = (const double*)(ws + WS_SM + SM_F); const float* CS = (const float*)(ws + WS_SM + SM_CS);
        const int l = ph / 12, k = ph % 12, i = l >> 1; const bool even = !(l & 1);
        bool did = true;
        if (ph == NPH - 1) {
            if (EN(0)) norm_phase<2>(A.out, A.norm_final, nullptr, A.out, nullptr, nullptr, nullptr, nullptr, gw, NGW, lane, tid);
        } else if (k == 0 || k == 9) {
            const int f = (k == 0) ? 0 : 1;
            if (EN(1)) if (k == 0) { convert_layer(A, l, (LAS float*)(lds + wave * 16384), gw, NGW, lane); if (l == 0) rope_table(A, gw, NGW, lane); }
            if (EN(0)) norm_phase<0>((l == 0 && k == 0) ? A.x : A.out, A.norm_ffn + (size_t)(l * 2 + f) * DM, HN, nullptr, nullptr, nullptr, nullptr, nullptr, gw, NGW, lane, tid);
        } else if (k == 1 || k == 10) {
            const int f = (k == 1) ? 0 : 1;
            pg8::Gemm g{HN, (const bf16_t*)(ws + WS_W + (f ? W_GU1 : W_GU0)), T, 2 * FF, DM}; pg8::StaticOrder S; S.init(T, 2 * FF, G, bx);
            pg8::EpiSwiglu E{R1, FF};
            if (EN(2)) pg8::gemm_phase<pg8::EpiSwiglu, pg8::StaticOrder, true, true>(lds, g, S, E);
        } else if (k == 4 && !even && G == 256) {
            pg8::Gemm g{HN, (const bf16_t*)(ws + WS_W + W_MIN), T, 512, DM}; pg8::StaticOrder S; S.init(T, 512, G, bx);
            pg8::EpiMlaIn E{(bf16_t*)(ws + WS_R1 + R_CQN), (bf16_t*)(ws + WS_R1 + R_CKVN), (bf16_t*)(ws + WS_R1 + R_KR), A.mla_q_norm + (size_t)i * 256, A.mla_kv_norm + (size_t)i * 128, CS};
            pg8::gemm_phase<pg8::EpiMlaIn, pg8::StaticOrder, false, true>(lds, g, S, E);
        } else if (k == 2 || k == 11 || k == 8 || (k == 4 && !even)) {
            pg8::Gemm g; pg8::EpiResF32 E;
            if (k == 2 || k == 11) { const int f = (k == 2) ? 0 : 1; g = pg8::Gemm{R1, (const bf16_t*)(ws + WS_W + (f ? W_D1 : W_D0)), T, DM, FF, 1};
                E = pg8::EpiResF32{(l == 0 && k == 2) ? A.x : A.out, A.out, DM, 0.5f}; }
            else if (k == 8) { g = pg8::Gemm{Yb, (const bf16_t*)(ws + WS_W + W_OUT), T, DM, DM}; E = pg8::EpiResF32{A.out, A.out, DM, 1.0f}; }
            else { g = pg8::Gemm{HN, (const bf16_t*)(ws + WS_W + W_MIN), T, 512, DM}; E = pg8::EpiResF32{nullptr, (float*)(ws + WS_Y), 512, 1.0f}; }
            pg8::StaticOrder S; S.init(g.M, g.N, G, bx);
            if (EN(3)) pg8::gemm_phase<pg8::EpiResF32, pg8::StaticOrder, true, true>(lds, g, S, E);
        } else if (k == 3) {
            if (even && bx == 0 && tid < 64) { ((unsigned*)(ws + WS_SM + SM_KQ))[tid] = 0u; if (tid == 0) *(unsigned*)(ws + WS_SM + SM_CTR) = 0u; }
            if (!EN(4)) {} else if (even) norm_phase<1>(A.out, A.norm_mix + (size_t)l * DM, HN, nullptr, A.ab_w_in + (size_t)i * DM * 2056, A.ab_b_forget + (size_t)i * 8, LFb, (LAS float*)lds, gw, NGW, lane, tid);
            else norm_phase<0>(A.out, A.norm_mix + (size_t)l * DM, HN, nullptr, nullptr, nullptr, nullptr, nullptr, gw, NGW, lane, tid);
        } else if ((k == 4 && even) || (k == 6 && !even)) {
            const int ng = even ? 2 : 3;
            for (int j = 0; j < ng; ++j) {
                pg8::Gemm g; pg8::EpiBf16S E;
                if (even) {
                    if (j == 0) { g = pg8::Gemm{HN, (const bf16_t*)(ws + WS_W + W_IN), T, 1536, DM}; E = pg8::EpiBf16S{R1, 1536, 512, 1024, 0.125f * LOG2E}; }
                    else { g = pg8::Gemm{(const bf16_t*)(ws + WS_W + W_V), HN, 512, T, DM}; E = pg8::EpiBf16S{VT, T, 0, 0, 1.0f}; }
                } else {
                    if (j == 0) { g = pg8::Gemm{(const bf16_t*)(ws + WS_R1 + R_CQN), (const bf16_t*)(ws + WS_W + W_QB), T, 1536, 256}; E = pg8::EpiBf16S{R1, 1536, 0, 1536, 0.10206207261596577f * LOG2E}; }
                    else if (j == 1) { g = pg8::Gemm{(const bf16_t*)(ws + WS_R1 + R_CKVN), (const bf16_t*)(ws + WS_W + W_KNW), T, 1024, 256}; E = pg8::EpiBf16S{KN, 1024, 0, 0, 1.0f}; }
                    else { g = pg8::Gemm{(const bf16_t*)(ws + WS_W + W_VVW), (const bf16_t*)(ws + WS_R1 + R_CKVN), 1024, T, 256}; E = pg8::EpiBf16S{VT, T, 0, 0, 1.0f}; }
                }
                pg8::StaticOrder S; S.init(g.M, g.N, G, bx);
                if (EN(5)) pg8::gemm_phase<pg8::EpiBf16S, pg8::StaticOrder, true, true>(lds, g, S, E);
                __syncthreads();
            }
        } else if (k == 5) {
            if (!EN(6)) {} else if (even) scan_pool(A, i, lds, gw, NGW, lane, tid, wave);
            else if (G == 256) did = false;
            else mla_small(A, i, gw, NGW, lane);
        } else if (k == 7) {
            if (even) {
                unsigned* ctr = (unsigned*)(ws + WS_SM + SM_CTR); const unsigned* KQ = (const unsigned*)(ws + WS_SM + SM_KQ);
                LAS unsigned* qslot = (LAS unsigned*)(lds + 100000);
                for (;;) {
                    if (tid == 0) qslot[0] = atomicAdd(ctr, 1u);
                    LBAR(); const unsigned u = qslot[0]; LBAR();
                    if (u >= 1024u) break;
                    const int qb = 63 - (int)(u >> 4), bh = (int)(u & 15u), b = bh >> 3, h = bh & 7;
                    float mq_ = 0.f, mk_ = 0.f;
                    { const float* KQP = (const float*)(ws + WS_SM + SM_KQP) + (bh >> 3) * 16 + (bh & 7) * 2;
                      for (int x = lane; x < G; x += 64) { mq_ = fmaxf(mq_, KQP[(size_t)x * 32]); mk_ = fmaxf(mk_, KQP[(size_t)x * 32 + 1]); }
#pragma unroll
                      for (int o = 1; o < 64; o <<= 1) { mq_ = fmaxf(mq_, __shfl_xor(mq_, o)); mk_ = fmaxf(mk_, __shfl_xor(mk_, o)); } }
                    const float thr = 2.0f * sqrtf(mq_ * mk_) + 48.0f;
                    if (!attn_unit<64, true, false>(lds, R1 + (size_t)(b * SEQ) * 1536 + 512 + 64 * h, 1536, R1 + (size_t)(b * SEQ) * 1536 + 1024 + 64 * h, 1536, nullptr,
                                        VT + (size_t)(64 * h) * T + (size_t)b * SEQ, Fb + (size_t)bh * SEQ, nullptr, Yb + (size_t)(b * SEQ) * DM + 512 + 64 * h, qb * 256, tid, thr)) attn_unit<64, true, true>(lds, R1 + (size_t)(b * SEQ) * 1536 + 512 + 64 * h, 1536, R1 + (size_t)(b * SEQ) * 1536 + 1024 + 64 * h, 1536, nullptr,
                                        VT + (size_t)(64 * h) * T + (size_t)b * SEQ, Fb + (size_t)bh * SEQ, nullptr, Yb + (size_t)(b * SEQ) * DM + 512 + 64 * h, qb * 256, tid, thr);
                }
            } else {
                for (int p = vcu; p < 32 * 32; p += G) { const int bh = p >> 5, s = p & 31, b = bh >> 4, h = bh & 15;
                    for (int z = 0; z < 2; ++z) { const int qb = z ? s : 63 - s;
                        if (!attn_unit<96, false, false>(lds, R1 + (size_t)(b * SEQ) * 1536 + 96 * h, 1536, KN + (size_t)(b * SEQ) * 1024 + 64 * h, 1024, (const bf16_t*)(ws + WS_R1 + R_KR) + (size_t)(b * SEQ) * 32,
                                             VT + (size_t)(64 * h) * T + (size_t)b * SEQ, nullptr, CS + (size_t)(b * SEQ) * 32, Yb + (size_t)(b * SEQ) * DM + 64 * h, qb * 256, tid, 0.f)) attn_unit<96, false, true>(lds, R1 + (size_t)(b * SEQ) * 1536 + 96 * h, 1536, KN + (size_t)(b * SEQ) * 1024 + 64 * h, 1024, (const bf16_t*)(ws + WS_R1 + R_KR) + (size_t)(b * SEQ) * 32,
                                             VT + (size_t)(64 * h) * T + (size_t)b * SEQ, nullptr, CS + (size_t)(b * SEQ) * 32, Yb + (size_t)(b * SEQ) * DM + 64 * h, qb * 256, tid, 0.f); } }
            }
        } else did = false;
        if (did && ph + 1 < ph_hi) { if (do_sync) { if (first_sync) { cg::this_grid().sync(); first_sync = false; } else xcd_barrier(xbar); } }
#if PROBE_KMASK
        { const int kk_ = (ph == NPH - 1) ? 12 : (ph % 12); if ((PROBE_KMASK >> kk_) & 1) t_acc += __builtin_amdgcn_s_memrealtime() - t_ph0; }
        if (ph == NPH - 1 && blockIdx.x == 0 && (threadIdx.x >> 6) == 0) {
            const int M_ = (int)(t_acc / 200ull) > 8192 ? 8192 : (int)(t_acc / 200ull);
            for (int idx = threadIdx.x & 63; idx < M_; idx += 64) A.out[(size_t)(idx >> 10) * NGW * DM + (idx & 1023)] += 0.05f;
        }
#endif
    }
}

extern "C" void kernel_launch(void* const* d_in, const int* in_sizes, int n_in, void* d_out, int out_size, void* d_ws, size_t ws_size, hipStream_t stream) {
    static int grid = 0;
    if (grid == 0) {
        if (n_in != 19 || out_size != T * DM || ws_size < WS_END) { fprintf(stderr, "kernel_launch: unexpected shapes (n_in %d out %d ws %zu)\n", n_in, out_size, ws_size); grid = -1; return; }
        int dev = 0, cus = 0, per_cu = 0;
        hipGetDevice(&dev); hipDeviceGetAttribute(&cus, hipDeviceAttributeMultiprocessorCount, dev);
        if (hipFuncSetAttribute((const void*)fwd_mega, hipFuncAttributeMaxDynamicSharedMemorySize, LDS_BYTES) != hipSuccess) { fprintf(stderr, "kernel_launch: hipFuncSetAttribute failed\n"); grid = -1; return; }
        if (hipOccupancyMaxActiveBlocksPerMultiprocessor(&per_cu, (const void*)fwd_mega, 512, LDS_BYTES) != hipSuccess || per_cu < 1) { fprintf(stderr, "kernel_launch: occupancy query says %d\n", per_cu); per_cu = 1; }
        (void)hipGetLastError();
        grid = cus * 1;
    }
    if (grid < 0) return;
    Args a{};
    a.x = (const float*)d_in[0]; a.pos = (const int*)d_in[1]; a.norm_ffn = (const float*)d_in[2]; a.norm_mix = (const float*)d_in[3]; a.norm_final = (const float*)d_in[4];
    a.w_gate = (const float*)d_in[5]; a.w_up = (const float*)d_in[6]; a.w_down = (const float*)d_in[7];
    a.ab_w_in = (const float*)d_in[8]; a.ab_b_forget = (const float*)d_in[9]; a.pool_w = (const float*)d_in[10]; a.pool_scale = (const float*)d_in[11]; a.ab_w_out = (const float*)d_in[12];
    a.mla_w_in = (const float*)d_in[13]; a.mla_q_norm = (const float*)d_in[14]; a.mla_kv_norm = (const float*)d_in[15]; a.mla_w_q_b = (const float*)d_in[16]; a.mla_w_kv_b = (const float*)d_in[17]; a.mla_w_out = (const float*)d_in[18];
    a.out = (float*)d_out; a.ws = (unsigned char*)d_ws; a.pad = 0;
#if ONE_LAUNCH
    a.ph_lo = 0; a.ph_hi = NPH; a.do_sync = 1;
    if (hipMemsetAsync((char*)d_ws + WS_SM + SM_BAR, 0, XCD_BAR_WORDS * 4, stream) != hipSuccess) { fprintf(stderr, "kernel_launch: memset of the barrier words failed\n"); return; }
    void* args[] = {&a};
    hipError_t e = hipLaunchCooperativeKernel((const void*)fwd_mega, dim3(grid), dim3(512), args, LDS_BYTES, stream);
    if (e != hipSuccess) fprintf(stderr, "cooperative launch failed: %s (grid %d)\n", hipGetErrorString(e), grid);
#else
    for (int ph = 0; ph < NPH; ++ph) {
        const int l = ph / 12, k = ph % 12; if (ph != NPH - 1 && k == 6 && !(l & 1)) continue;
        a.ph_lo = ph; a.ph_hi = ph + 1; a.do_sync = 0;
        hipLaunchKernelGGL(fwd_mega, dim3(grid), dim3(512), LDS_BYTES, stream, a);
    }
#endif
}
```

```cpp
#include <hip/hip_runtime.h>
#include <hip/hip_cooperative_groups.h>
#include <cstdio>
#include <cstdint>
namespace cg = cooperative_groups;
#ifndef ONE_LAUNCH
#define ONE_LAUNCH 1
#endif
namespace pg8 {
#define PG8_LAS __attribute__((address_space(3)))
typedef unsigned short bf16_t;
typedef short bf16x8 __attribute__((ext_vector_type(8)));
typedef float f32x4 __attribute__((ext_vector_type(4)));
typedef unsigned u32x4 __attribute__((ext_vector_type(4)));
constexpr int BM = 256, BK = 64, HALF = 128, HTB = HALF * BK * 2  , STAGE_BYTES = 8 * HTB, NXCD = 8, WGM = 8;

__host__ __device__ __forceinline__ int lds_byte(int r, int c) { const int st = (r >> 4) * 2 + (c >> 5), rr = r & 15, cc = c & 31, ob = rr * 64 + cc * 2; return st * 1024 + (ob ^ (((ob >> 9) & 1) << 5)); }
__host__ __device__ __forceinline__ void stage_rc(int b, int& R, int& C) { const int st = b / 1024, sb = b % 1024, swz = sb ^ (((sb >> 9) & 1) << 5); R = (st >> 1) * 16 + swz / 64; C = (st & 1) * 32 + (swz % 64) / 2; }
__host__ __device__ __forceinline__ int perm32(int rho) { const int n = rho >> 4, i = rho & 15; return 8 * (i >> 2) + 4 * n + (i & 3); }

struct Unit { int pm, pn; };
struct Gemm { const bf16_t* A; const bf16_t* Bt; int M, N, K; };

struct StaticOrder {
    int nM, nN, nwg, G, c;
    __host__ __device__ void init(int M, int N, int G_, int c_) { nM = M / BM; nN = N / BM; nwg = nM * nN; G = G_; c = c_; }
    __host__ __device__ bool next(int i, Unit& u) const {
        const long L = (long)i * G + c; if (L >= nwg) return false;
        int wgid = (int)L; { const int q = nwg / NXCD, r = nwg % NXCD, xcd = wgid % NXCD, off = wgid / NXCD; wgid = (xcd < r ? xcd * (q + 1) : r * (q + 1) + (xcd - r) * q) + off; }
        const int nig = WGM * nN, gid = wgid / nig, fm = gid * WGM, gsz = (nM - fm) < WGM ? (nM - fm) : WGM;
        u.pm = fm + ((wgid % nig) % gsz); u.pn = (wgid % nig) / gsz; return true;
    }
    __device__ __forceinline__ void a_ready(const Unit&) const {}
    __device__ __forceinline__ void done(const Unit&) const {}
};
__device__ __forceinline__ unsigned cvt_pk_bf16(float lo, float hi) { unsigned r; asm volatile("v_cvt_pk_bf16_f32 %0, %1, %2" : "=v"(r) : "v"(lo), "v"(hi)); return r; }
typedef float f32x2 __attribute__((ext_vector_type(2)));
struct EpiBf16S {
    static constexpr bool PERM = true, AFTER_DRAIN = false;
    bf16_t* O; int ldc; int sc_lo, sc_hi; float scale;
    __device__ __forceinline__ void operator()(const f32x4 (&acc)[2][2][4][2], const Unit& u, int wr, int wc, int fr, int fq) const {
        const int row0 = u.pm * BM + wr * 64 + fr; const int colt = u.pn * BM;
        const float sc = (colt >= sc_lo && colt < sc_hi) ? scale : 1.f;
        const int col0 = colt + wc * 32 + 8 * fq;
#pragma unroll
        for (int ai = 0; ai < 2; ++ai)
#pragma unroll
            for (int m = 0; m < 4; ++m) { bf16_t* rowp = O + (size_t)(row0 + ai * HALF + m * 16) * ldc + col0;
#pragma unroll
                for (int bj = 0; bj < 2; ++bj) { const f32x4 v0 = acc[ai][bj][m][0] * sc, v1 = acc[ai][bj][m][1] * sc;
                    u32x4 w; w.x = cvt_pk_bf16(v0[0], v0[1]); w.y = cvt_pk_bf16(v0[2], v0[3]); w.z = cvt_pk_bf16(v1[0], v1[1]); w.w = cvt_pk_bf16(v1[2], v1[3]);
                    *(u32x4*)(rowp + bj * HALF) = w; } }
    }
};
struct EpiSwiglu {
    static constexpr bool PERM = true, AFTER_DRAIN = false;
    bf16_t* O; int ldc;
    __device__ __forceinline__ void operator()(const f32x4 (&acc)[2][2][4][2], const Unit& u, int wr, int wc, int fr, int fq) const {
        const int row0 = u.pm * BM + wr * 64 + fr; const int col0 = u.pn * HALF + wc * 32 + 8 * fq;
#pragma unroll
        for (int ai = 0; ai < 2; ++ai)
#pragma unroll
            for (int m = 0; m < 4; ++m) { bf16_t* rowp = O + (size_t)(row0 + ai * HALF + m * 16) * ldc + col0;
                float a[8];
#pragma unroll
                for (int n = 0; n < 2; ++n)
#pragma unroll
                    for (int e = 0; e < 4; ++e) { const float g = acc[ai][0][m][n][e], up = acc[ai][1][m][n][e];
                        const float sg = g * __builtin_amdgcn_rcpf(1.0f + __builtin_amdgcn_exp2f(-1.4426950408889634f * g)); a[n * 4 + e] = sg * up; }
                u32x4 w; w.x = cvt_pk_bf16(a[0], a[1]); w.y = cvt_pk_bf16(a[2], a[3]); w.z = cvt_pk_bf16(a[4], a[5]); w.w = cvt_pk_bf16(a[6], a[7]);
                *(u32x4*)rowp = w; }
    }
};
typedef _Float16 f16x4 __attribute__((ext_vector_type(4)));
struct EpiResF32 {
    static constexpr bool PERM = false, AFTER_DRAIN = false;
    const void* base; _Float16* out; int ldc; float alpha; int base32;
    __device__ __forceinline__ void operator()(const f32x4 (&acc)[2][2][4][2], const Unit& u, int wr, int wc, int fr, int fq) const {
        const int col0 = u.pn * BM + wc * 32 + 4 * fq;
#pragma unroll
        for (int ai = 0; ai < 2; ++ai) {
            f32x4 pre[4][2][2];
#pragma unroll
            for (int m = 0; m < 4; ++m) { const size_t off = (size_t)(u.pm * BM + ai * HALF + wr * 64 + m * 16 + fr) * ldc + col0;
#pragma unroll
                for (int bj = 0; bj < 2; ++bj)
#pragma unroll
                    for (int n = 0; n < 2; ++n) {
                        if (base32) pre[m][bj][n] = *(const f32x4*)((const float*)base + off + bj * HALF + n * 16);
                        else pre[m][bj][n] = __builtin_convertvector(*(const f16x4*)((const _Float16*)base + off + bj * HALF + n * 16), f32x4); } }
            asm volatile("" ::: "memory");
#pragma unroll
            for (int m = 0; m < 4; ++m) { const size_t off = (size_t)(u.pm * BM + ai * HALF + wr * 64 + m * 16 + fr) * ldc + col0;
#pragma unroll
                for (int bj = 0; bj < 2; ++bj)
#pragma unroll
                    for (int n = 0; n < 2; ++n) *(f16x4*)(out + off + bj * HALF + n * 16) = __builtin_convertvector(acc[ai][bj][m][n] * alpha + pre[m][bj][n], f16x4); }
            asm volatile("" ::: "memory");
        }
    }
};

struct EpiMlaIn {
    static constexpr bool PERM = false, AFTER_DRAIN = true;
    bf16_t* cqn; bf16_t* ckvn; bf16_t* kr; const float* qn; const float* kvn; const float* cs;
    __device__ __forceinline__ void fused(f32x4 (&acc)[2][2][4][2], const Unit& u, int wr, int wc, int fr, int fq, PG8_LAS unsigned char* lds, int wid, int lane) const {
        typedef unsigned u32x2_t __attribute__((ext_vector_type(2)));
        PG8_LAS float* P = (PG8_LAS float*)lds;
        const bool isq = (u.pn == 0);
#pragma unroll
        for (int ai = 0; ai < 2; ++ai)
#pragma unroll
            for (int m = 0; m < 4; ++m) { float s = 0.f;
#pragma unroll
                for (int n = 0; n < 2; ++n) { const f32x4 x = acc[ai][0][m][n]; s += (x[0] * x[0] + x[1] * x[1]) + (x[2] * x[2] + x[3] * x[3]); }
                if (isq) {
#pragma unroll
                    for (int n = 0; n < 2; ++n) { const f32x4 x = acc[ai][1][m][n]; s += (x[0] * x[0] + x[1] * x[1]) + (x[2] * x[2] + x[3] * x[3]); } }
                s += __shfl_xor(s, 16); s += __shfl_xor(s, 32);
                if (fq == 0) P[(ai * HALF + wr * 64 + m * 16 + fr) * 4 + wc] = s; }
        asm volatile("s_waitcnt lgkmcnt(0)" ::: "memory"); __builtin_amdgcn_s_barrier(); asm volatile("" ::: "memory");
#pragma unroll
        for (int ai = 0; ai < 2; ++ai)
#pragma unroll
            for (int m = 0; m < 4; ++m) { const int rl = ai * HALF + wr * 64 + m * 16 + fr; const size_t r = (size_t)u.pm * BM + rl;
                const f32x4 p4 = *(const PG8_LAS f32x4*)(P + rl * 4); const float ss = (p4[0] + p4[1]) + (p4[2] + p4[3]);
                if (isq) { const float rstd = 1.0f / sqrtf(ss * (1.0f / 256.0f) + 1e-6f);
#pragma unroll
                    for (int bj = 0; bj < 2; ++bj)
#pragma unroll
                        for (int n = 0; n < 2; ++n) { const int c = bj * HALF + wc * 32 + n * 16 + 4 * fq; const f32x4 g4 = *(const f32x4*)(qn + c); const f32x4 y = acc[ai][bj][m][n] * rstd * g4;
                            u32x2_t w; w.x = cvt_pk_bf16(y[0], y[1]); w.y = cvt_pk_bf16(y[2], y[3]); *(u32x2_t*)(cqn + r * 256 + c) = w; }
                } else { const float rstd = 1.0f / sqrtf(ss * (1.0f / 128.0f) + 1e-6f);
#pragma unroll
                    for (int n = 0; n < 2; ++n) { const int c = wc * 32 + n * 16 + 4 * fq; const f32x4 g4 = *(const f32x4*)(kvn + c); const f32x4 y = acc[ai][0][m][n] * rstd * g4;
                        u32x2_t w; w.x = cvt_pk_bf16(y[0], y[1]); w.y = cvt_pk_bf16(y[2], y[3]); *(u32x2_t*)(ckvn + r * 256 + c) = w;
                        u32x2_t z; z.x = 0u; z.y = 0u; *(u32x2_t*)(ckvn + r * 256 + HALF + c) = z; }
                    if (wc == 0) { const int i0 = 4 * fq; const f32x4 x1 = acc[ai][1][m][0], x2 = acc[ai][1][m][1];
                        const f32x4 c4 = *(const f32x4*)(cs + r * 32 + i0), s4 = *(const f32x4*)(cs + r * 32 + 16 + i0);
                        const f32x4 o1 = x1 * c4 - x2 * s4, o2 = x2 * c4 + x1 * s4;
                        u32x2_t w1, w2; w1.x = cvt_pk_bf16(o1[0], o1[1]); w1.y = cvt_pk_bf16(o1[2], o1[3]); w2.x = cvt_pk_bf16(o2[0], o2[1]); w2.y = cvt_pk_bf16(o2[2], o2[3]);
                        *(u32x2_t*)(kr + r * 32 + i0) = w1; *(u32x2_t*)(kr + r * 32 + 16 + i0) = w2; } } }
        asm volatile("s_waitcnt lgkmcnt(0)" ::: "memory"); __builtin_amdgcn_s_barrier(); asm volatile("" ::: "memory");
    }
};

template <class Epi, class Sched, bool ALIGN_EPI = false, bool SP2 = false>
__device__ __forceinline__ void gemm_phase(PG8_LAS unsigned char* lds, const Gemm g, const Sched& S, const Epi& E) {
    int tid_l = threadIdx.x; asm volatile("" : "+v"(tid_l));
    const int tid = tid_l, wid = __builtin_amdgcn_readfirstlane(tid >> 6), lane = tid & 63, wr = wid >> 2, wc = wid & 3, fr = lane & 15, fq = lane >> 4;
    const int K = g.K, nt = K / BK;
    unsigned voffA[2], voffB[2];
#pragma unroll
    for (int i = 0; i < 2; ++i) { int R, C; stage_rc(tid * 16 + i * 8192, R, C); const int Rb = Epi::PERM ? ((R & ~31) + perm32(R & 31)) : R;
        voffA[i] = (unsigned)(R * K + C) * 2u; voffB[i] = (unsigned)(Rb * K + C) * 2u; }
    const size_t kstep = (size_t)(BK * 2);
    const size_t hstep = (size_t)HALF * K * 2;
    const size_t tstep = 2 * hstep;
    const unsigned ldsw = (unsigned)wid * 1024u;
    const int aoff = lds_byte(wr * 64 + fr, fq * 8), boff = lds_byte(wc * 32 + fr, fq * 8);
#define PG8_SA(b, h) (((b) * 2 + (h)) * HTB)
#define PG8_SB(b, h) ((4 + (b) * 2 + (h)) * HTB)
#define PG8_STAGE(bufoff, gbase, voff) do { _Pragma("unroll") for (int _i = 0; _i < 2; ++_i) \
        __builtin_amdgcn_global_load_lds((const unsigned*)((const char*)(gbase) + (voff)[_i]), (PG8_LAS unsigned*)(lds + (bufoff) + ldsw + _i * 8192), 16, 0, 0); } while (0)
#define PG8_LDA(dst, b, h) do { _Pragma("unroll") for (int m = 0; m < 4; ++m) _Pragma("unroll") for (int k = 0; k < 2; ++k) dst[m][k] = *(const PG8_LAS bf16x8*)(lds + PG8_SA(b, h) + aoff + m * 2048 + k * 1024); } while (0)
#define PG8_LDB(dst, b, h) do { _Pragma("unroll") for (int n = 0; n < 2; ++n) _Pragma("unroll") for (int k = 0; k < 2; ++k) dst[n][k] = *(const PG8_LAS bf16x8*)(lds + PG8_SB(b, h) + boff + n * 2048 + k * 1024); } while (0)
#define PG8_MMA(ai, bj, At, Bt) do { __builtin_amdgcn_s_setprio(1); _Pragma("unroll") for (int m = 0; m < 4; ++m) _Pragma("unroll") for (int n = 0; n < 2; ++n) _Pragma("unroll") for (int k = 0; k < 2; ++k) \
        acc[ai][bj][m][n] = __builtin_amdgcn_mfma_f32_16x16x32_bf16(Bt[n][k], At[m][k], acc[ai][bj][m][n], 0, 0, 0); __builtin_amdgcn_s_setprio(0); } while (0)
#define PG8_WAIT_V(n) asm volatile("s_waitcnt vmcnt(" #n ")" ::: "memory")
#define PG8_WAIT_L(n) asm volatile("s_waitcnt lgkmcnt(" #n ")" ::: "memory")
#define PG8_BAR __builtin_amdgcn_s_barrier()
#define PG8_SCHED __builtin_amdgcn_sched_barrier(0)
    Unit cur, nxt; int ui = 0;
    if (!S.next(0, cur)) return;
    f32x4 acc[2][2][4][2];
#pragma unroll
    for (int a = 0; a < 2; ++a)
#pragma unroll
        for (int b = 0; b < 2; ++b)
#pragma unroll
            for (int m = 0; m < 4; ++m)
#pragma unroll
                for (int n = 0; n < 2; ++n) acc[a][b][m][n] = (f32x4){0.f, 0.f, 0.f, 0.f};
    bf16x8 At[4][2], B0[2][2], B1[2][2];
    const char* cA = (const char*)g.A + (size_t)cur.pm * tstep; const char* cB = (const char*)g.Bt + (size_t)cur.pn * tstep;
    S.a_ready(cur);
    if constexpr (SP2) {
        PG8_STAGE(PG8_SB(0, 0), cB, voffB); PG8_STAGE(PG8_SB(0, 1), cB + hstep, voffB); PG8_STAGE(PG8_SA(0, 0), cA, voffA); PG8_STAGE(PG8_SA(0, 1), cA + hstep, voffA);
        if (wr == 1) PG8_BAR;
        PG8_WAIT_V(2); PG8_BAR;
        PG8_STAGE(PG8_SB(1, 0), cB + kstep, voffB); PG8_STAGE(PG8_SA(1, 0), cA + kstep, voffA); PG8_STAGE(PG8_SB(1, 1), cB + hstep + kstep, voffB);
        PG8_WAIT_V(6); PG8_BAR;
    } else {
        PG8_STAGE(PG8_SB(0, 0), cB, voffB); PG8_STAGE(PG8_SA(0, 0), cA, voffA); PG8_STAGE(PG8_SB(0, 1), cB + hstep, voffB); PG8_STAGE(PG8_SA(0, 1), cA + hstep, voffA);
        if (wr == 1) PG8_BAR;
        PG8_WAIT_V(4); PG8_BAR;
        PG8_STAGE(PG8_SB(1, 0), cB + kstep, voffB); PG8_STAGE(PG8_SA(1, 0), cA + kstep, voffA); PG8_STAGE(PG8_SB(1, 1), cB + hstep + kstep, voffB);
        PG8_WAIT_V(6); PG8_BAR;
    }
    for (;;) {
        const bool has_next = S.next(ui + 1, nxt);
        const char* nA = has_next ? (const char*)g.A + (size_t)nxt.pm * tstep : cA; const char* nB = has_next ? (const char*)g.Bt + (size_t)nxt.pn * tstep : cB;
        for (int t = 0; t < nt; t += 2) {
            const bool last = (t == nt - 2);
            const char* a1 = cA + (size_t)(t + 1) * kstep;
            const char* a2 = last ? nA : cA + (size_t)(t + 2) * kstep; const char* b2 = last ? nB : cB + (size_t)(t + 2) * kstep;
            const char* a3 = a2 + kstep; const char* b3 = b2 + kstep;
            if (last && has_next) S.a_ready(nxt);
            if constexpr (SP2) {
            PG8_LDB(B0, 0, 0); PG8_LDB(B1, 0, 1); PG8_SCHED; PG8_LDA(At, 0, 0); PG8_STAGE(PG8_SA(1, 1), a1 + hstep, voffA);
            PG8_WAIT_V(8); PG8_WAIT_L(0); PG8_BAR; PG8_MMA(0, 0, At, B0); PG8_MMA(0, 1, At, B1); PG8_BAR; PG8_SCHED;
            PG8_LDA(At, 0, 1); PG8_STAGE(PG8_SB(0, 0), b2, voffB); PG8_STAGE(PG8_SB(0, 1), b2 + hstep, voffB); PG8_STAGE(PG8_SA(0, 0), a2, voffA);
            PG8_WAIT_V(8); PG8_WAIT_L(0); PG8_BAR; PG8_MMA(1, 0, At, B0); PG8_MMA(1, 1, At, B1); PG8_BAR; PG8_SCHED;
            PG8_LDB(B0, 1, 0); PG8_LDB(B1, 1, 1); PG8_SCHED; PG8_LDA(At, 1, 0); PG8_STAGE(PG8_SA(0, 1), a2 + hstep, voffA);
            PG8_WAIT_V(8); PG8_WAIT_L(0); PG8_BAR; PG8_MMA(0, 0, At, B0); PG8_MMA(0, 1, At, B1); PG8_BAR; PG8_SCHED;
            PG8_LDA(At, 1, 1); PG8_STAGE(PG8_SB(1, 0), b3, voffB); PG8_STAGE(PG8_SB(1, 1), b3 + hstep, voffB); PG8_STAGE(PG8_SA(1, 0), a3, voffA);
            PG8_WAIT_V(8); PG8_WAIT_L(0); PG8_BAR; PG8_MMA(1, 0, At, B0); PG8_MMA(1, 1, At, B1); PG8_BAR; PG8_SCHED;
            } else {
            PG8_LDB(B0, 0, 0); PG8_SCHED; PG8_LDA(At, 0, 0); PG8_STAGE(PG8_SA(1, 1), a1 + hstep, voffA);
            PG8_WAIT_L(8); PG8_BAR; PG8_WAIT_L(0); PG8_MMA(0, 0, At, B0); PG8_BAR; PG8_SCHED;
            PG8_LDB(B1, 0, 1); PG8_STAGE(PG8_SB(0, 0), b2, voffB);
            PG8_BAR; PG8_WAIT_L(0); PG8_MMA(0, 1, At, B1); PG8_BAR;
            PG8_LDA(At, 0, 1); PG8_STAGE(PG8_SA(0, 0), a2, voffA);
            PG8_BAR; PG8_WAIT_L(0); PG8_MMA(1, 0, At, B0); PG8_BAR; PG8_SCHED;
            PG8_STAGE(PG8_SB(0, 1), b2 + hstep, voffB);
            PG8_WAIT_V(6); PG8_BAR; PG8_MMA(1, 1, At, B1); PG8_BAR;
            PG8_LDB(B0, 1, 0); PG8_SCHED; PG8_LDA(At, 1, 0); PG8_STAGE(PG8_SA(0, 1), a2 + hstep, voffA);
            PG8_WAIT_L(8); PG8_BAR; PG8_WAIT_L(0); PG8_MMA(0, 0, At, B0); PG8_BAR; PG8_SCHED;
            PG8_LDB(B1, 1, 1); PG8_STAGE(PG8_SB(1, 0), b3, voffB);
            PG8_BAR; PG8_WAIT_L(0); PG8_MMA(0, 1, At, B1); PG8_BAR;
            PG8_LDA(At, 1, 1); PG8_STAGE(PG8_SA(1, 0), a3, voffA);
            PG8_BAR; PG8_WAIT_L(0); PG8_MMA(1, 0, At, B0); PG8_BAR; PG8_SCHED;
            PG8_STAGE(PG8_SB(1, 1), b3 + hstep, voffB);
            PG8_WAIT_V(6); PG8_BAR; PG8_MMA(1, 1, At, B1); PG8_BAR;
            }
        }
        if constexpr (ALIGN_EPI) { if (wr == 0) PG8_BAR; }
        if constexpr (!Epi::AFTER_DRAIN) { E(acc, cur, wr, wc, fr, fq); S.done(cur); }
        if (!has_next) break;
#pragma unroll
        for (int a = 0; a < 2; ++a)
#pragma unroll
            for (int b = 0; b < 2; ++b)
#pragma unroll
                for (int m = 0; m < 4; ++m)
#pragma unroll
                    for (int n = 0; n < 2; ++n) acc[a][b][m][n] = (f32x4){0.f, 0.f, 0.f, 0.f};
        cur = nxt; cA = nA; cB = nB; ++ui;
        if constexpr (ALIGN_EPI) { if (wr == 1) PG8_BAR; }
    }
    PG8_WAIT_V(0);
    if constexpr (!ALIGN_EPI) { if (wr == 0) PG8_BAR; }
    PG8_BAR;
    if constexpr (Epi::AFTER_DRAIN) { E.fused(acc, cur, wr, wc, fr, fq, lds, wid, lane); S.done(cur); }
#undef PG8_SA
#undef PG8_SB
#undef PG8_STAGE
#undef PG8_LDA
#undef PG8_LDB
#undef PG8_MMA
#undef PG8_WAIT_V
#undef PG8_WAIT_L
#undef PG8_BAR
#undef PG8_SCHED
}
}
#define LAS __attribute__((address_space(3)))
typedef unsigned short bf16_t;
typedef short bf16x8 __attribute__((ext_vector_type(8)));
typedef float f32x4 __attribute__((ext_vector_type(4)));
typedef float f32x16 __attribute__((ext_vector_type(16)));
typedef unsigned u32x4 __attribute__((ext_vector_type(4)));
typedef unsigned u32x2 __attribute__((ext_vector_type(2)));

constexpr int SEQ = 16384, NB = 2, T = NB * SEQ, DM = 1024, FF = 2816;
constexpr size_t MiB = 1u << 20;
constexpr size_t WS_W = 0, WS_HN = 48 * MiB, WS_Y = 112 * MiB, WS_R1 = 176 * MiB, WS_VT = 352 * MiB, WS_KN = WS_HN, WS_H16 = 416 * MiB, WS_SM = 480 * MiB, WS_END = 488 * MiB;
constexpr size_t W_GU0 = 0, W_D0 = 11 * MiB, W_GU1 = 17 * MiB, W_D1 = 28 * MiB, W_MIX = 34 * MiB;
constexpr size_t W_IN = W_MIX, W_V = W_MIX + 3 * MiB, W_OUT = W_MIX + 4 * MiB, W_P = W_MIX + 6 * MiB;
constexpr size_t W_MIN = W_MIX, W_QB = W_MIX + 1 * MiB, W_KNW = W_MIX + 2 * MiB, W_VVW = W_MIX + 2 * MiB + 512 * 1024;
constexpr size_t R_Q = 0, R_CQN = 96 * MiB, R_CKVN = 112 * MiB, R_KR = 128 * MiB;
constexpr size_t SM_LF = 0, SM_F = 1 * MiB, SM_KQ = 3 * MiB, SM_CTR = 3 * MiB + 1024, SM_BAR = 3 * MiB + 65536, SM_KQP = 3 * MiB + 131072, SM_CS = 4 * MiB;
constexpr int LDS_BYTES = 147456;
constexpr float LOG2E = 1.4426950408889634f;
constexpr int NPH = 49;
#ifndef PROBE_KMASK
#define PROBE_KMASK 0
#endif
#ifndef EN_MASK
#define EN_MASK 0xFFFF
#endif
#define EN(b) ((EN_MASK >> (b)) & 1)

struct Args {
    const float* x; const int* pos; const float* norm_ffn; const float* norm_mix; const float* norm_final;
    const float* w_gate; const float* w_up; const float* w_down;
    const float* ab_w_in; const float* ab_b_forget; const float* pool_w; const float* pool_scale; const float* ab_w_out;
    const float* mla_w_in; const float* mla_q_norm; const float* mla_kv_norm; const float* mla_w_q_b; const float* mla_w_kv_b; const float* mla_w_out;
    float* out; unsigned char* ws; int ph_lo, ph_hi; int do_sync, pad;
};

__device__ __forceinline__ float wave_sum(float v) {
#pragma unroll
    for (int o = 1; o < 64; o <<= 1) v += __shfl_xor(v, o);
    return v;
}
typedef float f32x2_t __attribute__((ext_vector_type(2))); typedef __bf16 bf16x2_t __attribute__((ext_vector_type(2)));
__device__ __forceinline__ unsigned pk2(float lo, float hi) { f32x2_t v = {lo, hi}; bf16x2_t b = __builtin_convertvector(v, bf16x2_t); return __builtin_bit_cast(unsigned, b); }
__device__ __forceinline__ float bflo(unsigned w) { return __uint_as_float(w << 16); }
__device__ __forceinline__ float bfhi(unsigned w) { return __uint_as_float(w & 0xffff0000u); }
__device__ __forceinline__ float max3f(float a, float b, float c) { float r; asm("v_max3_f32 %0, %1, %2, %3" : "=v"(r) : "v"(a), "v"(b), "v"(c)); return r; }
#define LDS_FENCE() asm volatile("s_waitcnt lgkmcnt(0)" ::: "memory")
#define LBAR() do { asm volatile("s_waitcnt lgkmcnt(0)" ::: "memory"); __builtin_amdgcn_s_barrier(); asm volatile("" ::: "memory"); } while (0)

__device__ __forceinline__ void transpose_item(const float* __restrict__ src, int ld, int k0, bf16_t* __restrict__ dst, int ldd, LAS float* scr, int lane) {
#pragma unroll 8
    for (int i = 0; i < 32; ++i) { const int kk = 2 * i + (lane >> 5); scr[kk * 33 + (lane & 31)] = src[(size_t)(k0 + kk) * ld + (lane & 31)]; }
    LDS_FENCE();
    const int c = lane & 7;
#pragma unroll
    for (int j = 0; j < 4; ++j) { const int n = (lane >> 3) + 8 * j; const LAS float* s = scr + (8 * c) * 33 + n;
        u32x4 o; o.x = pk2(s[0 * 33], s[1 * 33]); o.y = pk2(s[2 * 33], s[3 * 33]); o.z = pk2(s[4 * 33], s[5 * 33]); o.w = pk2(s[6 * 33], s[7 * 33]);
        *(u32x4*)(dst + (size_t)n * ldd + k0 + 8 * c) = o; }
    LDS_FENCE();
}

__device__ __forceinline__ void convert_layer(const Args& A, int l, LAS float* scr, int gw, int NGW, int lane) {
    const int i = l >> 1; const bool even = !(l & 1);
    constexpr int NF = 1408;
    unsigned char* W = A.ws + WS_W;
    const int total = 6 * NF + (even ? (768 + 256 + 512 + 32) : (208 + 192 + 128 + 512));
    for (int it = gw; it < total; it += NGW) {
        int r = it;
        if (r < 6 * NF) {
            const int f = r / (3 * NF), r2 = r % (3 * NF), kind = r2 / NF, q = r2 % NF;
            const size_t wo = (size_t)(l * 2 + f) * DM * FF;
            if (kind < 2) { const int kb = q / 88, nb = q % 88; const float* src = (kind == 0 ? A.w_gate : A.w_up) + wo + 32 * nb;
                bf16_t* dst = (bf16_t*)(W + (f ? W_GU1 : W_GU0)) + (size_t)((nb >> 2) * 256 + (nb & 3) * 32 + kind * 128) * DM;
                transpose_item(src, FF, 64 * kb, dst, DM, scr, lane); }
            else { const int kb = q / 32, nb = q % 32; const float* src = A.w_down + wo + 32 * nb;
                bf16_t* dst = (bf16_t*)(W + (f ? W_D1 : W_D0)) + (size_t)(32 * nb) * FF;
                transpose_item(src, DM, 64 * kb, dst, FF, scr, lane); }
            continue;
        }
        r -= 6 * NF;
        if (even) {
            const float* win = A.ab_w_in + (size_t)i * DM * 2056;
            if (r < 768) { const int kb = r / 48, nb = r % 48; transpose_item(win + 32 * nb, 2056, 64 * kb, (bf16_t*)(W + W_IN) + (size_t)(32 * nb) * DM, DM, scr, lane); continue; } r -= 768;
            if (r < 256) { const int kb = r / 16, nb = r % 16; transpose_item(win + 1536 + 32 * nb, 2056, 64 * kb, (bf16_t*)(W + W_V) + (size_t)(32 * nb) * DM, DM, scr, lane); continue; } r -= 256;
            if (r < 512) { const int kb = r / 32, nb = r % 32; transpose_item(A.ab_w_out + (size_t)i * DM * DM + 32 * nb, DM, 64 * kb, (bf16_t*)(W + W_OUT) + (size_t)(32 * nb) * DM, DM, scr, lane); continue; } r -= 512;
            { const int g = r >> 3, kb = (r & 7) >> 2, nb = r & 3; transpose_item(A.pool_w + (size_t)(i * 4 + g) * 16384 + 32 * nb, 128, 64 * kb, (bf16_t*)(W + W_P) + (size_t)g * 16384 + (size_t)(32 * nb) * 128, 128, scr, lane); }
        } else {
            if (r < 208) { const int kb = r / 13, nb = r % 13; transpose_item(A.mla_w_in + (size_t)i * DM * 416 + 32 * nb, 416, 64 * kb, (bf16_t*)(W + W_MIN) + (size_t)(32 * nb) * DM, DM, scr, lane); continue; } r -= 208;
            if (r < 192) { const int kb = r / 48, nb = r % 48; transpose_item(A.mla_w_q_b + (size_t)i * 256 * 1536 + 32 * nb, 1536, 64 * kb, (bf16_t*)(W + W_QB) + (size_t)(32 * nb) * 256, 256, scr, lane); continue; } r -= 192;
            if (r < 128) { const int kb = r / 64, nb = r % 64; const int col0 = 32 * nb, head = col0 >> 7, within = col0 & 127;
                bf16_t* dst = (within < 64) ? (bf16_t*)(W + W_KNW) + (size_t)(64 * head + within) * 256 : (bf16_t*)(W + W_VVW) + (size_t)(64 * head + within - 64) * 256;
                transpose_item(A.mla_w_kv_b + (size_t)i * 128 * 2048 + col0, 2048, 64 * kb, dst, 256, scr, lane); continue; } r -= 128;
            { const int kb = r / 32, nb = r % 32; transpose_item(A.mla_w_out + (size_t)i * DM * DM + 32 * nb, DM, 64 * kb, (bf16_t*)(W + W_OUT) + (size_t)(32 * nb) * DM, DM, scr, lane); }
        }
    }
    if (!even) {
        const int gt = gw * 64 + lane, NT_ = NGW * 64;
        for (int idx = gt; idx < 2048 * 16; idx += NT_) { const int row = idx >> 4, c = idx & 15;
            *(u32x4*)((bf16_t*)(W + W_KNW) + (size_t)row * 256 + 128 + 8 * c) = (u32x4){0u, 0u, 0u, 0u}; }
    }
}

__constant__ float ROPE_INVF[16] = {(float)1.0, (float)0.5623413251903491, (float)0.31622776601683794, (float)0.1778279410038923, (float)0.1, (float)0.05623413251903491, (float)0.031622776601683794, (float)0.01778279410038923,
    (float)0.01, (float)0.005623413251903491, (float)0.0031622776601683794, (float)0.001778279410038923, (float)0.001, (float)0.0005623413251903491, (float)0.00031622776601683794, (float)0.0001778279410038923};
__device__ __forceinline__ void rope_table(const Args& A, int gw, int NGW, int lane) {
    float* CS = (float*)(A.ws + WS_SM + SM_CS);
    const int gt = gw * 64 + lane, NT_ = NGW * 64;
    for (int idx = gt; idx < T * 16; idx += NT_) {
        const int t = idx >> 4, j = idx & 15;
        const float invf = ROPE_INVF[j];
        const float ang = (float)A.pos[t] * invf;
        const double rev = (double)ang * 0.15915494309189535;
        const float fr = (float)(rev - __builtin_rint(rev));
        CS[(size_t)t * 32 + j] = __builtin_amdgcn_cosf(fr);
        CS[(size_t)t * 32 + 16 + j] = __builtin_amdgcn_sinf(fr);
    }
}

typedef _Float16 h16x4 __attribute__((ext_vector_type(4)));
template <int MODE, bool SRC16>
__device__ __forceinline__ void norm_phase(const void* src, const float* __restrict__ g, bf16_t* dst16, float* dst32,
                                           const float* __restrict__ wfsrc, const float* __restrict__ bforget, float* LF, LAS float* wfT, int gw, int NGW, int lane, int tid) {
    if (MODE == 1) {
        for (int idx = tid; idx < 8192; idx += 512) { const int k = idx >> 3, f = idx & 7; wfT[f * 1024 + k] = wfsrc[(size_t)k * 2056 + 2048 + f]; }
        LDS_FENCE(); __syncthreads();
    }
    f32x4 gv[4];
#pragma unroll
    for (int j = 0; j < 4; ++j) gv[j] = *(const f32x4*)(g + 4 * lane + 256 * j);
    constexpr int NR = (MODE == 1) ? 2 : 4;
    for (int mb = gw * NR; mb < T; mb += NGW * NR) {
        f32x4 v[NR][4]; float ss[NR];
#pragma unroll
        for (int r = 0; r < NR; ++r) {
            if (SRC16) { const h16x4* xr = (const h16x4*)((const _Float16*)src + (size_t)(mb + r) * DM) + lane;
#pragma unroll
                for (int j = 0; j < 4; ++j) v[r][j] = __builtin_convertvector(xr[64 * j], f32x4); }
            else { const f32x4* xr = (const f32x4*)((const float*)src + (size_t)(mb + r) * DM) + lane;
#pragma unroll
                for (int j = 0; j < 4; ++j) v[r][j] = xr[64 * j]; } }
#pragma unroll
        for (int r = 0; r < NR; ++r) { float a = 0.f;
#pragma unroll
            for (int j = 0; j < 4; ++j) a += (v[r][j].x * v[r][j].x + v[r][j].y * v[r][j].y) + (v[r][j].z * v[r][j].z + v[r][j].w * v[r][j].w);
            ss[r] = a; }
#pragma unroll
        for (int o = 1; o < 64; o <<= 1) {
#pragma unroll
            for (int r = 0; r < NR; ++r) ss[r] += __shfl_xor(ss[r], o); }
#pragma unroll
        for (int r = 0; r < NR; ++r) {
            const int m = mb + r;
            const float rstd = 1.0f / sqrtf(ss[r] * (1.0f / DM) + 1e-6f);
#pragma unroll
            for (int j = 0; j < 4; ++j) v[r][j] = v[r][j] * rstd * gv[j];
            if (MODE == 2) {
                f32x4* o = (f32x4*)(dst32 + (size_t)m * DM) + lane;
#pragma unroll
                for (int j = 0; j < 4; ++j) o[64 * j] = v[r][j];
            } else {
                u32x2* o = (u32x2*)(dst16 + (size_t)m * DM) + lane;
#pragma unroll
                for (int j = 0; j < 4; ++j) { u32x2 w; w.x = pk2(v[r][j].x, v[r][j].y); w.y = pk2(v[r][j].z, v[r][j].w); o[64 * j] = w; }
            }
            if (MODE == 1) {
                float mine = 0.f;
#pragma unroll
                for (int f = 0; f < 8; ++f) { float a = 0.f;
#pragma unroll
                    for (int j = 0; j < 4; ++j) { const f32x4 w = *(const LAS f32x4*)(wfT + f * 1024 + 4 * lane + 256 * j); a += (v[r][j].x * w.x + v[r][j].y * w.y) + (v[r][j].z * w.z + v[r][j].w * w.w); }
                    a = wave_sum(a); mine = (lane == f) ? a : mine; }
                if (lane < 8) { const float xx = mine + bforget[lane];
                    const float ax = fabsf(xx); const float sp = __builtin_amdgcn_logf(1.0f + __builtin_amdgcn_exp2f(-ax * LOG2E)) * 0.6931471805599453f;
                    const float ls = (xx < 0.f ? xx : 0.f) - sp;
                    const int b = m / SEQ, t = m % SEQ; LF[(size_t)(b * 8 + lane) * SEQ + t] = ls; }
            }
        }
    }
}

__device__ __forceinline__ void mla_small(const Args& A, int i, int gw, int NGW, int lane) {
    const float* PROJ = (const float*)(A.ws + WS_Y);
    bf16_t* CQN = (bf16_t*)(A.ws + WS_R1 + R_CQN); bf16_t* CKVN = (bf16_t*)(A.ws + WS_R1 + R_CKVN); bf16_t* KR = (bf16_t*)(A.ws + WS_R1 + R_KR);
    const float* CS = (const float*)(A.ws + WS_SM + SM_CS);
    const f32x4 gq = *(const f32x4*)(A.mla_q_norm + (size_t)i * 256 + 4 * lane);
    const f32x4 gk = *(const f32x4*)(A.mla_kv_norm + (size_t)i * 128 + 4 * (lane & 31));
    for (int mb = gw * 4; mb < T; mb += NGW * 4) {
        f32x4 av[4], bv[4];
#pragma unroll
        for (int r = 0; r < 4; ++r) { const float* row = PROJ + (size_t)(mb + r) * 512; av[r] = *(const f32x4*)(row + 4 * lane); bv[r] = (f32x4){0.f, 0.f, 0.f, 0.f}; if (lane < 40) bv[r] = *(const f32x4*)(row + 256 + 4 * lane); }
#pragma unroll
        for (int r = 0; r < 4; ++r) {
            const int m = mb + r; const f32x4 a = av[r], b = bv[r];
            const float sq = wave_sum((a.x * a.x + a.y * a.y) + (a.z * a.z + a.w * a.w));
            const float skv = wave_sum(lane < 32 ? (b.x * b.x + b.y * b.y) + (b.z * b.z + b.w * b.w) : 0.f);
            const float rq = 1.0f / sqrtf(sq * (1.0f / 256.0f) + 1e-6f), rkv = 1.0f / sqrtf(skv * (1.0f / 128.0f) + 1e-6f);
            { const f32x4 y = a * rq * gq; u32x2 w; w.x = pk2(y.x, y.y); w.y = pk2(y.z, y.w); *(u32x2*)(CQN + (size_t)m * 256 + 4 * lane) = w; }
            { const f32x4 y = b * rkv * gk; u32x2 w; w.x = pk2(y.x, y.y); w.y = pk2(y.z, y.w); if (lane >= 32) { w.x = 0u; w.y = 0u; }
              *(u32x2*)(CKVN + (size_t)m * 256 + 4 * lane) = w; }
            f32x4 p; p.x = __shfl_xor(b.x, 4); p.y = __shfl_xor(b.y, 4); p.z = __shfl_xor(b.z, 4); p.w = __shfl_xor(b.w, 4);
            if (lane >= 32 && lane < 40) { const int i0 = 4 * ((lane - 32) & 3);
                const f32x4 c = *(const f32x4*)(CS + (size_t)m * 32 + i0), sn = *(const f32x4*)(CS + (size_t)m * 32 + 16 + i0);
                f32x4 o; if (lane < 36) o = b * c - p * sn; else o = b * c + p * sn;
                u32x2 w; w.x = pk2(o.x, o.y); w.y = pk2(o.z, o.w); *(u32x2*)(KR + (size_t)m * 32 + 4 * (lane - 32)) = w; }
        }
    }
}

template <int WND>
__device__ __forceinline__ void pool_unit(const bf16_t* __restrict__ P, bf16_t* __restrict__ Y, const bf16_t* __restrict__ WP, const float* __restrict__ psc, int g, int rb, int r32, int hi) {
    const int tg = 32 * rb + r32, t = tg & (SEQ - 1);
    const int cnt = (t + 1 < WND) ? (t + 1) : WND; const float inv = 1.0f / (float)cnt;
    const bf16_t* up = P + (size_t)tg * 1536 + 128 * g + 8 * hi;
    const bf16_t* wp = WP + (size_t)g * 16384 + (size_t)r32 * 128 + 8 * hi;
    f32x16 acc0 = {}, acc1 = {}, acc2 = {}, acc3 = {};
#pragma unroll 2
    for (int kk = 0; kk < 8; ++kk) {
        u32x4 w[WND];
#pragma unroll
        for (int j = 0; j < WND; ++j) { w[j] = (u32x4){0u, 0u, 0u, 0u}; if (j < cnt) w[j] = *(const u32x4*)(up - (size_t)j * 1536 + 16 * kk); }
        float s0 = 0.f, s1 = 0.f, s2 = 0.f, s3 = 0.f, s4 = 0.f, s5 = 0.f, s6 = 0.f, s7 = 0.f;
#pragma unroll
        for (int j = 0; j < WND; ++j) { s0 += bflo(w[j].x); s1 += bfhi(w[j].x); s2 += bflo(w[j].y); s3 += bfhi(w[j].y); s4 += bflo(w[j].z); s5 += bfhi(w[j].z); s6 += bflo(w[j].w); s7 += bfhi(w[j].w); }
        u32x4 o; o.x = pk2(s0 * inv - bflo(w[0].x), s1 * inv - bfhi(w[0].x)); o.y = pk2(s2 * inv - bflo(w[0].y), s3 * inv - bfhi(w[0].y));
        o.z = pk2(s4 * inv - bflo(w[0].z), s5 * inv - bfhi(w[0].z)); o.w = pk2(s6 * inv - bflo(w[0].w), s7 * inv - bfhi(w[0].w));
        const bf16x8 af = __builtin_bit_cast(bf16x8, o);
        acc0 = __builtin_amdgcn_mfma_f32_32x32x16_bf16(af, *(const bf16x8*)(wp + 16 * kk), acc0, 0, 0, 0);
        acc1 = __builtin_amdgcn_mfma_f32_32x32x16_bf16(af, *(const bf16x8*)(wp + 32 * 128 + 16 * kk), acc1, 0, 0, 0);
        acc2 = __builtin_amdgcn_mfma_f32_32x32x16_bf16(af, *(const bf16x8*)(wp + 64 * 128 + 16 * kk), acc2, 0, 0, 0);
        acc3 = __builtin_amdgcn_mfma_f32_32x32x16_bf16(af, *(const bf16x8*)(wp + 96 * 128 + 16 * kk), acc3, 0, 0, 0);
    }
    bf16_t* yb = Y + (size_t)(32 * rb + 4 * hi) * DM + 128 * g + r32;
    const float sc0 = psc[128 * g + r32], sc1 = psc[128 * g + 32 + r32], sc2 = psc[128 * g + 64 + r32], sc3 = psc[128 * g + 96 + r32];
#pragma unroll
    for (int r = 0; r < 16; ++r) { bf16_t* yr = yb + (size_t)((r & 3) + 8 * (r >> 2)) * DM;
        yr[0] = (bf16_t)(pk2(acc0[r] * sc0, 0.f) & 0xffffu); yr[32] = (bf16_t)(pk2(acc1[r] * sc1, 0.f) & 0xffffu);
        yr[64] = (bf16_t)(pk2(acc2[r] * sc2, 0.f) & 0xffffu); yr[96] = (bf16_t)(pk2(acc3[r] * sc3, 0.f) & 0xffffu); }
}

__device__ __forceinline__ void scan_pool(const Args& A, int i, LAS unsigned char* lds, int gw, int NGW, int lane, int tid, int wave) {
    for (int item = blockIdx.x; item < 256; item += gridDim.x) {
        const int bh = item >> 4, seg = item & 15;
        const float* lf = (const float*)(A.ws + WS_SM + SM_LF) + (size_t)bh * SEQ; double* Fo = (double*)(A.ws + WS_SM + SM_F) + (size_t)bh * SEQ + seg * 1024;
        LAS double* wt = (LAS double*)lds;
        double pre = 0.0;
        { f32x4 pv[8];
#pragma unroll
          for (int q = 0; q < 8; ++q) { const int c = q * 512 + tid; pv[q] = (f32x4){0.f, 0.f, 0.f, 0.f}; if (c < seg * 256) pv[q] = *(const f32x4*)(lf + 4 * c); }
#pragma unroll
          for (int q = 0; q < 8; ++q) pre += ((double)pv[q].x + (double)pv[q].y) + ((double)pv[q].z + (double)pv[q].w); }
#pragma unroll
        for (int o = 1; o < 64; o <<= 1) pre += __shfl_xor(pre, o);
        const float v0 = lf[seg * 1024 + 2 * tid], v1 = lf[seg * 1024 + 2 * tid + 1];
        const double tot = (double)v0 + (double)v1; double incl = tot;
#pragma unroll
        for (int o = 1; o < 64; o <<= 1) { const double n = __shfl_up(incl, o); if (lane >= o) incl += n; }
        if (lane == 63) { wt[wave] = pre; wt[8 + wave] = incl; }
        LDS_FENCE(); __syncthreads();
        double run = incl - tot;
#pragma unroll
        for (int j = 0; j < 8; ++j) { run += wt[j]; if (j < wave) run += wt[8 + j]; }
        const double o0 = run + (double)v0, o1 = o0 + (double)v1;
        Fo[2 * tid] = o0; Fo[2 * tid + 1] = o1;
        __syncthreads();
    }
    { const bf16_t* Pq = (const bf16_t*)(A.ws + WS_R1); float* KQP = (float*)(A.ws + WS_SM + SM_KQP);
      float mq0 = 0.f, mk0 = 0.f, mq1 = 0.f, mk1 = 0.f;
      for (int mb16 = gw * 16; mb16 < T; mb16 += NGW * 16) {
      float mq = 0.f, mk = 0.f;
#pragma unroll 4
      for (int j = 0; j < 16; ++j) { const size_t m = (size_t)mb16 + j;
          const u32x4 q = *(const u32x4*)(Pq + m * 1536 + 512 + 8 * lane), k = *(const u32x4*)(Pq + m * 1536 + 1024 + 8 * lane);
          float sq = bflo(q.x) * bflo(q.x) + bfhi(q.x) * bfhi(q.x) + bflo(q.y) * bflo(q.y) + bfhi(q.y) * bfhi(q.y) + bflo(q.z) * bflo(q.z) + bfhi(q.z) * bfhi(q.z) + bflo(q.w) * bflo(q.w) + bfhi(q.w) * bfhi(q.w);
          float sk = bflo(k.x) * bflo(k.x) + bfhi(k.x) * bfhi(k.x) + bflo(k.y) * bflo(k.y) + bfhi(k.y) * bfhi(k.y) + bflo(k.z) * bflo(k.z) + bfhi(k.z) * bfhi(k.z) + bflo(k.w) * bflo(k.w) + bfhi(k.w) * bfhi(k.w);
          sq += __shfl_xor(sq, 1); sq += __shfl_xor(sq, 2); sq += __shfl_xor(sq, 4); sk += __shfl_xor(sk, 1); sk += __shfl_xor(sk, 2); sk += __shfl_xor(sk, 4);
          mq = fmaxf(mq, sq); mk = fmaxf(mk, sk); }
      if (mb16 < SEQ) { mq0 = fmaxf(mq0, mq); mk0 = fmaxf(mk0, mk); } else { mq1 = fmaxf(mq1, mq); mk1 = fmaxf(mk1, mk); } }
      LAS float* wm = (LAS float*)lds + 64;
      if ((lane & 7) == 0) { const int h = lane >> 3; wm[wave * 32 + h * 2] = mq0; wm[wave * 32 + h * 2 + 1] = mk0; wm[wave * 32 + 16 + h * 2] = mq1; wm[wave * 32 + 16 + h * 2 + 1] = mk1; }
      LDS_FENCE(); __syncthreads();
      if (tid < 32) { float v = wm[tid];
#pragma unroll
          for (int wv = 1; wv < 8; ++wv) v = fmaxf(v, wm[wv * 32 + tid]);
          KQP[(size_t)blockIdx.x * 32 + tid] = v; }
      __syncthreads(); }
    const bf16_t* P = (const bf16_t*)(A.ws + WS_R1); bf16_t* Y = (bf16_t*)(A.ws + WS_Y); const bf16_t* WP = (const bf16_t*)(A.ws + WS_W + W_P);
    const float* psc = A.pool_scale + (size_t)i * 512;
    const int r32 = lane & 31, hi = lane >> 5;
    for (int u = gw; u < 4096; u += NGW) {
        const int g = (u + (u >> 11)) & 3, rb = u >> 2;
        if (g == 0) pool_unit<2>(P, Y, WP, psc, g, rb, r32, hi);
        else if (g == 1) pool_unit<4>(P, Y, WP, psc, g, rb, r32, hi);
        else if (g == 2) pool_unit<8>(P, Y, WP, psc, g, rb, r32, hi);
        else pool_unit<16>(P, Y, WP, psc, g, rb, r32, hi);
    }
}

template <int DK, bool FOX, bool TRACK>
__device__ __forceinline__ bool attn_unit(LAS unsigned char* lds, const bf16_t* __restrict__ Qp, int ldq, const bf16_t* __restrict__ Kp, int ldk, const bf16_t* __restrict__ Kr,
                                          const bf16_t* __restrict__ VTp, const double* __restrict__ F, const float* __restrict__ CS, bf16_t* Yp, int q0, int tid_in, float acp_thr) {
    int tid = tid_in;
    constexpr int KSTR = DK * 2 + 16, VSTR = 144, KBYTES = 64 * KSTR, VBYTES = 64 * VSTR;
    constexpr int OFF_K = 0, OFF_V = 3 * KBYTES, OFF_FK = OFF_V + 4 * VBYTES, OFF_WS = OFF_FK + 768;
    constexpr int ND = DK / 16;
    asm volatile("" : "+v"(tid));
    const int lane = tid & 63, r32 = lane & 31, hi = lane >> 5, w = __builtin_amdgcn_readfirstlane(tid >> 6);
    const int wrow0 = q0 + 32 * w, trow = wrow0 + r32;
    bf16x8 qf[ND];
#pragma unroll
    for (int d0 = 0; d0 < ND; ++d0) qf[d0] = *(const bf16x8*)(Qp + (size_t)trow * ldq + 16 * d0 + 8 * hi);
    if (!FOX) {
        const u32x4 a = __builtin_bit_cast(u32x4, qf[ND - 2]), b = __builtin_bit_cast(u32x4, qf[ND - 1]);
        const float* cs = CS + (size_t)trow * 32 + 8 * hi;
        const f32x4 c0 = *(const f32x4*)cs, c1 = *(const f32x4*)(cs + 4), s0 = *(const f32x4*)(cs + 16), s1 = *(const f32x4*)(cs + 20);
        const float x1[8] = {bflo(a.x), bfhi(a.x), bflo(a.y), bfhi(a.y), bflo(a.z), bfhi(a.z), bflo(a.w), bfhi(a.w)};
        const float x2[8] = {bflo(b.x), bfhi(b.x), bflo(b.y), bfhi(b.y), bflo(b.z), bfhi(b.z), bflo(b.w), bfhi(b.w)};
        const float cc[8] = {c0.x, c0.y, c0.z, c0.w, c1.x, c1.y, c1.z, c1.w}, sn[8] = {s0.x, s0.y, s0.z, s0.w, s1.x, s1.y, s1.z, s1.w};
        u32x4 oa, ob;
        oa.x = pk2(x1[0] * cc[0] - x2[0] * sn[0], x1[1] * cc[1] - x2[1] * sn[1]); oa.y = pk2(x1[2] * cc[2] - x2[2] * sn[2], x1[3] * cc[3] - x2[3] * sn[3]);
        oa.z = pk2(x1[4] * cc[4] - x2[4] * sn[4], x1[5] * cc[5] - x2[5] * sn[5]); oa.w = pk2(x1[6] * cc[6] - x2[6] * sn[6], x1[7] * cc[7] - x2[7] * sn[7]);
        ob.x = pk2(x2[0] * cc[0] + x1[0] * sn[0], x2[1] * cc[1] + x1[1] * sn[1]); ob.y = pk2(x2[2] * cc[2] + x1[2] * sn[2], x2[3] * cc[3] + x1[3] * sn[3]);
        ob.z = pk2(x2[4] * cc[4] + x1[4] * sn[4], x2[5] * cc[5] + x1[5] * sn[5]); ob.w = pk2(x2[6] * cc[6] + x1[6] * sn[6], x2[7] * cc[7] + x1[7] * sn[7]);
        qf[ND - 2] = __builtin_bit_cast(bf16x8, oa); qf[ND - 1] = __builtin_bit_cast(bf16x8, ob);
    }
    float fq2 = 0.f; double Fref = 0.0;
    if (FOX) { Fref = F[q0]; fq2 = (float)((F[trow] - Fref) * (double)LOG2E); }
    f32x16 o0 = {}, o1 = {}; float mrun = 0.f, lrun = 0.f;
    const int ktmax = (q0 >> 6) + 3, wkt = wrow0 >> 6;
    int kt_lo = 0;
    if (FOX) { const int nq = q0 >> 6; int cnt = 0;
#pragma unroll
        for (int j = 0; j < 4; ++j) { const int kk = lane + 64 * j; bool c = false; if (kk < nq) c = (Fref - F[64 * kk + 63]) * (double)LOG2E < -(double)acp_thr; cnt += __popcll(__ballot(c)); }
        kt_lo = __builtin_amdgcn_readfirstlane(cnt); }
    const int krow = tid >> 3, kch = tid & 7, rrow = (tid >> 2) & 63, rch = tid & 3;
    const unsigned koff = (unsigned)(krow * ldk + kch * 8) * 2u, voff = (unsigned)(krow * T + kch * 8) * 2u, roff = (unsigned)(rrow * 32 + rch * 8) * 2u;
    u32x4 kreg, vreg, rreg = {}, kregB, vregB, rregB = {}; float fkreg = 0.f, fkregB = 0.f;
#define AT_GLOAD_S(kt, KR, VR, RR, FK) do { KR = *(const u32x4*)((const char*)(Kp + (size_t)(kt) * 64 * ldk) + koff); VR = *(const u32x4*)((const char*)(VTp + (size_t)(kt) * 64) + voff); \
        if (!FOX && tid < 256) RR = *(const u32x4*)((const char*)(Kr + (size_t)(kt) * 64 * 32) + roff); \
        if (FOX && tid < 64) FK = -(float)((F[(kt) * 64 + tid] - Fref) * (double)LOG2E); } while (0)
#define AT_LWRITE_S(KT, KR, VR, RR, FK) do { *(LAS u32x4*)(lds + OFF_K + ((KT) % 3) * KBYTES + krow * KSTR + kch * 16) = KR; *(LAS u32x4*)(lds + OFF_V + ((KT) & 3) * VBYTES + krow * VSTR + kch * 16) = VR; \
        if (!FOX && tid < 256) *(LAS u32x4*)(lds + OFF_K + ((KT) % 3) * KBYTES + rrow * KSTR + 128 + rch * 16) = RR; \
        if (FOX && tid < 64) *(LAS float*)(lds + OFF_FK + ((KT) % 3) * 256 + tid * 4) = FK; } while (0)
#define AT_GLOAD(kt) AT_GLOAD_S(kt, kreg, vreg, rreg, fkreg)
#define AT_LWRITE(KT) AT_LWRITE_S(KT, kreg, vreg, rreg, fkreg)
#define AT_STAGE(KT) do { if ((KT) - 2 >= kt_lo) AT_LWRITE((KT) - 2); if ((KT) - 3 >= kt_lo) AT_GLOAD((KT) - 3); } while (0)
    LAS float* wsf = (LAS float*)(lds + OFF_WS) + w * 64;
    const int sig = (r32 & 0x13) | ((r32 & 4) << 1) | ((r32 & 8) >> 1);
#define AT_KFH(KT, H) _Pragma("unroll") for (int d0 = (H) * (ND / 2); d0 < ((H) + 1) * (ND / 2); ++d0) { kf[2 * d0] = *(const LAS bf16x8*)(kb_ + d0 * 32); kf[2 * d0 + 1] = *(const LAS bf16x8*)(kb_ + 32 * KSTR + d0 * 32); }
#define AT_KB(KT) const LAS unsigned char* kb_ = lds + OFF_K + ((KT) % 3) * KBYTES + sig * KSTR + hi * 16; bf16x8 kf[2 * ND];
#define AT_VF(SLOT) const LAS unsigned char* vb_ = lds + OFF_V + (SLOT) * VBYTES + r32 * VSTR + hi * 16; bf16x8 vf[8]; \
    _Pragma("unroll") for (int c = 0; c < 4; ++c) { vf[2 * c] = *(const LAS bf16x8*)(vb_ + 32 * c); vf[2 * c + 1] = *(const LAS bf16x8*)(vb_ + 32 * VSTR + 32 * c); }
#define AT_CINIT(SC0, SC1, KT) do { if (FOX) { const LAS float* fk = (const LAS float*)(lds + OFF_FK + ((KT) % 3) * 256) + 8 * hi; const float cq = fq2 - mrun; \
        const f32x4 a0 = *(const LAS f32x4*)(fk), a1 = *(const LAS f32x4*)(fk + 4), a2 = *(const LAS f32x4*)(fk + 16), a3 = *(const LAS f32x4*)(fk + 20); \
        const f32x4 b0 = *(const LAS f32x4*)(fk + 32), b1 = *(const LAS f32x4*)(fk + 36), b2 = *(const LAS f32x4*)(fk + 48), b3 = *(const LAS f32x4*)(fk + 52); \
        _Pragma("unroll") for (int e = 0; e < 4; ++e) { SC0[e] = a0[e] + cq; SC0[4 + e] = a1[e] + cq; SC0[8 + e] = a2[e] + cq; SC0[12 + e] = a3[e] + cq; \
                                                      SC1[e] = b0[e] + cq; SC1[4 + e] = b1[e] + cq; SC1[8 + e] = b2[e] + cq; SC1[12 + e] = b3[e] + cq; } \
    } else { SC0 = (f32x16){}; SC1 = (f32x16){}; } } while (0)
#define AT_QKH(SC0, SC1, H) do { _Pragma("unroll") for (int d0 = (H) * (ND / 2); d0 < ((H) + 1) * (ND / 2); ++d0) { \
        SC0 = __builtin_amdgcn_mfma_f32_32x32x16_bf16(kf[2 * d0], qf[d0], SC0, 0, 0, 0); SC1 = __builtin_amdgcn_mfma_f32_32x32x16_bf16(kf[2 * d0 + 1], qf[d0], SC1, 0, 0, 0); } } while (0)
#define AT_EXPH(SP) _Pragma("unroll") for (int r = 0; r < 16; ++r) { SP[r] = __builtin_amdgcn_exp2f(SP[r]); ls_ += SP[r]; }
#define AT_PACK(SP0, SP1) u32x4 p0, p1, p2, p3; \
    p0.x = pk2(SP0[0], SP0[1]); p0.y = pk2(SP0[2], SP0[3]); p0.z = pk2(SP0[4], SP0[5]); p0.w = pk2(SP0[6], SP0[7]); \
    p1.x = pk2(SP0[8], SP0[9]); p1.y = pk2(SP0[10], SP0[11]); p1.z = pk2(SP0[12], SP0[13]); p1.w = pk2(SP0[14], SP0[15]); \
    p2.x = pk2(SP1[0], SP1[1]); p2.y = pk2(SP1[2], SP1[3]); p2.z = pk2(SP1[4], SP1[5]); p2.w = pk2(SP1[6], SP1[7]); \
    p3.x = pk2(SP1[8], SP1[9]); p3.y = pk2(SP1[10], SP1[11]); p3.z = pk2(SP1[12], SP1[13]); p3.w = pk2(SP1[14], SP1[15]); \

#define AT_PV() do { const bf16x8 pa0 = __builtin_bit_cast(bf16x8, p0), pa1 = __builtin_bit_cast(bf16x8, p1), pa2 = __builtin_bit_cast(bf16x8, p2), pa3 = __builtin_bit_cast(bf16x8, p3); \
    o0 = __builtin_amdgcn_mfma_f32_32x32x16_bf16(pa0, vf[0], o0, 0, 0, 0); o1 = __builtin_amdgcn_mfma_f32_32x32x16_bf16(pa0, vf[1], o1, 0, 0, 0); \
    o0 = __builtin_amdgcn_mfma_f32_32x32x16_bf16(pa1, vf[2], o0, 0, 0, 0); o1 = __builtin_amdgcn_mfma_f32_32x32x16_bf16(pa1, vf[3], o1, 0, 0, 0); \
    o0 = __builtin_amdgcn_mfma_f32_32x32x16_bf16(pa2, vf[4], o0, 0, 0, 0); o1 = __builtin_amdgcn_mfma_f32_32x32x16_bf16(pa2, vf[5], o1, 0, 0, 0); \
    o0 = __builtin_amdgcn_mfma_f32_32x32x16_bf16(pa3, vf[6], o0, 0, 0, 0); o1 = __builtin_amdgcn_mfma_f32_32x32x16_bf16(pa3, vf[7], o1, 0, 0, 0); } while (0)
#define AT_REL(SC0, SC1) do { if (TRACK && !FOX) { if (__any(mrun != 0.f)) { _Pragma("unroll") for (int r = 0; r < 16; ++r) { SC0[r] -= mrun; SC1[r] -= mrun; } } } } while (0)
#define AT_MAX(SC0, SC1) float mloc; { float ma = max3f(SC0[0], SC0[1], SC1[0]), mb = max3f(SC0[2], SC0[3], SC1[1]); ma = max3f(ma, SC1[2], SC1[3]); \
        _Pragma("unroll") for (int r = 4; r < 16; r += 4) { ma = max3f(ma, SC0[r], SC0[r + 1]); mb = max3f(mb, SC0[r + 2], SC0[r + 3]); ma = max3f(ma, SC1[r], SC1[r + 1]); mb = max3f(mb, SC1[r + 2], SC1[r + 3]); } \
        mloc = max3f(ma, mb, mb); mloc = max3f(mloc, __shfl_xor(mloc, 32), mloc); }
#define AT_DEC(SC0, SC1) do { if (__any(mloc > 12.0f)) { \
        const float dl = fmaxf(mloc, 0.f); mrun += dl; const float alpha = __builtin_amdgcn_exp2f(-dl); lrun *= alpha; \
        _Pragma("unroll") for (int r = 0; r < 16; ++r) { SC0[r] -= dl; SC1[r] -= dl; } \
        if (hi == 0) wsf[r32] = alpha; \
        LDS_FENCE(); \
        _Pragma("unroll") for (int r4 = 0; r4 < 4; ++r4) { const f32x4 al = *(const LAS f32x4*)(wsf + 8 * r4 + 4 * hi); \
            _Pragma("unroll") for (int e = 0; e < 4; ++e) { o0[4 * r4 + e] *= al[e]; o1[4 * r4 + e] *= al[e]; } } \
        LDS_FENCE(); } } while (0)
#define AT_FIRST(SC0, SC1, KT) do { AT_KB(KT); AT_KFH(KT, 0); AT_KFH(KT, 1); AT_CINIT(SC0, SC1, KT); __builtin_amdgcn_sched_barrier(0); AT_QKH(SC0, SC1, 0); AT_QKH(SC0, SC1, 1); __builtin_amdgcn_sched_barrier(0); AT_STAGE(KT); __builtin_amdgcn_sched_barrier(0); \
        AT_REL(SC0, SC1); \
        if (FOX) { const int kv0 = 64 * (KT) + 8 * hi; \
            _Pragma("unroll") for (int r = 0; r < 16; ++r) { const int kv = kv0 + 16 * (r >> 3) + (r & 7); if (kv > trow) SC0[r] = -INFINITY; if (kv + 32 > trow) SC1[r] = -INFINITY; } } \
        if (TRACK) { AT_MAX(SC0, SC1); AT_DEC(SC0, SC1); } } while (0)
#define AT_STEADY(SC0, SC1, SP0, SP1, KT) do { AT_KB(KT); AT_KFH(KT, 0); AT_CINIT(SC0, SC1, KT); float ls_ = 0.f; __builtin_amdgcn_sched_barrier(0); \
        AT_QKH(SC0, SC1, 0); AT_KFH(KT, 1); AT_EXPH(SP0); asm volatile("" : "+v"(SP0), "+v"(ls_)); AT_SGB_QK(); __builtin_amdgcn_sched_barrier(0); AT_STAGE(KT); __builtin_amdgcn_sched_barrier(0); \
        AT_QKH(SC0, SC1, 1); AT_VF(((KT) + 1) & 3); AT_EXPH(SP1); lrun += ls_; AT_PACK(SP0, SP1); asm volatile("" : "+v"(p0), "+v"(p1), "+v"(p2), "+v"(p3), "+v"(lrun)); AT_SGB_QK(); __builtin_amdgcn_sched_barrier(0); \
        AT_REL(SC0, SC1); \
        if (TRACK) { AT_PV(); AT_MAX(SC0, SC1); AT_SGB_PV(); __builtin_amdgcn_sched_barrier(0); AT_DEC(SC0, SC1); } else { AT_PV(); } } while (0)
#define AT_DRAIN(SP0, SP1) do { AT_VF(kt_lo & 3); float ls_ = 0.f; AT_EXPH(SP0); AT_EXPH(SP1); lrun += ls_; AT_PACK(SP0, SP1); AT_PV(); } while (0)
#ifndef AT_HINTS
#define AT_HINTS 1
#endif
#if AT_HINTS
#define AT_SGB_QK() do { _Pragma("unroll") for (int i_ = 0; i_ < ND; ++i_) { __builtin_amdgcn_sched_group_barrier(0x008, 1, 0); __builtin_amdgcn_sched_group_barrier(0x002, (DK == 96 ? 7 : 10), 0); } } while (0)
#define AT_SGB_PV() do { _Pragma("unroll") for (int i_ = 0; i_ < 8; ++i_) { __builtin_amdgcn_sched_group_barrier(0x008, 1, 0); __builtin_amdgcn_sched_group_barrier(0x002, 2, 0); } } while (0)
#else
#define AT_SGB_QK() do {} while (0)
#define AT_SGB_PV() do {} while (0)
#endif
#define AT_STEP_STEADY(SC0, SC1, SP0, SP1, KT) do { const int kt_ = (KT); AT_STEADY(SC0, SC1, SP0, SP1, kt_); LBAR(); } while (0)
    f32x16 sA0 = {}, sA1 = {}, sB0 = {}, sB1 = {};
    LAS unsigned* uflag = (LAS unsigned*)(lds + 100016);
    if (!TRACK && tid == 0) *uflag = 0u;
    AT_GLOAD(ktmax); AT_GLOAD_S(ktmax - 1, kregB, vregB, rregB, fkregB); AT_LWRITE(ktmax); AT_LWRITE_S(ktmax - 1, kregB, vregB, rregB, fkregB); AT_GLOAD(ktmax - 2); LBAR();
    for (int kt = ktmax; kt > wkt; --kt) { AT_STAGE(kt); LBAR(); }
    { AT_FIRST(sA0, sA1, wkt); LBAR(); }
    int kt = wkt - 1;
    for (; kt >= kt_lo + 1; kt -= 2) {
        AT_STEP_STEADY(sB0, sB1, sA0, sA1, kt);
        AT_STEP_STEADY(sA0, sA1, sB0, sB1, kt - 1);
    }
    if (kt == kt_lo) { AT_STEP_STEADY(sB0, sB1, sA0, sA1, kt_lo); AT_DRAIN(sB0, sB1); LBAR(); }
    else { AT_DRAIN(sA0, sA1); LBAR(); }
#undef AT_GLOAD
#undef AT_LWRITE
#undef AT_GLOAD_S
#undef AT_LWRITE_S
#undef AT_STAGE
#undef AT_KFH
#undef AT_KB
#undef AT_QKH
#undef AT_EXPH
#undef AT_PACK
#undef AT_REL
#undef AT_STEP_STEADY
#undef AT_VF
#undef AT_CINIT
#undef AT_QK
#undef AT_SOFT
#undef AT_PV
#undef AT_MAX
#undef AT_DEC
#undef AT_FIRST
#undef AT_STEADY
#undef AT_DRAIN
#undef AT_STEP
    lrun += __shfl_xor(lrun, 32);
    if (hi == 0) wsf[32 + r32] = lrun;
    LDS_FENCE();
#pragma unroll
    for (int r4 = 0; r4 < 4; ++r4) { const f32x4 lv = *(const LAS f32x4*)(wsf + 32 + 8 * r4 + 4 * hi);
#pragma unroll
        for (int e = 0; e < 4; ++e) { const float inv = 1.0f / lv[e]; const int row = wrow0 + e + 8 * r4 + 4 * hi;
            Yp[(size_t)row * DM + r32] = (bf16_t)(pk2(o0[4 * r4 + e] * inv, 0.f) & 0xffffu);
            Yp[(size_t)row * DM + 32 + r32] = (bf16_t)(pk2(o1[4 * r4 + e] * inv, 0.f) & 0xffffu); } }
    LDS_FENCE();
    if (!TRACK) {
        const bool bad = !(lrun > 1e-30f && lrun < 1e30f);
        if (__any(bad)) { if (lane == 0) atomicOr((unsigned*)uflag, 1u); }
        LBAR(); const unsigned f_ = *uflag; LBAR();
        return f_ == 0u;
    }
    return true;
}

#define XB_TMO      128
#define XB_XCNT(j)  (256  + 64 * (j))
#define XB_XSUB(j)  (1280 + 64 * (j))
#define XB_XGEN(j)  (2304 + 64 * (j))
#define XB_TOP      3328
#define XB_TOPGEN   3392
#define XCD_BAR_WORDS 3456
#define XB_SPIN_CAP (1u << 18)

__device__ __forceinline__ unsigned xb_ld(unsigned* p)              { return __hip_atomic_load(p, __ATOMIC_RELAXED, __HIP_MEMORY_SCOPE_AGENT); }
__device__ __forceinline__ unsigned xb_add(unsigned* p, unsigned v) { return __hip_atomic_fetch_add(p, v, __ATOMIC_RELAXED, __HIP_MEMORY_SCOPE_AGENT); }
__device__ __forceinline__ unsigned xb_xcc_id() { return (unsigned)__builtin_amdgcn_s_getreg((3 << 11) | 20) & 0xFu; }
#define XB_SPIN(cond, bar) do { unsigned _sp = 0; while (cond) { __builtin_amdgcn_s_sleep(1); \
    if ((++_sp & 255u) == 0u) { if (xb_ld(&(bar)[XB_TMO])) break; if (_sp > XB_SPIN_CAP) { atomicAdd(&(bar)[XB_TMO], 1u); break; } } } } while (0)

struct XcdBarrier {
    unsigned* bar; unsigned x;
    volatile LAS unsigned* st;
};

__device__ __forceinline__ XcdBarrier xcd_barrier_post(unsigned* bar, volatile LAS unsigned* st) {
    XcdBarrier b; b.bar = bar; b.x = xb_xcc_id(); b.st = st;
    if (threadIdx.x == 0) (void)xb_add(&bar[XB_XCNT(b.x)], 1u);
    return b;
}
__device__ __forceinline__ void xcd_barrier_complete(unsigned* bar, unsigned x, unsigned& nloc, unsigned& nx) {
    const unsigned G = gridDim.x * gridDim.y * gridDim.z;
    unsigned sum, cnt, mine, sp = 0u;
    for (;;) {
        sum = 0u; cnt = 0u; mine = 0u;
#pragma unroll
        for (unsigned j = 0; j < 16; ++j) { const unsigned c = xb_ld(&bar[XB_XCNT(j)]); sum += c; cnt += (c > 0u) ? 1u : 0u; mine = (j == x) ? c : mine; }
        if (sum == G) break;
        __builtin_amdgcn_s_sleep(1);
        if ((++sp & 255u) == 0u) { if (xb_ld(&bar[XB_TMO])) break; if (sp > XB_SPIN_CAP) { atomicAdd(&bar[XB_TMO], 1u); break; } }
    }
    nloc = mine > 0u ? mine : 1u; nx = cnt > 0u ? cnt : 1u;
}

__device__ __forceinline__ void xcd_barrier(const XcdBarrier& b) {
    asm volatile("s_waitcnt vmcnt(0)" ::: "memory");
    __syncthreads();
    if (threadIdx.x == 0) {
        unsigned* bar = b.bar;
        __builtin_amdgcn_s_waitcnt(0);
        unsigned nloc = b.st[0], nx = b.st[1];
        if (nloc == 0u) { xcd_barrier_complete(bar, b.x, nloc, nx); b.st[0] = nloc; b.st[1] = nx; }
        const unsigned old = xb_add(&bar[XB_XSUB(b.x)], 1u);
        const unsigned gen = old / nloc;
        if (old + 1u == (gen + 1u) * nloc) {
            __builtin_amdgcn_fence(__ATOMIC_RELEASE, "agent");
            asm volatile("s_waitcnt vmcnt(0)" ::: "memory");
            const unsigned og = xb_add(&bar[XB_TOP], 1u);
            const unsigned tg = og / nx;
            if (og + 1u == (tg + 1u) * nx) xb_add(&bar[XB_TOPGEN], 1u);
            else XB_SPIN(xb_ld(&bar[XB_TOPGEN]) == tg, bar);
            __builtin_amdgcn_fence(__ATOMIC_ACQUIRE, "agent");
            xb_add(&bar[XB_XGEN(b.x)], 1u);
            asm volatile("s_waitcnt vmcnt(0)" ::: "memory");
        } else {
            XB_SPIN(xb_ld(&bar[XB_XGEN(b.x)]) == gen, bar);
            __builtin_amdgcn_fence(__ATOMIC_ACQUIRE, "agent");
            asm volatile("s_waitcnt vmcnt(0)" ::: "memory");
        }
    }
    __syncthreads();
}

__global__ void __launch_bounds__(512, 2) fwd_mega(Args Akern) {
    extern __shared__ __attribute__((aligned(16))) unsigned char lds_raw[];
    LAS unsigned char* lds = (LAS unsigned char*)lds_raw;
    const int G = gridDim.x, bx = blockIdx.x;
    const int vcu = (G % 8 == 0) ? (bx % 8) * (G / 8) + bx / 8 : bx;
    const int NGW = G * 8;
    const int ph_lo = Akern.ph_lo, ph_hi = Akern.ph_hi, do_sync = Akern.do_sync;
    volatile LAS unsigned* bar_st = (volatile LAS unsigned*)(lds + 140000);
    if (threadIdx.x < 2) bar_st[threadIdx.x] = 0u;
    __syncthreads();
    XcdBarrier xbar; xbar.bar = (unsigned*)(Akern.ws + WS_SM + SM_BAR); xbar.x = 0; xbar.st = nullptr;
    if (do_sync) xbar = xcd_barrier_post((unsigned*)(Akern.ws + WS_SM + SM_BAR), bar_st);
    bool first_sync = true;
#if defined(__HIP_DEVICE_COMPILE__)
    const __attribute__((address_space(4))) Args* Ak = (const __attribute__((address_space(4))) Args*)__builtin_amdgcn_kernarg_segment_ptr();
#else
    const Args* Ak = &Akern;
#endif

#if PROBE_KMASK
    unsigned long long t_acc = 0ull;
#endif
    for (int ph = ph_lo; ph < ph_hi; ++ph) {
#if PROBE_KMASK
        const unsigned long long t_ph0 = __builtin_amdgcn_s_memrealtime();
#endif
        asm volatile("" : "+s"(Ak));
        const Args A = *Ak;
        int tid = threadIdx.x; asm volatile("" : "+v"(tid));
        const int lane = tid & 63, wave = __builtin_amdgcn_readfirstlane(tid >> 6), gw = vcu * 8 + wave;
        unsigned char* ws = A.ws;
        bf16_t* HN = (bf16_t*)(ws + WS_HN); bf16_t* Yb = (bf16_t*)(ws + WS_Y); bf16_t* R1 = (bf16_t*)(ws + WS_R1); bf16_t* VT = (bf16_t*)(ws + WS_VT); bf16_t* KN = (bf16_t*)(ws + WS_KN); _Float16* H16 = (_Float16*)(ws + WS_H16);
        float* LFb = (float*)(ws + WS_SM + SM_LF); const double* Fb = (const double*)(ws + WS_SM + SM_F); const float* CS = (const float*)(ws + WS_SM + SM_CS);
        const int l = ph / 12, k = ph % 12, i = l >> 1; const bool even = !(l & 1);
        bool did = true;
        if (ph == NPH - 1) {
            if (EN(0)) norm_phase<2, true>(H16, A.norm_final, nullptr, A.out, nullptr, nullptr, nullptr, nullptr, gw, NGW, lane, tid);
        } else if (k == 0 || k == 9) {
            const int f = (k == 0) ? 0 : 1;
            if (EN(1)) if (k == 0) { convert_layer(A, l, (LAS float*)(lds + wave * 16384), gw, NGW, lane); if (l == 0) rope_table(A, gw, NGW, lane); }
            if (l == 0 && k == 0) norm_phase<0, false>(A.x, A.norm_ffn + (size_t)(l * 2 + f) * DM, HN, nullptr, nullptr, nullptr, nullptr, nullptr, gw, NGW, lane, tid);
            else norm_phase<0, true>(H16, A.norm_ffn + (size_t)(l * 2 + f) * DM, HN, nullptr, nullptr, nullptr, nullptr, nullptr, gw, NGW, lane, tid);
        } else if (k == 1 || k == 10) {
            const int f = (k == 1) ? 0 : 1;
            pg8::Gemm g{HN, (const bf16_t*)(ws + WS_W + (f ? W_GU1 : W_GU0)), T, 2 * FF, DM}; pg8::StaticOrder S; S.init(T, 2 * FF, G, bx);
            pg8::EpiSwiglu E{R1, FF};
            if (EN(2)) pg8::gemm_phase<pg8::EpiSwiglu, pg8::StaticOrder, true, true>(lds, g, S, E);
        } else if (k == 4 && !even) {
            pg8::Gemm g{HN, (const bf16_t*)(ws + WS_W + W_MIN), T, 512, DM}; pg8::StaticOrder S; S.init(T, 512, G, bx);
            pg8::EpiMlaIn E{(bf16_t*)(ws + WS_R1 + R_CQN), (bf16_t*)(ws + WS_R1 + R_CKVN), (bf16_t*)(ws + WS_R1 + R_KR), A.mla_q_norm + (size_t)i * 256, A.mla_kv_norm + (size_t)i * 128, CS};
            pg8::gemm_phase<pg8::EpiMlaIn, pg8::StaticOrder, false, true>(lds, g, S, E);
        } else if (k == 2 || k == 11 || k == 8) {
            pg8::Gemm g; pg8::EpiResF32 E;
            if (k == 2 || k == 11) { const int f = (k == 2) ? 0 : 1; g = pg8::Gemm{R1, (const bf16_t*)(ws + WS_W + (f ? W_D1 : W_D0)), T, DM, FF};
                if (l == 0 && k == 2) E = pg8::EpiResF32{A.x, H16, DM, 0.5f, 1}; else E = pg8::EpiResF32{H16, H16, DM, 0.5f, 0}; }
            else if (k == 8) { g = pg8::Gemm{Yb, (const bf16_t*)(ws + WS_W + W_OUT), T, DM, DM}; E = pg8::EpiResF32{H16, H16, DM, 1.0f, 0}; }
            else { g = pg8::Gemm{Yb, (const bf16_t*)(ws + WS_W + W_OUT), T, DM, DM}; E = pg8::EpiResF32{H16, H16, DM, 1.0f, 0}; }
            pg8::StaticOrder S; S.init(g.M, g.N, G, bx);
            if (EN(3)) pg8::gemm_phase<pg8::EpiResF32, pg8::StaticOrder, true, true>(lds, g, S, E);
        } else if (k == 3) {
            if (even && bx == 0 && tid < 64) { ((unsigned*)(ws + WS_SM + SM_KQ))[tid] = 0u; if (tid == 0) *(unsigned*)(ws + WS_SM + SM_CTR) = 0u; }
            if (!EN(4)) {} else if (even) norm_phase<1, true>(H16, A.norm_mix + (size_t)l * DM, HN, nullptr, A.ab_w_in + (size_t)i * DM * 2056, A.ab_b_forget + (size_t)i * 8, LFb, (LAS float*)lds, gw, NGW, lane, tid);
            else norm_phase<0, true>(H16, A.norm_mix + (size_t)l * DM, HN, nullptr, nullptr, nullptr, nullptr, nullptr, gw, NGW, lane, tid);
        } else if ((k == 4 && even) || (k == 6 && !even)) {
            const int ng = even ? 2 : 3;
            for (int j = 0; j < ng; ++j) {
                pg8::Gemm g; pg8::EpiBf16S E;
                if (even) {
                    if (j == 0) { g = pg8::Gemm{HN, (const bf16_t*)(ws + WS_W + W_IN), T, 1536, DM}; E = pg8::EpiBf16S{R1, 1536, 512, 1024, 0.125f * LOG2E}; }
                    else { g = pg8::Gemm{(const bf16_t*)(ws + WS_W + W_V), HN, 512, T, DM}; E = pg8::EpiBf16S{VT, T, 0, 0, 1.0f}; }
                } else {
                    if (j == 0) { g = pg8::Gemm{(const bf16_t*)(ws + WS_R1 + R_CQN), (const bf16_t*)(ws + WS_W + W_QB), T, 1536, 256}; E = pg8::EpiBf16S{R1, 1536, 0, 1536, 0.10206207261596577f * LOG2E}; }
                    else if (j == 1) { g = pg8::Gemm{(const bf16_t*)(ws + WS_R1 + R_CKVN), (const bf16_t*)(ws + WS_W + W_KNW), T, 1024, 256}; E = pg8::EpiBf16S{KN, 1024, 0, 0, 1.0f}; }
                    else { g = pg8::Gemm{(const bf16_t*)(ws + WS_W + W_VVW), (const bf16_t*)(ws + WS_R1 + R_CKVN), 1024, T, 256}; E = pg8::EpiBf16S{VT, T, 0, 0, 1.0f}; }
                }
                pg8::StaticOrder S; S.init(g.M, g.N, G, bx);
                if (EN(5)) pg8::gemm_phase<pg8::EpiBf16S, pg8::StaticOrder, true, true>(lds, g, S, E);
                __syncthreads();
            }
        } else if (k == 5) {
            if (!EN(6)) {} else if (even) scan_pool(A, i, lds, gw, NGW, lane, tid, wave);
            else did = false;
        } else if (k == 7) {
            if (even) {
                unsigned* ctr = (unsigned*)(ws + WS_SM + SM_CTR); const unsigned* KQ = (const unsigned*)(ws + WS_SM + SM_KQ);
                LAS unsigned* qslot = (LAS unsigned*)(lds + 100000);
                for (;;) {
                    if (tid == 0) qslot[0] = atomicAdd(ctr, 1u);
                    LBAR(); const unsigned u = qslot[0]; LBAR();
                    if (u >= 1024u) break;
                    const int qb = 63 - (int)(u >> 4), bh = (int)(u & 15u), b = bh >> 3, h = bh & 7;
                    float mq_ = 0.f, mk_ = 0.f;
                    { const float* KQP = (const float*)(ws + WS_SM + SM_KQP) + (bh >> 3) * 16 + (bh & 7) * 2;
                      for (int x = lane; x < G; x += 64) { mq_ = fmaxf(mq_, KQP[(size_t)x * 32]); mk_ = fmaxf(mk_, KQP[(size_t)x * 32 + 1]); }
#pragma unroll
                      for (int o = 1; o < 64; o <<= 1) { mq_ = fmaxf(mq_, __shfl_xor(mq_, o)); mk_ = fmaxf(mk_, __shfl_xor(mk_, o)); } }
                    const float thr = 2.0f * sqrtf(mq_ * mk_) + 48.0f;
                    if (!attn_unit<64, true, false>(lds, R1 + (size_t)(b * SEQ) * 1536 + 512 + 64 * h, 1536, R1 + (size_t)(b * SEQ) * 1536 + 1024 + 64 * h, 1536, nullptr,
                                        VT + (size_t)(64 * h) * T + (size_t)b * SEQ, Fb + (size_t)bh * SEQ, nullptr, Yb + (size_t)(b * SEQ) * DM + 512 + 64 * h, qb * 256, tid, thr)) attn_unit<64, true, true>(lds, R1 + (size_t)(b * SEQ) * 1536 + 512 + 64 * h, 1536, R1 + (size_t)(b * SEQ) * 1536 + 1024 + 64 * h, 1536, nullptr,
                                        VT + (size_t)(64 * h) * T + (size_t)b * SEQ, Fb + (size_t)bh * SEQ, nullptr, Yb + (size_t)(b * SEQ) * DM + 512 + 64 * h, qb * 256, tid, thr);
                }
            } else {
                for (int p = vcu; p < 32 * 32; p += G) { const int bh = p >> 5, s = p & 31, b = bh >> 4, h = bh & 15;
                    for (int z = 0; z < 2; ++z) { const int qb = z ? s : 63 - s;
                        if (!attn_unit<96, false, false>(lds, R1 + (size_t)(b * SEQ) * 1536 + 96 * h, 1536, KN + (size_t)(b * SEQ) * 1024 + 64 * h, 1024, (const bf16_t*)(ws + WS_R1 + R_KR) + (size_t)(b * SEQ) * 32,
                                             VT + (size_t)(64 * h) * T + (size_t)b * SEQ, nullptr, CS + (size_t)(b * SEQ) * 32, Yb + (size_t)(b * SEQ) * DM + 64 * h, qb * 256, tid, 0.f)) attn_unit<96, false, true>(lds, R1 + (size_t)(b * SEQ) * 1536 + 96 * h, 1536, KN + (size_t)(b * SEQ) * 1024 + 64 * h, 1024, (const bf16_t*)(ws + WS_R1 + R_KR) + (size_t)(b * SEQ) * 32,
                                             VT + (size_t)(64 * h) * T + (size_t)b * SEQ, nullptr, CS + (size_t)(b * SEQ) * 32, Yb + (size_t)(b * SEQ) * DM + 64 * h, qb * 256, tid, 0.f); } }
            }
        } else did = false;
        if (did && ph + 1 < ph_hi) { if (do_sync) { if (first_sync) { cg::this_grid().sync(); first_sync = false; } else xcd_barrier(xbar); } }
#if PROBE_KMASK
        { const int kk_ = (ph == NPH - 1) ? 12 : (ph % 12); if ((PROBE_KMASK >> kk_) & 1) t_acc += __builtin_amdgcn_s_memrealtime() - t_ph0; }
        if (ph == NPH - 1 && blockIdx.x == 0 && (threadIdx.x >> 6) == 0) {
            const int M_ = (int)(t_acc / 200ull) > 8192 ? 8192 : (int)(t_acc / 200ull);
            for (int idx = threadIdx.x & 63; idx < M_; idx += 64) A.out[(size_t)(idx >> 10) * NGW * DM + (idx & 1023)] += 0.05f;
        }
#endif
    }
}

extern "C" void kernel_launch(void* const* d_in, const int* in_sizes, int n_in, void* d_out, int out_size, void* d_ws, size_t ws_size, hipStream_t stream) {
    static int grid = 0;
    if (grid == 0) {
        if (n_in != 19 || out_size != T * DM || ws_size < WS_END) { fprintf(stderr, "kernel_launch: unexpected shapes (n_in %d out %d ws %zu)\n", n_in, out_size, ws_size); grid = -1; return; }
        int dev = 0, cus = 0, per_cu = 0;
        hipGetDevice(&dev); hipDeviceGetAttribute(&cus, hipDeviceAttributeMultiprocessorCount, dev);
        if (hipFuncSetAttribute((const void*)fwd_mega, hipFuncAttributeMaxDynamicSharedMemorySize, LDS_BYTES) != hipSuccess) { fprintf(stderr, "kernel_launch: hipFuncSetAttribute failed\n"); grid = -1; return; }
        if (hipOccupancyMaxActiveBlocksPerMultiprocessor(&per_cu, (const void*)fwd_mega, 512, LDS_BYTES) != hipSuccess || per_cu < 1) { fprintf(stderr, "kernel_launch: occupancy query says %d\n", per_cu); per_cu = 1; }
        (void)hipGetLastError();
        grid = cus * 1;
    }
    if (grid < 0) return;
    Args a{};
    a.x = (const float*)d_in[0]; a.pos = (const int*)d_in[1]; a.norm_ffn = (const float*)d_in[2]; a.norm_mix = (const float*)d_in[3]; a.norm_final = (const float*)d_in[4];
    a.w_gate = (const float*)d_in[5]; a.w_up = (const float*)d_in[6]; a.w_down = (const float*)d_in[7];
    a.ab_w_in = (const float*)d_in[8]; a.ab_b_forget = (const float*)d_in[9]; a.pool_w = (const float*)d_in[10]; a.pool_scale = (const float*)d_in[11]; a.ab_w_out = (const float*)d_in[12];
    a.mla_w_in = (const float*)d_in[13]; a.mla_q_norm = (const float*)d_in[14]; a.mla_kv_norm = (const float*)d_in[15]; a.mla_w_q_b = (const float*)d_in[16]; a.mla_w_kv_b = (const float*)d_in[17]; a.mla_w_out = (const float*)d_in[18];
    a.out = (float*)d_out; a.ws = (unsigned char*)d_ws; a.pad = 0;
#if ONE_LAUNCH
    a.ph_lo = 0; a.ph_hi = NPH; a.do_sync = 1;
    if (hipMemsetAsync((char*)d_ws + WS_SM + SM_BAR, 0, XCD_BAR_WORDS * 4, stream) != hipSuccess) { fprintf(stderr, "kernel_launch: memset of the barrier words failed\n"); return; }
    void* args[] = {&a};
    hipError_t e = hipLaunchCooperativeKernel((const void*)fwd_mega, dim3(grid), dim3(512), args, LDS_BYTES, stream);
    if (e != hipSuccess) fprintf(stderr, "cooperative launch failed: %s (grid %d)\n", hipGetErrorString(e), grid);
#else
    for (int ph = 0; ph < NPH; ++ph) {
        const int l = ph / 12, k = ph % 12; if (ph != NPH - 1 && k == 6 && !(l & 1)) continue;
        a.ph_lo = ph; a.ph_hi = ph + 1; a.do_sync = 0;
        hipLaunchKernelGGL(fwd_mega, dim3(grid), dim3(512), LDS_BYTES, stream, a);
    }
#endif
}
```

```cpp
#include <hip/hip_runtime.h>
#include <hip/hip_cooperative_groups.h>
#include <cstdio>
#include <cstdint>
namespace cg = cooperative_groups;
#ifndef ONE_LAUNCH
#define ONE_LAUNCH 1
#endif
namespace pg8 {
#define PG8_LAS __attribute__((address_space(3)))
typedef unsigned short bf16_t;
typedef short bf16x8 __attribute__((ext_vector_type(8)));
typedef float f32x4 __attribute__((ext_vector_type(4)));
typedef unsigned u32x4 __attribute__((ext_vector_type(4)));
constexpr int BM = 256, BK = 64, HALF = 128, HTB = HALF * BK * 2  , STAGE_BYTES = 8 * HTB, NXCD = 8, WGM = 8;

__host__ __device__ __forceinline__ int lds_byte(int r, int c) { const int st = (r >> 4) * 2 + (c >> 5), rr = r & 15, cc = c & 31, ob = rr * 64 + cc * 2; return st * 1024 + (ob ^ (((ob >> 9) & 1) << 5)); }
__host__ __device__ __forceinline__ void stage_rc(int b, int& R, int& C) { const int st = b / 1024, sb = b % 1024, swz = sb ^ (((sb >> 9) & 1) << 5); R = (st >> 1) * 16 + swz / 64; C = (st & 1) * 32 + (swz % 64) / 2; }
__host__ __device__ __forceinline__ int perm32(int rho) { const int n = rho >> 4, i = rho & 15; return 8 * (i >> 2) + 4 * n + (i & 3); }

struct Unit { int pm, pn; };
struct Gemm { const bf16_t* A; const bf16_t* Bt; int M, N, K; };

struct StaticOrder {
    int nM, nN, nwg, G, c;
    __host__ __device__ void init(int M, int N, int G_, int c_) { nM = M / BM; nN = N / BM; nwg = nM * nN; G = G_; c = c_; }
    __host__ __device__ bool next(int i, Unit& u) const {
        const long L = (long)i * G + c; if (L >= nwg) return false;
        int wgid = (int)L; { const int q = nwg / NXCD, r = nwg % NXCD, xcd = wgid % NXCD, off = wgid / NXCD; wgid = (xcd < r ? xcd * (q + 1) : r * (q + 1) + (xcd - r) * q) + off; }
        const int nig = WGM * nN, gid = wgid / nig, fm = gid * WGM, gsz = (nM - fm) < WGM ? (nM - fm) : WGM;
        u.pm = fm + ((wgid % nig) % gsz); u.pn = (wgid % nig) / gsz; return true;
    }
    __device__ __forceinline__ void a_ready(const Unit&) const {}
    __device__ __forceinline__ void done(const Unit&) const {}
};
__device__ __forceinline__ unsigned cvt_pk_bf16(float lo, float hi) { unsigned r; asm volatile("v_cvt_pk_bf16_f32 %0, %1, %2" : "=v"(r) : "v"(lo), "v"(hi)); return r; }
typedef float f32x2 __attribute__((ext_vector_type(2)));
struct EpiBf16S {
    static constexpr bool PERM = true, AFTER_DRAIN = false;
    bf16_t* O; int ldc; int sc_lo, sc_hi; float scale;
    __device__ __forceinline__ void operator()(const f32x4 (&acc)[2][2][4][2], const Unit& u, int wr, int wc, int fr, int fq) const {
        const int row0 = u.pm * BM + wr * 64 + fr; const int colt = u.pn * BM;
        const float sc = (colt >= sc_lo && colt < sc_hi) ? scale : 1.f;
        const int col0 = colt + wc * 32 + 8 * fq;
#pragma unroll
        for (int ai = 0; ai < 2; ++ai)
#pragma unroll
            for (int m = 0; m < 4; ++m) { bf16_t* rowp = O + (size_t)(row0 + ai * HALF + m * 16) * ldc + col0;
#pragma unroll
                for (int bj = 0; bj < 2; ++bj) { const f32x4 v0 = acc[ai][bj][m][0] * sc, v1 = acc[ai][bj][m][1] * sc;
                    u32x4 w; w.x = cvt_pk_bf16(v0[0], v0[1]); w.y = cvt_pk_bf16(v0[2], v0[3]); w.z = cvt_pk_bf16(v1[0], v1[1]); w.w = cvt_pk_bf16(v1[2], v1[3]);
                    *(u32x4*)(rowp + bj * HALF) = w; } }
    }
};
struct EpiSwiglu {
    static constexpr bool PERM = true, AFTER_DRAIN = false;
    bf16_t* O; int ldc;
    __device__ __forceinline__ void operator()(const f32x4 (&acc)[2][2][4][2], const Unit& u, int wr, int wc, int fr, int fq) const {
        const int row0 = u.pm * BM + wr * 64 + fr; const int col0 = u.pn * HALF + wc * 32 + 8 * fq;
#pragma unroll
        for (int ai = 0; ai < 2; ++ai)
#pragma unroll
            for (int m = 0; m < 4; ++m) { bf16_t* rowp = O + (size_t)(row0 + ai * HALF + m * 16) * ldc + col0;
                float a[8];
#pragma unroll
                for (int n = 0; n < 2; ++n)
#pragma unroll
                    for (int e = 0; e < 4; ++e) { const float g = acc[ai][0][m][n][e], up = acc[ai][1][m][n][e];
                        const float sg = g * __builtin_amdgcn_rcpf(1.0f + __builtin_amdgcn_exp2f(-1.4426950408889634f * g)); a[n * 4 + e] = sg * up; }
                u32x4 w; w.x = cvt_pk_bf16(a[0], a[1]); w.y = cvt_pk_bf16(a[2], a[3]); w.z = cvt_pk_bf16(a[4], a[5]); w.w = cvt_pk_bf16(a[6], a[7]);
                *(u32x4*)rowp = w; }
    }
};
typedef _Float16 f16x4 __attribute__((ext_vector_type(4)));
typedef _Float16 f16x8 __attribute__((ext_vector_type(8)));
typedef float f32x8 __attribute__((ext_vector_type(8)));
struct EpiResF32 {
    static constexpr bool PERM = true, AFTER_DRAIN = false;
    const void* base; _Float16* out; int ldc; float alpha; int base32;
    __device__ __forceinline__ void operator()(const f32x4 (&acc)[2][2][4][2], const Unit& u, int wr, int wc, int fr, int fq) const {
        const int col0 = u.pn * BM + wc * 32 + 8 * fq;
#pragma unroll
        for (int ai = 0; ai < 2; ++ai) {
            f32x8 pre[4][2];
#pragma unroll
            for (int m = 0; m < 4; ++m) { const size_t off = (size_t)(u.pm * BM + ai * HALF + wr * 64 + m * 16 + fr) * ldc + col0;
#pragma unroll
                for (int bj = 0; bj < 2; ++bj) {
                    if (base32) { const f32x4 lo = *(const f32x4*)((const float*)base + off + bj * HALF), hi4 = *(const f32x4*)((const float*)base + off + bj * HALF + 4);
                        pre[m][bj] = (f32x8){lo[0], lo[1], lo[2], lo[3], hi4[0], hi4[1], hi4[2], hi4[3]}; }
                    else pre[m][bj] = __builtin_convertvector(*(const f16x8*)((const _Float16*)base + off + bj * HALF), f32x8); } }
            asm volatile("" ::: "memory");
#pragma unroll
            for (int m = 0; m < 4; ++m) { const size_t off = (size_t)(u.pm * BM + ai * HALF + wr * 64 + m * 16 + fr) * ldc + col0;
#pragma unroll
                for (int bj = 0; bj < 2; ++bj) { const f32x4 a0 = acc[ai][bj][m][0] * alpha, a1 = acc[ai][bj][m][1] * alpha; const f32x8 p = pre[m][bj];
                    const f32x8 o = {a0[0] + p[0], a0[1] + p[1], a0[2] + p[2], a0[3] + p[3], a1[0] + p[4], a1[1] + p[5], a1[2] + p[6], a1[3] + p[7]};
                    *(f16x8*)(out + off + bj * HALF) = __builtin_convertvector(o, f16x8); } }
            asm volatile("" ::: "memory");
        }
    }
};

struct EpiMlaIn {
    static constexpr bool PERM = false, AFTER_DRAIN = true;
    bf16_t* cqn; bf16_t* ckvn; bf16_t* kr; const float* qn; const float* kvn; const float* cs;
    __device__ __forceinline__ void fused(f32x4 (&acc)[2][2][4][2], const Unit& u, int wr, int wc, int fr, int fq, PG8_LAS unsigned char* lds, int wid, int lane) const {
        typedef unsigned u32x2_t __attribute__((ext_vector_type(2)));
        PG8_LAS float* P = (PG8_LAS float*)lds;
        const bool isq = (u.pn == 0);
#pragma unroll
        for (int ai = 0; ai < 2; ++ai)
#pragma unroll
            for (int m = 0; m < 4; ++m) { float s = 0.f;
#pragma unroll
                for (int n = 0; n < 2; ++n) { const f32x4 x = acc[ai][0][m][n]; s += (x[0] * x[0] + x[1] * x[1]) + (x[2] * x[2] + x[3] * x[3]); }
                if (isq) {
#pragma unroll
                    for (int n = 0; n < 2; ++n) { const f32x4 x = acc[ai][1][m][n]; s += (x[0] * x[0] + x[1] * x[1]) + (x[2] * x[2] + x[3] * x[3]); } }
                s += __shfl_xor(s, 16); s += __shfl_xor(s, 32);
                if (fq == 0) P[(ai * HALF + wr * 64 + m * 16 + fr) * 4 + wc] = s; }
        asm volatile("s_waitcnt lgkmcnt(0)" ::: "memory"); __builtin_amdgcn_s_barrier(); asm volatile("" ::: "memory");
#pragma unroll
        for (int ai = 0; ai < 2; ++ai)
#pragma unroll
            for (int m = 0; m < 4; ++m) { const int rl = ai * HALF + wr * 64 + m * 16 + fr; const size_t r = (size_t)u.pm * BM + rl;
                const f32x4 p4 = *(const PG8_LAS f32x4*)(P + rl * 4); const float ss = (p4[0] + p4[1]) + (p4[2] + p4[3]);
                if (isq) { const float rstd = 1.0f / sqrtf(ss * (1.0f / 256.0f) + 1e-6f);
#pragma unroll
                    for (int bj = 0; bj < 2; ++bj)
#pragma unroll
                        for (int n = 0; n < 2; ++n) { const int c = bj * HALF + wc * 32 + n * 16 + 4 * fq; const f32x4 g4 = *(const f32x4*)(qn + c); const f32x4 y = acc[ai][bj][m][n] * rstd * g4;
                            u32x2_t w; w.x = cvt_pk_bf16(y[0], y[1]); w.y = cvt_pk_bf16(y[2], y[3]); *(u32x2_t*)(cqn + r * 256 + c) = w; }
                } else { const float rstd = 1.0f / sqrtf(ss * (1.0f / 128.0f) + 1e-6f);
#pragma unroll
                    for (int n = 0; n < 2; ++n) { const int c = wc * 32 + n * 16 + 4 * fq; const f32x4 g4 = *(const f32x4*)(kvn + c); const f32x4 y = acc[ai][0][m][n] * rstd * g4;
                        u32x2_t w; w.x = cvt_pk_bf16(y[0], y[1]); w.y = cvt_pk_bf16(y[2], y[3]); *(u32x2_t*)(ckvn + r * 256 + c) = w;
                        u32x2_t z; z.x = 0u; z.y = 0u; *(u32x2_t*)(ckvn + r * 256 + HALF + c) = z; }
                    if (wc == 0) { const int i0 = 4 * fq; const f32x4 x1 = acc[ai][1][m][0], x2 = acc[ai][1][m][1];
                        const f32x4 c4 = *(const f32x4*)(cs + r * 32 + i0), s4 = *(const f32x4*)(cs + r * 32 + 16 + i0);
                        const f32x4 o1 = x1 * c4 - x2 * s4, o2 = x2 * c4 + x1 * s4;
                        u32x2_t w1, w2; w1.x = cvt_pk_bf16(o1[0], o1[1]); w1.y = cvt_pk_bf16(o1[2], o1[3]); w2.x = cvt_pk_bf16(o2[0], o2[1]); w2.y = cvt_pk_bf16(o2[2], o2[3]);
                        *(u32x2_t*)(kr + r * 32 + i0) = w1; *(u32x2_t*)(kr + r * 32 + 16 + i0) = w2; } } }
        asm volatile("s_waitcnt lgkmcnt(0)" ::: "memory"); __builtin_amdgcn_s_barrier(); asm volatile("" ::: "memory");
    }
};

template <class Epi, class Sched, bool ALIGN_EPI = false, bool SP2 = false>
__device__ __forceinline__ void gemm_phase(PG8_LAS unsigned char* lds, const Gemm g, const Sched& S, const Epi& E) {
    int tid_l = threadIdx.x; asm volatile("" : "+v"(tid_l));
    const int tid = tid_l, wid = __builtin_amdgcn_readfirstlane(tid >> 6), lane = tid & 63, wr = wid >> 2, wc = wid & 3, fr = lane & 15, fq = lane >> 4;
    const int K = g.K, nt = K / BK;
    unsigned voffA[2], voffB[2];
#pragma unroll
    for (int i = 0; i < 2; ++i) { int R, C; stage_rc(tid * 16 + i * 8192, R, C); const int Rb = Epi::PERM ? ((R & ~31) + perm32(R & 31)) : R;
        voffA[i] = (unsigned)(R * K + C) * 2u; voffB[i] = (unsigned)(Rb * K + C) * 2u; }
    const size_t kstep = (size_t)(BK * 2);
    const size_t hstep = (size_t)HALF * K * 2;
    const size_t tstep = 2 * hstep;
    const unsigned ldsw = (unsigned)wid * 1024u;
    const int aoff = lds_byte(wr * 64 + fr, fq * 8), boff = lds_byte(wc * 32 + fr, fq * 8);
#define PG8_SA(b, h) (((b) * 2 + (h)) * HTB)
#define PG8_SB(b, h) ((4 + (b) * 2 + (h)) * HTB)
#define PG8_STAGE(bufoff, gbase, voff) do { _Pragma("unroll") for (int _i = 0; _i < 2; ++_i) \
        __builtin_amdgcn_global_load_lds((const unsigned*)((const char*)(gbase) + (voff)[_i]), (PG8_LAS unsigned*)(lds + (bufoff) + ldsw + _i * 8192), 16, 0, 0); } while (0)
#define PG8_LDA(dst, b, h) do { _Pragma("unroll") for (int m = 0; m < 4; ++m) _Pragma("unroll") for (int k = 0; k < 2; ++k) dst[m][k] = *(const PG8_LAS bf16x8*)(lds + PG8_SA(b, h) + aoff + m * 2048 + k * 1024); } while (0)
#define PG8_LDB(dst, b, h) do { _Pragma("unroll") for (int n = 0; n < 2; ++n) _Pragma("unroll") for (int k = 0; k < 2; ++k) dst[n][k] = *(const PG8_LAS bf16x8*)(lds + PG8_SB(b, h) + boff + n * 2048 + k * 1024); } while (0)
#define PG8_MMA(ai, bj, At, Bt) do { __builtin_amdgcn_s_setprio(1); _Pragma("unroll") for (int m = 0; m < 4; ++m) _Pragma("unroll") for (int n = 0; n < 2; ++n) _Pragma("unroll") for (int k = 0; k < 2; ++k) \
        acc[ai][bj][m][n] = __builtin_amdgcn_mfma_f32_16x16x32_bf16(Bt[n][k], At[m][k], acc[ai][bj][m][n], 0, 0, 0); __builtin_amdgcn_s_setprio(0); } while (0)
#define PG8_WAIT_V(n) asm volatile("s_waitcnt vmcnt(" #n ")" ::: "memory")
#define PG8_WAIT_L(n) asm volatile("s_waitcnt lgkmcnt(" #n ")" ::: "memory")
#define PG8_BAR __builtin_amdgcn_s_barrier()
#define PG8_SCHED __builtin_amdgcn_sched_barrier(0)
    Unit cur, nxt; int ui = 0;
    if (!S.next(0, cur)) return;
    f32x4 acc[2][2][4][2];
#pragma unroll
    for (int a = 0; a < 2; ++a)
#pragma unroll
        for (int b = 0; b < 2; ++b)
#pragma unroll
            for (int m = 0; m < 4; ++m)
#pragma unroll
                for (int n = 0; n < 2; ++n) acc[a][b][m][n] = (f32x4){0.f, 0.f, 0.f, 0.f};
    bf16x8 At[4][2], B0[2][2], B1[2][2];
    const char* cA = (const char*)g.A + (size_t)cur.pm * tstep; const char* cB = (const char*)g.Bt + (size_t)cur.pn * tstep;
    S.a_ready(cur);
    if constexpr (SP2) {
        PG8_STAGE(PG8_SB(0, 0), cB, voffB); PG8_STAGE(PG8_SB(0, 1), cB + hstep, voffB); PG8_STAGE(PG8_SA(0, 0), cA, voffA); PG8_STAGE(PG8_SA(0, 1), cA + hstep, voffA);
        if (wr == 1) PG8_BAR;
        PG8_WAIT_V(2); PG8_BAR;
        PG8_STAGE(PG8_SB(1, 0), cB + kstep, voffB); PG8_STAGE(PG8_SA(1, 0), cA + kstep, voffA); PG8_STAGE(PG8_SB(1, 1), cB + hstep + kstep, voffB);
        PG8_WAIT_V(6); PG8_BAR;
    } else {
        PG8_STAGE(PG8_SB(0, 0), cB, voffB); PG8_STAGE(PG8_SA(0, 0), cA, voffA); PG8_STAGE(PG8_SB(0, 1), cB + hstep, voffB); PG8_STAGE(PG8_SA(0, 1), cA + hstep, voffA);
        if (wr == 1) PG8_BAR;
        PG8_WAIT_V(4); PG8_BAR;
        PG8_STAGE(PG8_SB(1, 0), cB + kstep, voffB); PG8_STAGE(PG8_SA(1, 0), cA + kstep, voffA); PG8_STAGE(PG8_SB(1, 1), cB + hstep + kstep, voffB);
        PG8_WAIT_V(6); PG8_BAR;
    }
    for (;;) {
        const bool has_next = S.next(ui + 1, nxt);
        const char* nA = has_next ? (const char*)g.A + (size_t)nxt.pm * tstep : cA; const char* nB = has_next ? (const char*)g.Bt + (size_t)nxt.pn * tstep : cB;
        for (int t = 0; t < nt; t += 2) {
            const bool last = (t == nt - 2);
            const char* a1 = cA + (size_t)(t + 1) * kstep;
            const char* a2 = last ? nA : cA + (size_t)(t + 2) * kstep; const char* b2 = last ? nB : cB + (size_t)(t + 2) * kstep;
            const char* a3 = a2 + kstep; const char* b3 = b2 + kstep;
            if (last && has_next) S.a_ready(nxt);
            if constexpr (SP2) {
            PG8_LDB(B0, 0, 0); PG8_LDB(B1, 0, 1); PG8_SCHED; PG8_LDA(At, 0, 0); PG8_STAGE(PG8_SA(1, 1), a1 + hstep, voffA);
            PG8_WAIT_V(8); PG8_WAIT_L(0); PG8_BAR; PG8_MMA(0, 0, At, B0); PG8_MMA(0, 1, At, B1); PG8_BAR; PG8_SCHED;
            PG8_LDA(At, 0, 1); PG8_STAGE(PG8_SB(0, 0), b2, voffB); PG8_STAGE(PG8_SB(0, 1), b2 + hstep, voffB); PG8_STAGE(PG8_SA(0, 0), a2, voffA);
            PG8_WAIT_V(8); PG8_WAIT_L(0); PG8_BAR; PG8_MMA(1, 0, At, B0); PG8_MMA(1, 1, At, B1); PG8_BAR; PG8_SCHED;
            PG8_LDB(B0, 1, 0); PG8_LDB(B1, 1, 1); PG8_SCHED; PG8_LDA(At, 1, 0); PG8_STAGE(PG8_SA(0, 1), a2 + hstep, voffA);
            PG8_WAIT_V(8); PG8_WAIT_L(0); PG8_BAR; PG8_MMA(0, 0, At, B0); PG8_MMA(0, 1, At, B1); PG8_BAR; PG8_SCHED;
            PG8_LDA(At, 1, 1); PG8_STAGE(PG8_SB(1, 0), b3, voffB); PG8_STAGE(PG8_SB(1, 1), b3 + hstep, voffB); PG8_STAGE(PG8_SA(1, 0), a3, voffA);
            PG8_WAIT_V(8); PG8_WAIT_L(0); PG8_BAR; PG8_MMA(1, 0, At, B0); PG8_MMA(1, 1, At, B1); PG8_BAR; PG8_SCHED;
            } else {
            PG8_LDB(B0, 0, 0); PG8_SCHED; PG8_LDA(At, 0, 0); PG8_STAGE(PG8_SA(1, 1), a1 + hstep, voffA);
            PG8_WAIT_L(8); PG8_BAR; PG8_WAIT_L(0); PG8_MMA(0, 0, At, B0); PG8_BAR; PG8_SCHED;
            PG8_LDB(B1, 0, 1); PG8_STAGE(PG8_SB(0, 0), b2, voffB);
            PG8_BAR; PG8_WAIT_L(0); PG8_MMA(0, 1, At, B1); PG8_BAR;
            PG8_LDA(At, 0, 1); PG8_STAGE(PG8_SA(0, 0), a2, voffA);
            PG8_BAR; PG8_WAIT_L(0); PG8_MMA(1, 0, At, B0); PG8_BAR; PG8_SCHED;
            PG8_STAGE(PG8_SB(0, 1), b2 + hstep, voffB);
            PG8_WAIT_V(6); PG8_BAR; PG8_MMA(1, 1, At, B1); PG8_BAR;
            PG8_LDB(B0, 1, 0); PG8_SCHED; PG8_LDA(At, 1, 0); PG8_STAGE(PG8_SA(0, 1), a2 + hstep, voffA);
            PG8_WAIT_L(8); PG8_BAR; PG8_WAIT_L(0); PG8_MMA(0, 0, At, B0); PG8_BAR; PG8_SCHED;
            PG8_LDB(B1, 1, 1); PG8_STAGE(PG8_SB(1, 0), b3, voffB);
            PG8_BAR; PG8_WAIT_L(0); PG8_MMA(0, 1, At, B1); PG8_BAR;
            PG8_LDA(At, 1, 1); PG8_STAGE(PG8_SA(1, 0), a3, voffA);
            PG8_BAR; PG8_WAIT_L(0); PG8_MMA(1, 0, At, B0); PG8_BAR; PG8_SCHED;
            PG8_STAGE(PG8_SB(1, 1), b3 + hstep, voffB);
            PG8_WAIT_V(6); PG8_BAR; PG8_MMA(1, 1, At, B1); PG8_BAR;
            }
        }
        if constexpr (ALIGN_EPI) { if (wr == 0) PG8_BAR; }
        if constexpr (!Epi::AFTER_DRAIN) { E(acc, cur, wr, wc, fr, fq); S.done(cur); }
        if (!has_next) break;
#pragma unroll
        for (int a = 0; a < 2; ++a)
#pragma unroll
            for (int b = 0; b < 2; ++b)
#pragma unroll
                for (int m = 0; m < 4; ++m)
#pragma unroll
                    for (int n = 0; n < 2; ++n) acc[a][b][m][n] = (f32x4){0.f, 0.f, 0.f, 0.f};
        cur = nxt; cA = nA; cB = nB; ++ui;
        if constexpr (ALIGN_EPI) { if (wr == 1) PG8_BAR; }
    }
    PG8_WAIT_V(0);
    if constexpr (!ALIGN_EPI) { if (wr == 0) PG8_BAR; }
    PG8_BAR;
    if constexpr (Epi::AFTER_DRAIN) { E.fused(acc, cur, wr, wc, fr, fq, lds, wid, lane); S.done(cur); }
#undef PG8_SA
#undef PG8_SB
#undef PG8_STAGE
#undef PG8_LDA
#undef PG8_LDB
#undef PG8_MMA
#undef PG8_WAIT_V
#undef PG8_WAIT_L
#undef PG8_BAR
#undef PG8_SCHED
}
}
#define LAS __attribute__((address_space(3)))
typedef unsigned short bf16_t;
typedef short bf16x8 __attribute__((ext_vector_type(8)));
typedef float f32x4 __attribute__((ext_vector_type(4)));
typedef float f32x16 __attribute__((ext_vector_type(16)));
typedef unsigned u32x4 __attribute__((ext_vector_type(4)));
typedef unsigned u32x2 __attribute__((ext_vector_type(2)));

constexpr int SEQ = 16384, NB = 2, T = NB * SEQ, DM = 1024, FF = 2816;
constexpr size_t MiB = 1u << 20;
constexpr size_t WS_W = 0, WS_HN = 48 * MiB, WS_Y = 112 * MiB, WS_R1 = 176 * MiB, WS_VT = 352 * MiB, WS_KN = WS_HN, WS_H16 = 416 * MiB, WS_SM = 480 * MiB, WS_END = 488 * MiB;
constexpr size_t W_GU0 = 0, W_D0 = 11 * MiB, W_GU1 = 17 * MiB, W_D1 = 28 * MiB, W_MIX = 34 * MiB;
constexpr size_t W_IN = W_MIX, W_V = W_MIX + 3 * MiB, W_OUT = W_MIX + 4 * MiB, W_P = W_MIX + 6 * MiB;
constexpr size_t W_MIN = W_MIX, W_QB = W_MIX + 1 * MiB, W_KNW = W_MIX + 2 * MiB, W_VVW = W_MIX + 2 * MiB + 512 * 1024;
constexpr size_t R_Q = 0, R_CQN = 96 * MiB, R_CKVN = 112 * MiB, R_KR = 128 * MiB;
constexpr size_t SM_LF = 0, SM_F = 1 * MiB, SM_KQ = 3 * MiB, SM_CTR = 3 * MiB + 1024, SM_BAR = 3 * MiB + 65536, SM_KQP = 3 * MiB + 131072, SM_CS = 4 * MiB;
constexpr int LDS_BYTES = 147456;
constexpr float LOG2E = 1.4426950408889634f;
constexpr int NPH = 49;
#ifndef PROBE_KMASK
#define PROBE_KMASK 0
#endif
#ifndef EN_MASK
#define EN_MASK 0xFFFF
#endif
#define EN(b) ((EN_MASK >> (b)) & 1)

struct Args {
    const float* x; const int* pos; const float* norm_ffn; const float* norm_mix; const float* norm_final;
    const float* w_gate; const float* w_up; const float* w_down;
    const float* ab_w_in; const float* ab_b_forget; const float* pool_w; const float* pool_scale; const float* ab_w_out;
    const float* mla_w_in; const float* mla_q_norm; const float* mla_kv_norm; const float* mla_w_q_b; const float* mla_w_kv_b; const float* mla_w_out;
    float* out; unsigned char* ws; int ph_lo, ph_hi; int do_sync, pad;
};

__device__ __forceinline__ float wave_sum(float v) {
#pragma unroll
    for (int o = 1; o < 64; o <<= 1) v += __shfl_xor(v, o);
    return v;
}
typedef float f32x2_t __attribute__((ext_vector_type(2))); typedef __bf16 bf16x2_t __attribute__((ext_vector_type(2)));
__device__ __forceinline__ unsigned pk2(float lo, float hi) { f32x2_t v = {lo, hi}; bf16x2_t b = __builtin_convertvector(v, bf16x2_t); return __builtin_bit_cast(unsigned, b); }
__device__ __forceinline__ float bflo(unsigned w) { return __uint_as_float(w << 16); }
__device__ __forceinline__ float bfhi(unsigned w) { return __uint_as_float(w & 0xffff0000u); }
__device__ __forceinline__ float max3f(float a, float b, float c) { float r; asm("v_max3_f32 %0, %1, %2, %3" : "=v"(r) : "v"(a), "v"(b), "v"(c)); return r; }
#define LDS_FENCE() asm volatile("s_waitcnt lgkmcnt(0)" ::: "memory")
#define LBAR() do { asm volatile("s_waitcnt lgkmcnt(0)" ::: "memory"); __builtin_amdgcn_s_barrier(); asm volatile("" ::: "memory"); } while (0)

__device__ __forceinline__ void transpose_item(const float* __restrict__ src, int ld, int k0, bf16_t* __restrict__ dst, int ldd, LAS float* scr, int lane) {
#pragma unroll 8
    for (int i = 0; i < 32; ++i) { const int kk = 2 * i + (lane >> 5); scr[kk * 33 + (lane & 31)] = src[(size_t)(k0 + kk) * ld + (lane & 31)]; }
    LDS_FENCE();
    const int c = lane & 7;
#pragma unroll
    for (int j = 0; j < 4; ++j) { const int n = (lane >> 3) + 8 * j; const LAS float* s = scr + (8 * c) * 33 + n;
        u32x4 o; o.x = pk2(s[0 * 33], s[1 * 33]); o.y = pk2(s[2 * 33], s[3 * 33]); o.z = pk2(s[4 * 33], s[5 * 33]); o.w = pk2(s[6 * 33], s[7 * 33]);
        *(u32x4*)(dst + (size_t)n * ldd + k0 + 8 * c) = o; }
    LDS_FENCE();
}

__device__ __forceinline__ void convert_layer(const Args& A, int l, LAS float* scr, int gw, int NGW, int lane) {
    const int i = l >> 1; const bool even = !(l & 1);
    constexpr int NF = 1408;
    unsigned char* W = A.ws + WS_W;
    const int total = 6 * NF + (even ? (768 + 256 + 512 + 32) : (208 + 192 + 128 + 512));
    for (int it = gw; it < total; it += NGW) {
        int r = it;
        if (r < 6 * NF) {
            const int f = r / (3 * NF), r2 = r % (3 * NF), kind = r2 / NF, q = r2 % NF;
            const size_t wo = (size_t)(l * 2 + f) * DM * FF;
            if (kind < 2) { const int kb = q / 88, nb = q % 88; const float* src = (kind == 0 ? A.w_gate : A.w_up) + wo + 32 * nb;
                bf16_t* dst = (bf16_t*)(W + (f ? W_GU1 : W_GU0)) + (size_t)((nb >> 2) * 256 + (nb & 3) * 32 + kind * 128) * DM;
                transpose_item(src, FF, 64 * kb, dst, DM, scr, lane); }
            else { const int kb = q / 32, nb = q % 32; const float* src = A.w_down + wo + 32 * nb;
                bf16_t* dst = (bf16_t*)(W + (f ? W_D1 : W_D0)) + (size_t)(32 * nb) * FF;
                transpose_item(src, DM, 64 * kb, dst, FF, scr, lane); }
            continue;
        }
        r -= 6 * NF;
        if (even) {
            const float* win = A.ab_w_in + (size_t)i * DM * 2056;
            if (r < 768) { const int kb = r / 48, nb = r % 48; transpose_item(win + 32 * nb, 2056, 64 * kb, (bf16_t*)(W + W_IN) + (size_t)(32 * nb) * DM, DM, scr, lane); continue; } r -= 768;
            if (r < 256) { const int kb = r / 16, nb = r % 16; transpose_item(win + 1536 + 32 * nb, 2056, 64 * kb, (bf16_t*)(W + W_V) + (size_t)(32 * nb) * DM, DM, scr, lane); continue; } r -= 256;
            if (r < 512) { const int kb = r / 32, nb = r % 32; transpose_item(A.ab_w_out + (size_t)i * DM * DM + 32 * nb, DM, 64 * kb, (bf16_t*)(W + W_OUT) + (size_t)(32 * nb) * DM, DM, scr, lane); continue; } r -= 512;
            { const int g = r >> 3, kb = (r & 7) >> 2, nb = r & 3; transpose_item(A.pool_w + (size_t)(i * 4 + g) * 16384 + 32 * nb, 128, 64 * kb, (bf16_t*)(W + W_P) + (size_t)g * 16384 + (size_t)(32 * nb) * 128, 128, scr, lane); }
        } else {
            if (r < 208) { const int kb = r / 13, nb = r % 13; transpose_item(A.mla_w_in + (size_t)i * DM * 416 + 32 * nb, 416, 64 * kb, (bf16_t*)(W + W_MIN) + (size_t)(32 * nb) * DM, DM, scr, lane); continue; } r -= 208;
            if (r < 192) { const int kb = r / 48, nb = r % 48; transpose_item(A.mla_w_q_b + (size_t)i * 256 * 1536 + 32 * nb, 1536, 64 * kb, (bf16_t*)(W + W_QB) + (size_t)(32 * nb) * 256, 256, scr, lane); continue; } r -= 192;
            if (r < 128) { const int kb = r / 64, nb = r % 64; const int col0 = 32 * nb, head = col0 >> 7, within = col0 & 127;
                bf16_t* dst = (within < 64) ? (bf16_t*)(W + W_KNW) + (size_t)(64 * head + within) * 256 : (bf16_t*)(W + W_VVW) + (size_t)(64 * head + within - 64) * 256;
                transpose_item(A.mla_w_kv_b + (size_t)i * 128 * 2048 + col0, 2048, 64 * kb, dst, 256, scr, lane); continue; } r -= 128;
            { const int kb = r / 32, nb = r % 32; transpose_item(A.mla_w_out + (size_t)i * DM * DM + 32 * nb, DM, 64 * kb, (bf16_t*)(W + W_OUT) + (size_t)(32 * nb) * DM, DM, scr, lane); }
        }
    }
    if (!even) {
        const int gt = gw * 64 + lane, NT_ = NGW * 64;
        for (int idx = gt; idx < 2048 * 16; idx += NT_) { const int row = idx >> 4, c = idx & 15;
            *(u32x4*)((bf16_t*)(W + W_KNW) + (size_t)row * 256 + 128 + 8 * c) = (u32x4){0u, 0u, 0u, 0u}; }
    }
}

__constant__ float ROPE_INVF[16] = {(float)1.0, (float)0.5623413251903491, (float)0.31622776601683794, (float)0.1778279410038923, (float)0.1, (float)0.05623413251903491, (float)0.031622776601683794, (float)0.01778279410038923,
    (float)0.01, (float)0.005623413251903491, (float)0.0031622776601683794, (float)0.001778279410038923, (float)0.001, (float)0.0005623413251903491, (float)0.00031622776601683794, (float)0.0001778279410038923};
__device__ __forceinline__ void rope_table(const Args& A, int gw, int NGW, int lane) {
    float* CS = (float*)(A.ws + WS_SM + SM_CS);
    const int gt = gw * 64 + lane, NT_ = NGW * 64;
    for (int idx = gt; idx < T * 16; idx += NT_) {
        const int t = idx >> 4, j = idx & 15;
        const float invf = ROPE_INVF[j];
        const float ang = (float)A.pos[t] * invf;
        const double rev = (double)ang * 0.15915494309189535;
        const float fr = (float)(rev - __builtin_rint(rev));
        CS[(size_t)t * 32 + j] = __builtin_amdgcn_cosf(fr);
        CS[(size_t)t * 32 + 16 + j] = __builtin_amdgcn_sinf(fr);
    }
}

typedef _Float16 h16x4 __attribute__((ext_vector_type(4)));
template <int MODE, bool SRC16>
__device__ __forceinline__ void norm_phase(const void* src, const float* __restrict__ g, bf16_t* dst16, float* dst32,
                                           const float* __restrict__ wfsrc, const float* __restrict__ bforget, float* LF, LAS float* wfT, int gw, int NGW, int lane, int tid) {
    if (MODE == 1) {
        for (int idx = tid; idx < 8192; idx += 512) { const int k = idx >> 3, f = idx & 7; wfT[f * 1024 + k] = wfsrc[(size_t)k * 2056 + 2048 + f]; }
        LDS_FENCE(); __syncthreads();
    }
    f32x4 gv[4];
#pragma unroll
    for (int j = 0; j < 4; ++j) gv[j] = *(const f32x4*)(g + 4 * lane + 256 * j);
    constexpr int NR = (MODE == 1) ? 2 : 4;
    for (int mb = gw * NR; mb < T; mb += NGW * NR) {
        f32x4 v[NR][4]; float ss[NR];
#pragma unroll
        for (int r = 0; r < NR; ++r) {
            if (SRC16) { const h16x4* xr = (const h16x4*)((const _Float16*)src + (size_t)(mb + r) * DM) + lane;
#pragma unroll
                for (int j = 0; j < 4; ++j) v[r][j] = __builtin_convertvector(xr[64 * j], f32x4); }
            else { const f32x4* xr = (const f32x4*)((const float*)src + (size_t)(mb + r) * DM) + lane;
#pragma unroll
                for (int j = 0; j < 4; ++j) v[r][j] = xr[64 * j]; } }
#pragma unroll
        for (int r = 0; r < NR; ++r) { float a = 0.f;
#pragma unroll
            for (int j = 0; j < 4; ++j) a += (v[r][j].x * v[r][j].x + v[r][j].y * v[r][j].y) + (v[r][j].z * v[r][j].z + v[r][j].w * v[r][j].w);
            ss[r] = a; }
#pragma unroll
        for (int o = 1; o < 64; o <<= 1) {
#pragma unroll
            for (int r = 0; r < NR; ++r) ss[r] += __shfl_xor(ss[r], o); }
#pragma unroll
        for (int r = 0; r < NR; ++r) {
            const int m = mb + r;
            const float rstd = 1.0f / sqrtf(ss[r] * (1.0f / DM) + 1e-6f);
#pragma unroll
            for (int j = 0; j < 4; ++j) v[r][j] = v[r][j] * rstd * gv[j];
            if (MODE == 2) {
                f32x4* o = (f32x4*)(dst32 + (size_t)m * DM) + lane;
#pragma unroll
                for (int j = 0; j < 4; ++j) o[64 * j] = v[r][j];
            } else {
                u32x2* o = (u32x2*)(dst16 + (size_t)m * DM) + lane;
#pragma unroll
                for (int j = 0; j < 4; ++j) { u32x2 w; w.x = pk2(v[r][j].x, v[r][j].y); w.y = pk2(v[r][j].z, v[r][j].w); o[64 * j] = w; }
            }
            if (MODE == 1) {
                float mine = 0.f;
#pragma unroll
                for (int f = 0; f < 8; ++f) { float a = 0.f;
#pragma unroll
                    for (int j = 0; j < 4; ++j) { const f32x4 w = *(const LAS f32x4*)(wfT + f * 1024 + 4 * lane + 256 * j); a += (v[r][j].x * w.x + v[r][j].y * w.y) + (v[r][j].z * w.z + v[r][j].w * w.w); }
                    a = wave_sum(a); mine = (lane == f) ? a : mine; }
                if (lane < 8) { const float xx = mine + bforget[lane];
                    const float ax = fabsf(xx); const float sp = __builtin_amdgcn_logf(1.0f + __builtin_amdgcn_exp2f(-ax * LOG2E)) * 0.6931471805599453f;
                    const float ls = (xx < 0.f ? xx : 0.f) - sp;
                    const int b = m / SEQ, t = m % SEQ; LF[(size_t)(b * 8 + lane) * SEQ + t] = ls; }
            }
        }
    }
}

__device__ __forceinline__ void mla_small(const Args& A, int i, int gw, int NGW, int lane) {
    const float* PROJ = (const float*)(A.ws + WS_Y);
    bf16_t* CQN = (bf16_t*)(A.ws + WS_R1 + R_CQN); bf16_t* CKVN = (bf16_t*)(A.ws + WS_R1 + R_CKVN); bf16_t* KR = (bf16_t*)(A.ws + WS_R1 + R_KR);
    const float* CS = (const float*)(A.ws + WS_SM + SM_CS);
    const f32x4 gq = *(const f32x4*)(A.mla_q_norm + (size_t)i * 256 + 4 * lane);
    const f32x4 gk = *(const f32x4*)(A.mla_kv_norm + (size_t)i * 128 + 4 * (lane & 31));
    for (int mb = gw * 4; mb < T; mb += NGW * 4) {
        f32x4 av[4], bv[4];
#pragma unroll
        for (int r = 0; r < 4; ++r) { const float* row = PROJ + (size_t)(mb + r) * 512; av[r] = *(const f32x4*)(row + 4 * lane); bv[r] = (f32x4){0.f, 0.f, 0.f, 0.f}; if (lane < 40) bv[r] = *(const f32x4*)(row + 256 + 4 * lane); }
#pragma unroll
        for (int r = 0; r < 4; ++r) {
            const int m = mb + r; const f32x4 a = av[r], b = bv[r];
            const float sq = wave_sum((a.x * a.x + a.y * a.y) + (a.z * a.z + a.w * a.w));
            const float skv = wave_sum(lane < 32 ? (b.x * b.x + b.y * b.y) + (b.z * b.z + b.w * b.w) : 0.f);
            const float rq = 1.0f / sqrtf(sq * (1.0f / 256.0f) + 1e-6f), rkv = 1.0f / sqrtf(skv * (1.0f / 128.0f) + 1e-6f);
            { const f32x4 y = a * rq * gq; u32x2 w; w.x = pk2(y.x, y.y); w.y = pk2(y.z, y.w); *(u32x2*)(CQN + (size_t)m * 256 + 4 * lane) = w; }
            { const f32x4 y = b * rkv * gk; u32x2 w; w.x = pk2(y.x, y.y); w.y = pk2(y.z, y.w); if (lane >= 32) { w.x = 0u; w.y = 0u; }
              *(u32x2*)(CKVN + (size_t)m * 256 + 4 * lane) = w; }
            f32x4 p; p.x = __shfl_xor(b.x, 4); p.y = __shfl_xor(b.y, 4); p.z = __shfl_xor(b.z, 4); p.w = __shfl_xor(b.w, 4);
            if (lane >= 32 && lane < 40) { const int i0 = 4 * ((lane - 32) & 3);
                const f32x4 c = *(const f32x4*)(CS + (size_t)m * 32 + i0), sn = *(const f32x4*)(CS + (size_t)m * 32 + 16 + i0);
                f32x4 o; if (lane < 36) o = b * c - p * sn; else o = b * c + p * sn;
                u32x2 w; w.x = pk2(o.x, o.y); w.y = pk2(o.z, o.w); *(u32x2*)(KR + (size_t)m * 32 + 4 * (lane - 32)) = w; }
        }
    }
}

template <int WND>
__device__ __forceinline__ void pool_unit(const bf16_t* __restrict__ P, bf16_t* __restrict__ Y, const bf16_t* __restrict__ WP, const float* __restrict__ psc, int g, int rb, int r32, int hi) {
    const int tg = 32 * rb + r32, t = tg & (SEQ - 1);
    const int cnt = (t + 1 < WND) ? (t + 1) : WND; const float inv = 1.0f / (float)cnt;
    const bf16_t* up = P + (size_t)tg * 1536 + 128 * g + 8 * hi;
    const bf16_t* wp = WP + (size_t)g * 16384 + (size_t)r32 * 128 + 8 * hi;
    f32x16 acc0 = {}, acc1 = {}, acc2 = {}, acc3 = {};
#pragma unroll 2
    for (int kk = 0; kk < 8; ++kk) {
        u32x4 w[WND];
#pragma unroll
        for (int j = 0; j < WND; ++j) { w[j] = (u32x4){0u, 0u, 0u, 0u}; if (j < cnt) w[j] = *(const u32x4*)(up - (size_t)j * 1536 + 16 * kk); }
        float s0 = 0.f, s1 = 0.f, s2 = 0.f, s3 = 0.f, s4 = 0.f, s5 = 0.f, s6 = 0.f, s7 = 0.f;
#pragma unroll
        for (int j = 0; j < WND; ++j) { s0 += bflo(w[j].x); s1 += bfhi(w[j].x); s2 += bflo(w[j].y); s3 += bfhi(w[j].y); s4 += bflo(w[j].z); s5 += bfhi(w[j].z); s6 += bflo(w[j].w); s7 += bfhi(w[j].w); }
        u32x4 o; o.x = pk2(s0 * inv - bflo(w[0].x), s1 * inv - bfhi(w[0].x)); o.y = pk2(s2 * inv - bflo(w[0].y), s3 * inv - bfhi(w[0].y));
        o.z = pk2(s4 * inv - bflo(w[0].z), s5 * inv - bfhi(w[0].z)); o.w = pk2(s6 * inv - bflo(w[0].w), s7 * inv - bfhi(w[0].w));
        const bf16x8 af = __builtin_bit_cast(bf16x8, o);
        acc0 = __builtin_amdgcn_mfma_f32_32x32x16_bf16(af, *(const bf16x8*)(wp + 16 * kk), acc0, 0, 0, 0);
        acc1 = __builtin_amdgcn_mfma_f32_32x32x16_bf16(af, *(const bf16x8*)(wp + 32 * 128 + 16 * kk), acc1, 0, 0, 0);
        acc2 = __builtin_amdgcn_mfma_f32_32x32x16_bf16(af, *(const bf16x8*)(wp + 64 * 128 + 16 * kk), acc2, 0, 0, 0);
        acc3 = __builtin_amdgcn_mfma_f32_32x32x16_bf16(af, *(const bf16x8*)(wp + 96 * 128 + 16 * kk), acc3, 0, 0, 0);
    }
    bf16_t* yb = Y + (size_t)(32 * rb + 4 * hi) * DM + 128 * g + r32;
    const float sc0 = psc[128 * g + r32], sc1 = psc[128 * g + 32 + r32], sc2 = psc[128 * g + 64 + r32], sc3 = psc[128 * g + 96 + r32];
#pragma unroll
    for (int r = 0; r < 16; ++r) { bf16_t* yr = yb + (size_t)((r & 3) + 8 * (r >> 2)) * DM;
        yr[0] = (bf16_t)(pk2(acc0[r] * sc0, 0.f) & 0xffffu); yr[32] = (bf16_t)(pk2(acc1[r] * sc1, 0.f) & 0xffffu);
        yr[64] = (bf16_t)(pk2(acc2[r] * sc2, 0.f) & 0xffffu); yr[96] = (bf16_t)(pk2(acc3[r] * sc3, 0.f) & 0xffffu); }
}

__device__ __forceinline__ void scan_pool(const Args& A, int i, LAS unsigned char* lds, int gw, int NGW, int lane, int tid, int wave) {
    for (int item = blockIdx.x; item < 256; item += gridDim.x) {
        const int bh = item >> 4, seg = item & 15;
        const float* lf = (const float*)(A.ws + WS_SM + SM_LF) + (size_t)bh * SEQ; double* Fo = (double*)(A.ws + WS_SM + SM_F) + (size_t)bh * SEQ + seg * 1024;
        LAS double* wt = (LAS double*)lds;
        double pre = 0.0;
        { f32x4 pv[8];
#pragma unroll
          for (int q = 0; q < 8; ++q) { const int c = q * 512 + tid; pv[q] = (f32x4){0.f, 0.f, 0.f, 0.f}; if (c < seg * 256) pv[q] = *(const f32x4*)(lf + 4 * c); }
#pragma unroll
          for (int q = 0; q < 8; ++q) pre += ((double)pv[q].x + (double)pv[q].y) + ((double)pv[q].z + (double)pv[q].w); }
#pragma unroll
        for (int o = 1; o < 64; o <<= 1) pre += __shfl_xor(pre, o);
        const float v0 = lf[seg * 1024 + 2 * tid], v1 = lf[seg * 1024 + 2 * tid + 1];
        const double tot = (double)v0 + (double)v1; double incl = tot;
#pragma unroll
        for (int o = 1; o < 64; o <<= 1) { const double n = __shfl_up(incl, o); if (lane >= o) incl += n; }
        if (lane == 63) { wt[wave] = pre; wt[8 + wave] = incl; }
        LDS_FENCE(); __syncthreads();
        double run = incl - tot;
#pragma unroll
        for (int j = 0; j < 8; ++j) { run += wt[j]; if (j < wave) run += wt[8 + j]; }
        const double o0 = run + (double)v0, o1 = o0 + (double)v1;
        Fo[2 * tid] = o0; Fo[2 * tid + 1] = o1;
        __syncthreads();
    }
    { const bf16_t* Pq = (const bf16_t*)(A.ws + WS_R1); float* KQP = (float*)(A.ws + WS_SM + SM_KQP);
      float mq0 = 0.f, mk0 = 0.f, mq1 = 0.f, mk1 = 0.f;
      for (int mb16 = gw * 16; mb16 < T; mb16 += NGW * 16) {
      float mq = 0.f, mk = 0.f;
#pragma unroll 4
      for (int j = 0; j < 16; ++j) { const size_t m = (size_t)mb16 + j;
          const u32x4 q = *(const u32x4*)(Pq + m * 1536 + 512 + 8 * lane), k = *(const u32x4*)(Pq + m * 1536 + 1024 + 8 * lane);
          float sq = bflo(q.x) * bflo(q.x) + bfhi(q.x) * bfhi(q.x) + bflo(q.y) * bflo(q.y) + bfhi(q.y) * bfhi(q.y) + bflo(q.z) * bflo(q.z) + bfhi(q.z) * bfhi(q.z) + bflo(q.w) * bflo(q.w) + bfhi(q.w) * bfhi(q.w);
          float sk = bflo(k.x) * bflo(k.x) + bfhi(k.x) * bfhi(k.x) + bflo(k.y) * bflo(k.y) + bfhi(k.y) * bfhi(k.y) + bflo(k.z) * bflo(k.z) + bfhi(k.z) * bfhi(k.z) + bflo(k.w) * bflo(k.w) + bfhi(k.w) * bfhi(k.w);
          sq += __shfl_xor(sq, 1); sq += __shfl_xor(sq, 2); sq += __shfl_xor(sq, 4); sk += __shfl_xor(sk, 1); sk += __shfl_xor(sk, 2); sk += __shfl_xor(sk, 4);
          mq = fmaxf(mq, sq); mk = fmaxf(mk, sk); }
      if (mb16 < SEQ) { mq0 = fmaxf(mq0, mq); mk0 = fmaxf(mk0, mk); } else { mq1 = fmaxf(mq1, mq); mk1 = fmaxf(mk1, mk); } }
      LAS float* wm = (LAS float*)lds + 64;
      if ((lane & 7) == 0) { const int h = lane >> 3; wm[wave * 32 + h * 2] = mq0; wm[wave * 32 + h * 2 + 1] = mk0; wm[wave * 32 + 16 + h * 2] = mq1; wm[wave * 32 + 16 + h * 2 + 1] = mk1; }
      LDS_FENCE(); __syncthreads();
      if (tid < 32) { float v = wm[tid];
#pragma unroll
          for (int wv = 1; wv < 8; ++wv) v = fmaxf(v, wm[wv * 32 + tid]);
          KQP[(size_t)blockIdx.x * 32 + tid] = v; }
      __syncthreads(); }
    const bf16_t* P = (const bf16_t*)(A.ws + WS_R1); bf16_t* Y = (bf16_t*)(A.ws + WS_Y); const bf16_t* WP = (const bf16_t*)(A.ws + WS_W + W_P);
    const float* psc = A.pool_scale + (size_t)i * 512;
    const int r32 = lane & 31, hi = lane >> 5;
    for (int u = gw; u < 4096; u += NGW) {
        const int g = (u + (u >> 11)) & 3, rb = u >> 2;
        if (g == 0) pool_unit<2>(P, Y, WP, psc, g, rb, r32, hi);
        else if (g == 1) pool_unit<4>(P, Y, WP, psc, g, rb, r32, hi);
        else if (g == 2) pool_unit<8>(P, Y, WP, psc, g, rb, r32, hi);
        else pool_unit<16>(P, Y, WP, psc, g, rb, r32, hi);
    }
}

template <int DK, bool FOX, bool TRACK>
__device__ __forceinline__ bool attn_unit(LAS unsigned char* lds, const bf16_t* __restrict__ Qp, int ldq, const bf16_t* __restrict__ Kp, int ldk, const bf16_t* __restrict__ Kr,
                                          const bf16_t* __restrict__ VTp, const double* __restrict__ F, const float* __restrict__ CS, bf16_t* Yp, int q0, int tid_in, float acp_thr) {
    int tid = tid_in;
    constexpr int KSTR = DK * 2 + 16, VSTR = 144, KBYTES = 64 * KSTR, VBYTES = 64 * VSTR;
    constexpr int OFF_K = 0, OFF_V = 3 * KBYTES, OFF_FK = OFF_V + 4 * VBYTES, OFF_WS = OFF_FK + 768;
    constexpr int ND = DK / 16;
    asm volatile("" : "+v"(tid));
    const int lane = tid & 63, r32 = lane & 31, hi = lane >> 5, w = __builtin_amdgcn_readfirstlane(tid >> 6);
    const int wrow0 = q0 + 32 * w, trow = wrow0 + r32;
    bf16x8 qf[ND];
#pragma unroll
    for (int d0 = 0; d0 < ND; ++d0) qf[d0] = *(const bf16x8*)(Qp + (size_t)trow * ldq + 16 * d0 + 8 * hi);
    if (!FOX) {
        const u32x4 a = __builtin_bit_cast(u32x4, qf[ND - 2]), b = __builtin_bit_cast(u32x4, qf[ND - 1]);
        const float* cs = CS + (size_t)trow * 32 + 8 * hi;
        const f32x4 c0 = *(const f32x4*)cs, c1 = *(const f32x4*)(cs + 4), s0 = *(const f32x4*)(cs + 16), s1 = *(const f32x4*)(cs + 20);
        const float x1[8] = {bflo(a.x), bfhi(a.x), bflo(a.y), bfhi(a.y), bflo(a.z), bfhi(a.z), bflo(a.w), bfhi(a.w)};
        const float x2[8] = {bflo(b.x), bfhi(b.x), bflo(b.y), bfhi(b.y), bflo(b.z), bfhi(b.z), bflo(b.w), bfhi(b.w)};
        const float cc[8] = {c0.x, c0.y, c0.z, c0.w, c1.x, c1.y, c1.z, c1.w}, sn[8] = {s0.x, s0.y, s0.z, s0.w, s1.x, s1.y, s1.z, s1.w};
        u32x4 oa, ob;
        oa.x = pk2(x1[0] * cc[0] - x2[0] * sn[0], x1[1] * cc[1] - x2[1] * sn[1]); oa.y = pk2(x1[2] * cc[2] - x2[2] * sn[2], x1[3] * cc[3] - x2[3] * sn[3]);
        oa.z = pk2(x1[4] * cc[4] - x2[4] * sn[4], x1[5] * cc[5] - x2[5] * sn[5]); oa.w = pk2(x1[6] * cc[6] - x2[6] * sn[6], x1[7] * cc[7] - x2[7] * sn[7]);
        ob.x = pk2(x2[0] * cc[0] + x1[0] * sn[0], x2[1] * cc[1] + x1[1] * sn[1]); ob.y = pk2(x2[2] * cc[2] + x1[2] * sn[2], x2[3] * cc[3] + x1[3] * sn[3]);
        ob.z = pk2(x2[4] * cc[4] + x1[4] * sn[4], x2[5] * cc[5] + x1[5] * sn[5]); ob.w = pk2(x2[6] * cc[6] + x1[6] * sn[6], x2[7] * cc[7] + x1[7] * sn[7]);
        qf[ND - 2] = __builtin_bit_cast(bf16x8, oa); qf[ND - 1] = __builtin_bit_cast(bf16x8, ob);
    }
    float fq2 = 0.f; double Fref = 0.0;
    if (FOX) { Fref = F[q0]; fq2 = (float)((F[trow] - Fref) * (double)LOG2E); }
    f32x16 o0 = {}, o1 = {}; float mrun = 0.f, lrun = 0.f;
    const int ktmax = (q0 >> 6) + 3, wkt = wrow0 >> 6;
    int kt_lo = 0;
    if (FOX) { const int nq = q0 >> 6; int cnt = 0;
#pragma unroll
        for (int j = 0; j < 4; ++j) { const int kk = lane + 64 * j; bool c = false; if (kk < nq) c = (Fref - F[64 * kk + 63]) * (double)LOG2E < -(double)acp_thr; cnt += __popcll(__ballot(c)); }
        kt_lo = __builtin_amdgcn_readfirstlane(cnt); }
    const int krow = tid >> 3, kch = tid & 7, rrow = (tid >> 2) & 63, rch = tid & 3;
    const unsigned koff = (unsigned)(krow * ldk + kch * 8) * 2u, voff = (unsigned)(krow * T + kch * 8) * 2u, roff = (unsigned)(rrow * 32 + rch * 8) * 2u;
    u32x4 kreg, vreg, rreg = {}, kregB, vregB, rregB = {}; float fkreg = 0.f, fkregB = 0.f;
#define AT_GLOAD_S(kt, KR, VR, RR, FK) do { KR = *(const u32x4*)((const char*)(Kp + (size_t)(kt) * 64 * ldk) + koff); VR = *(const u32x4*)((const char*)(VTp + (size_t)(kt) * 64) + voff); \
        if (!FOX && tid < 256) RR = *(const u32x4*)((const char*)(Kr + (size_t)(kt) * 64 * 32) + roff); \
        if (FOX && tid < 64) FK = -(float)((F[(kt) * 64 + tid] - Fref) * (double)LOG2E); } while (0)
#define AT_LWRITE_S(KT, KR, VR, RR, FK) do { *(LAS u32x4*)(lds + OFF_K + ((KT) % 3) * KBYTES + krow * KSTR + kch * 16) = KR; *(LAS u32x4*)(lds + OFF_V + ((KT) & 3) * VBYTES + krow * VSTR + kch * 16) = VR; \
        if (!FOX && tid < 256) *(LAS u32x4*)(lds + OFF_K + ((KT) % 3) * KBYTES + rrow * KSTR + 128 + rch * 16) = RR; \
        if (FOX && tid < 64) *(LAS float*)(lds + OFF_FK + ((KT) % 3) * 256 + tid * 4) = FK; } while (0)
#define AT_GLOAD(kt) AT_GLOAD_S(kt, kreg, vreg, rreg, fkreg)
#define AT_LWRITE(KT) AT_LWRITE_S(KT, kreg, vreg, rreg, fkreg)
#define AT_STAGE(KT) do { if ((KT) - 2 >= kt_lo) AT_LWRITE((KT) - 2); if ((KT) - 3 >= kt_lo) AT_GLOAD((KT) - 3); } while (0)
    LAS float* wsf = (LAS float*)(lds + OFF_WS) + w * 64;
    const int sig = (r32 & 0x13) | ((r32 & 4) << 1) | ((r32 & 8) >> 1);
#define AT_KFH(KT, H) _Pragma("unroll") for (int d0 = (H) * (ND / 2); d0 < ((H) + 1) * (ND / 2); ++d0) { kf[2 * d0] = *(const LAS bf16x8*)(kb_ + d0 * 32); kf[2 * d0 + 1] = *(const LAS bf16x8*)(kb_ + 32 * KSTR + d0 * 32); }
#define AT_KB(KT) const LAS unsigned char* kb_ = lds + OFF_K + ((KT) % 3) * KBYTES + sig * KSTR + hi * 16; bf16x8 kf[2 * ND];
#define AT_VF(SLOT) const LAS unsigned char* vb_ = lds + OFF_V + (SLOT) * VBYTES + r32 * VSTR + hi * 16; bf16x8 vf[8]; \
    _Pragma("unroll") for (int c = 0; c < 4; ++c) { vf[2 * c] = *(const LAS bf16x8*)(vb_ + 32 * c); vf[2 * c + 1] = *(const LAS bf16x8*)(vb_ + 32 * VSTR + 32 * c); }
#define AT_CINIT(SC0, SC1, KT) do { if (FOX) { const LAS float* fk = (const LAS float*)(lds + OFF_FK + ((KT) % 3) * 256) + 8 * hi; const float cq = fq2 - mrun; \
        const f32x4 a0 = *(const LAS f32x4*)(fk), a1 = *(const LAS f32x4*)(fk + 4), a2 = *(const LAS f32x4*)(fk + 16), a3 = *(const LAS f32x4*)(fk + 20); \
        const f32x4 b0 = *(const LAS f32x4*)(fk + 32), b1 = *(const LAS f32x4*)(fk + 36), b2 = *(const LAS f32x4*)(fk + 48), b3 = *(const LAS f32x4*)(fk + 52); \
        _Pragma("unroll") for (int e = 0; e < 4; ++e) { SC0[e] = a0[e] + cq; SC0[4 + e] = a1[e] + cq; SC0[8 + e] = a2[e] + cq; SC0[12 + e] = a3[e] + cq; \
                                                      SC1[e] = b0[e] + cq; SC1[4 + e] = b1[e] + cq; SC1[8 + e] = b2[e] + cq; SC1[12 + e] = b3[e] + cq; } \
    } else { SC0 = (f32x16){}; SC1 = (f32x16){}; } } while (0)
#define AT_QKH(SC0, SC1, H) do { _Pragma("unroll") for (int d0 = (H) * (ND / 2); d0 < ((H) + 1) * (ND / 2); ++d0) { \
        SC0 = __builtin_amdgcn_mfma_f32_32x32x16_bf16(kf[2 * d0], qf[d0], SC0, 0, 0, 0); SC1 = __builtin_amdgcn_mfma_f32_32x32x16_bf16(kf[2 * d0 + 1], qf[d0], SC1, 0, 0, 0); } } while (0)
#define AT_EXPH(SP) _Pragma("unroll") for (int r = 0; r < 16; ++r) { SP[r] = __builtin_amdgcn_exp2f(SP[r]); ls_ += SP[r]; }
#define AT_PACK(SP0, SP1) u32x4 p0, p1, p2, p3; \
    p0.x = pk2(SP0[0], SP0[1]); p0.y = pk2(SP0[2], SP0[3]); p0.z = pk2(SP0[4], SP0[5]); p0.w = pk2(SP0[6], SP0[7]); \
    p1.x = pk2(SP0[8], SP0[9]); p1.y = pk2(SP0[10], SP0[11]); p1.z = pk2(SP0[12], SP0[13]); p1.w = pk2(SP0[14], SP0[15]); \
    p2.x = pk2(SP1[0], SP1[1]); p2.y = pk2(SP1[2], SP1[3]); p2.z = pk2(SP1[4], SP1[5]); p2.w = pk2(SP1[6], SP1[7]); \
    p3.x = pk2(SP1[8], SP1[9]); p3.y = pk2(SP1[10], SP1[11]); p3.z = pk2(SP1[12], SP1[13]); p3.w = pk2(SP1[14], SP1[15]); \

#define AT_PV() do { const bf16x8 pa0 = __builtin_bit_cast(bf16x8, p0), pa1 = __builtin_bit_cast(bf16x8, p1), pa2 = __builtin_bit_cast(bf16x8, p2), pa3 = __builtin_bit_cast(bf16x8, p3); \
    o0 = __builtin_amdgcn_mfma_f32_32x32x16_bf16(pa0, vf[0], o0, 0, 0, 0); o1 = __builtin_amdgcn_mfma_f32_32x32x16_bf16(pa0, vf[1], o1, 0, 0, 0); \
    o0 = __builtin_amdgcn_mfma_f32_32x32x16_bf16(pa1, vf[2], o0, 0, 0, 0); o1 = __builtin_amdgcn_mfma_f32_32x32x16_bf16(pa1, vf[3], o1, 0, 0, 0); \
    o0 = __builtin_amdgcn_mfma_f32_32x32x16_bf16(pa2, vf[4], o0, 0, 0, 0); o1 = __builtin_amdgcn_mfma_f32_32x32x16_bf16(pa2, vf[5], o1, 0, 0, 0); \
    o0 = __builtin_amdgcn_mfma_f32_32x32x16_bf16(pa3, vf[6], o0, 0, 0, 0); o1 = __builtin_amdgcn_mfma_f32_32x32x16_bf16(pa3, vf[7], o1, 0, 0, 0); } while (0)
#define AT_REL(SC0, SC1) do { if (TRACK && !FOX) { if (__any(mrun != 0.f)) { _Pragma("unroll") for (int r = 0; r < 16; ++r) { SC0[r] -= mrun; SC1[r] -= mrun; } } } } while (0)
#define AT_MAX(SC0, SC1) float mloc; { float ma = max3f(SC0[0], SC0[1], SC1[0]), mb = max3f(SC0[2], SC0[3], SC1[1]); ma = max3f(ma, SC1[2], SC1[3]); \
        _Pragma("unroll") for (int r = 4; r < 16; r += 4) { ma = max3f(ma, SC0[r], SC0[r + 1]); mb = max3f(mb, SC0[r + 2], SC0[r + 3]); ma = max3f(ma, SC1[r], SC1[r + 1]); mb = max3f(mb, SC1[r + 2], SC1[r + 3]); } \
        mloc = max3f(ma, mb, mb); mloc = max3f(mloc, __shfl_xor(mloc, 32), mloc); }
#define AT_DEC(SC0, SC1) do { if (__any(mloc > 12.0f)) { \
        const float dl = fmaxf(mloc, 0.f); mrun += dl; const float alpha = __builtin_amdgcn_exp2f(-dl); lrun *= alpha; \
        _Pragma("unroll") for (int r = 0; r < 16; ++r) { SC0[r] -= dl; SC1[r] -= dl; } \
        if (hi == 0) wsf[r32] = alpha; \
        LDS_FENCE(); \
        _Pragma("unroll") for (int r4 = 0; r4 < 4; ++r4) { const f32x4 al = *(const LAS f32x4*)(wsf + 8 * r4 + 4 * hi); \
            _Pragma("unroll") for (int e = 0; e < 4; ++e) { o0[4 * r4 + e] *= al[e]; o1[4 * r4 + e] *= al[e]; } } \
        LDS_FENCE(); } } while (0)
#define AT_FIRST(SC0, SC1, KT) do { AT_KB(KT); AT_KFH(KT, 0); AT_KFH(KT, 1); AT_CINIT(SC0, SC1, KT); __builtin_amdgcn_sched_barrier(0); AT_QKH(SC0, SC1, 0); AT_QKH(SC0, SC1, 1); __builtin_amdgcn_sched_barrier(0); AT_STAGE(KT); __builtin_amdgcn_sched_barrier(0); \
        AT_REL(SC0, SC1); \
        if (FOX) { const int kv0 = 64 * (KT) + 8 * hi; \
            _Pragma("unroll") for (int r = 0; r < 16; ++r) { const int kv = kv0 + 16 * (r >> 3) + (r & 7); if (kv > trow) SC0[r] = -INFINITY; if (kv + 32 > trow) SC1[r] = -INFINITY; } } \
        if (TRACK) { AT_MAX(SC0, SC1); AT_DEC(SC0, SC1); } } while (0)
#define AT_STEADY(SC0, SC1, SP0, SP1, KT) do { AT_KB(KT); AT_KFH(KT, 0); AT_CINIT(SC0, SC1, KT); float ls_ = 0.f; __builtin_amdgcn_sched_barrier(0); \
        AT_QKH(SC0, SC1, 0); AT_KFH(KT, 1); AT_EXPH(SP0); asm volatile("" : "+v"(SP0), "+v"(ls_)); AT_SGB_QK(); __builtin_amdgcn_sched_barrier(0); AT_STAGE(KT); __builtin_amdgcn_sched_barrier(0); \
        AT_QKH(SC0, SC1, 1); AT_VF(((KT) + 1) & 3); AT_EXPH(SP1); lrun += ls_; AT_PACK(SP0, SP1); asm volatile("" : "+v"(p0), "+v"(p1), "+v"(p2), "+v"(p3), "+v"(lrun)); AT_SGB_QK(); __builtin_amdgcn_sched_barrier(0); \
        AT_REL(SC0, SC1); \
        if (TRACK) { AT_PV(); AT_MAX(SC0, SC1); AT_SGB_PV(); __builtin_amdgcn_sched_barrier(0); AT_DEC(SC0, SC1); } else { AT_PV(); } } while (0)
#define AT_DRAIN(SP0, SP1) do { AT_VF(kt_lo & 3); float ls_ = 0.f; AT_EXPH(SP0); AT_EXPH(SP1); lrun += ls_; AT_PACK(SP0, SP1); AT_PV(); } while (0)
#ifndef AT_HINTS
#define AT_HINTS 1
#endif
#if AT_HINTS
#define AT_SGB_QK() do { _Pragma("unroll") for (int i_ = 0; i_ < ND; ++i_) { __builtin_amdgcn_sched_group_barrier(0x008, 1, 0); __builtin_amdgcn_sched_group_barrier(0x002, (DK == 96 ? 7 : 10), 0); } } while (0)
#define AT_SGB_PV() do { _Pragma("unroll") for (int i_ = 0; i_ < 8; ++i_) { __builtin_amdgcn_sched_group_barrier(0x008, 1, 0); __builtin_amdgcn_sched_group_barrier(0x002, 2, 0); } } while (0)
#else
#define AT_SGB_QK() do {} while (0)
#define AT_SGB_PV() do {} while (0)
#endif
#define AT_STEP_STEADY(SC0, SC1, SP0, SP1, KT) do { const int kt_ = (KT); AT_STEADY(SC0, SC1, SP0, SP1, kt_); LBAR(); } while (0)
    f32x16 sA0 = {}, sA1 = {}, sB0 = {}, sB1 = {};
    LAS unsigned* uflag = (LAS unsigned*)(lds + 100016);
    if (!TRACK && tid == 0) *uflag = 0u;
    AT_GLOAD(ktmax); AT_GLOAD_S(ktmax - 1, kregB, vregB, rregB, fkregB); AT_LWRITE(ktmax); AT_LWRITE_S(ktmax - 1, kregB, vregB, rregB, fkregB); AT_GLOAD(ktmax - 2); LBAR();
    for (int kt = ktmax; kt > wkt; --kt) { AT_STAGE(kt); LBAR(); }
    { AT_FIRST(sA0, sA1, wkt); LBAR(); }
    int kt = wkt - 1;
    for (; kt >= kt_lo + 1; kt -= 2) {
        AT_STEP_STEADY(sB0, sB1, sA0, sA1, kt);
        AT_STEP_STEADY(sA0, sA1, sB0, sB1, kt - 1);
    }
    if (kt == kt_lo) { AT_STEP_STEADY(sB0, sB1, sA0, sA1, kt_lo); AT_DRAIN(sB0, sB1); LBAR(); }
    else { AT_DRAIN(sA0, sA1); LBAR(); }
#undef AT_GLOAD
#undef AT_LWRITE
#undef AT_GLOAD_S
#undef AT_LWRITE_S
#undef AT_STAGE
#undef AT_KFH
#undef AT_KB
#undef AT_QKH
#undef AT_EXPH
#undef AT_PACK
#undef AT_REL
#undef AT_STEP_STEADY
#undef AT_VF
#undef AT_CINIT
#undef AT_QK
#undef AT_SOFT
#undef AT_PV
#undef AT_MAX
#undef AT_DEC
#undef AT_FIRST
#undef AT_STEADY
#undef AT_DRAIN
#undef AT_STEP
    lrun += __shfl_xor(lrun, 32);
    if (hi == 0) wsf[32 + r32] = lrun;
    LDS_FENCE();
#pragma unroll
    for (int r4 = 0; r4 < 4; ++r4) { const f32x4 lv = *(const LAS f32x4*)(wsf + 32 + 8 * r4 + 4 * hi);
#pragma unroll
        for (int e = 0; e < 4; ++e) { const float inv = 1.0f / lv[e]; const int row = wrow0 + e + 8 * r4 + 4 * hi;
            Yp[(size_t)row * DM + r32] = (bf16_t)(pk2(o0[4 * r4 + e] * inv, 0.f) & 0xffffu);
            Yp[(size_t)row * DM + 32 + r32] = (bf16_t)(pk2(o1[4 * r4 + e] * inv, 0.f) & 0xffffu); } }
    LDS_FENCE();
    if (!TRACK) {
        const bool bad = !(lrun > 1e-30f && lrun < 1e30f);
        if (__any(bad)) { if (lane == 0) atomicOr((unsigned*)uflag, 1u); }
        LBAR(); const unsigned f_ = *uflag; LBAR();
        return f_ == 0u;
    }
    return true;
}

#define XB_TMO      128
#define XB_XCNT(j)  (256  + 64 * (j))
#define XB_XSUB(j)  (1280 + 64 * (j))
#define XB_XGEN(j)  (2304 + 64 * (j))
#define XB_TOP      3328
#define XB_TOPGEN   3392
#define XCD_BAR_WORDS 3456
#define XB_SPIN_CAP (1u << 18)

__device__ __forceinline__ unsigned xb_ld(unsigned* p)              { return __hip_atomic_load(p, __ATOMIC_RELAXED, __HIP_MEMORY_SCOPE_AGENT); }
__device__ __forceinline__ unsigned xb_add(unsigned* p, unsigned v) { return __hip_atomic_fetch_add(p, v, __ATOMIC_RELAXED, __HIP_MEMORY_SCOPE_AGENT); }
__device__ __forceinline__ unsigned xb_xcc_id() { return (unsigned)__builtin_amdgcn_s_getreg((3 << 11) | 20) & 0xFu; }
#define XB_SPIN(cond, bar) do { unsigned _sp = 0; while (cond) { __builtin_amdgcn_s_sleep(1); \
    if ((++_sp & 255u) == 0u) { if (xb_ld(&(bar)[XB_TMO])) break; if (_sp > XB_SPIN_CAP) { atomicAdd(&(bar)[XB_TMO], 1u); break; } } } } while (0)

struct XcdBarrier {
    unsigned* bar; unsigned x;
    volatile LAS unsigned* st;
};

__device__ __forceinline__ XcdBarrier xcd_barrier_post(unsigned* bar, volatile LAS unsigned* st) {
    XcdBarrier b; b.bar = bar; b.x = xb_xcc_id(); b.st = st;
    if (threadIdx.x == 0) (void)xb_add(&bar[XB_XCNT(b.x)], 1u);
    return b;
}
__device__ __forceinline__ void xcd_barrier_complete(unsigned* bar, unsigned x, unsigned& nloc, unsigned& nx) {
    const unsigned G = gridDim.x * gridDim.y * gridDim.z;
    unsigned sum, cnt, mine, sp = 0u;
    for (;;) {
        sum = 0u; cnt = 0u; mine = 0u;
#pragma unroll
        for (unsigned j = 0; j < 16; ++j) { const unsigned c = xb_ld(&bar[XB_XCNT(j)]); sum += c; cnt += (c > 0u) ? 1u : 0u; mine = (j == x) ? c : mine; }
        if (sum == G) break;
        __builtin_amdgcn_s_sleep(1);
        if ((++sp & 255u) == 0u) { if (xb_ld(&bar[XB_TMO])) break; if (sp > XB_SPIN_CAP) { atomicAdd(&bar[XB_TMO], 1u); break; } }
    }
    nloc = mine > 0u ? mine : 1u; nx = cnt > 0u ? cnt : 1u;
}

__device__ __forceinline__ void xcd_barrier(const XcdBarrier& b) {
    asm volatile("s_waitcnt vmcnt(0)" ::: "memory");
    __syncthreads();
    if (threadIdx.x == 0) {
        unsigned* bar = b.bar;
        __builtin_amdgcn_s_waitcnt(0);
        unsigned nloc = b.st[0], nx = b.st[1];
        if (nloc == 0u) { xcd_barrier_complete(bar, b.x, nloc, nx); b.st[0] = nloc; b.st[1] = nx; }
        const unsigned old = xb_add(&bar[XB_XSUB(b.x)], 1u);
        const unsigned gen = old / nloc;
        if (old + 1u == (gen + 1u) * nloc) {
            __builtin_amdgcn_fence(__ATOMIC_RELEASE, "agent");
            asm volatile("s_waitcnt vmcnt(0)" ::: "memory");
            const unsigned og = xb_add(&bar[XB_TOP], 1u);
            const unsigned tg = og / nx;
            if (og + 1u == (tg + 1u) * nx) xb_add(&bar[XB_TOPGEN], 1u);
            else XB_SPIN(xb_ld(&bar[XB_TOPGEN]) == tg, bar);
            __builtin_amdgcn_fence(__ATOMIC_ACQUIRE, "agent");
            xb_add(&bar[XB_XGEN(b.x)], 1u);
            asm volatile("s_waitcnt vmcnt(0)" ::: "memory");
        } else {
            XB_SPIN(xb_ld(&bar[XB_XGEN(b.x)]) == gen, bar);
            __builtin_amdgcn_fence(__ATOMIC_ACQUIRE, "agent");
            asm volatile("s_waitcnt vmcnt(0)" ::: "memory");
        }
    }
    __syncthreads();
}

__global__ void __launch_bounds__(512, 2) fwd_mega(Args Akern) {
    extern __shared__ __attribute__((aligned(16))) unsigned char lds_raw[];
    LAS unsigned char* lds = (LAS unsigned char*)lds_raw;
    const int G = gridDim.x, bx = blockIdx.x;
    const int vcu = (G % 8 == 0) ? (bx % 8) * (G / 8) + bx / 8 : bx;
    const int NGW = G * 8;
    const int ph_lo = Akern.ph_lo, ph_hi = Akern.ph_hi, do_sync = Akern.do_sync;
    volatile LAS unsigned* bar_st = (volatile LAS unsigned*)(lds + 140000);
    if (threadIdx.x < 2) bar_st[threadIdx.x] = 0u;
    __syncthreads();
    XcdBarrier xbar; xbar.bar = (unsigned*)(Akern.ws + WS_SM + SM_BAR); xbar.x = 0; xbar.st = nullptr;
    if (do_sync) xbar = xcd_barrier_post((unsigned*)(Akern.ws + WS_SM + SM_BAR), bar_st);
    bool first_sync = true;
#if defined(__HIP_DEVICE_COMPILE__)
    const __attribute__((address_space(4))) Args* Ak = (const __attribute__((address_space(4))) Args*)__builtin_amdgcn_kernarg_segment_ptr();
#else
    const Args* Ak = &Akern;
#endif

#if PROBE_KMASK
    unsigned long long t_acc = 0ull;
#endif
    for (int ph = ph_lo; ph < ph_hi; ++ph) {
#if PROBE_KMASK
        const unsigned long long t_ph0 = __builtin_amdgcn_s_memrealtime();
#endif
        asm volatile("" : "+s"(Ak));
        const Args A = *Ak;
        int tid = threadIdx.x; asm volatile("" : "+v"(tid));
        const int lane = tid & 63, wave = __builtin_amdgcn_readfirstlane(tid >> 6), gw = vcu * 8 + wave;
        unsigned char* ws = A.ws;
        bf16_t* HN = (bf16_t*)(ws + WS_HN); bf16_t* Yb = (bf16_t*)(ws + WS_Y); bf16_t* R1 = (bf16_t*)(ws + WS_R1); bf16_t* VT = (bf16_t*)(ws + WS_VT); bf16_t* KN = (bf16_t*)(ws + WS_KN); _Float16* H16 = (_Float16*)(ws + WS_H16);
        float* LFb = (float*)(ws + WS_SM + SM_LF); const double* Fb = (const double*)(ws + WS_SM + SM_F); const float* CS = (const float*)(ws + WS_SM + SM_CS);
        const int l = ph / 12, k = ph % 12, i = l >> 1; const bool even = !(l & 1);
        bool did = true;
        if (ph == NPH - 1) {
            if (EN(0)) norm_phase<2, true>(H16, A.norm_final, nullptr, A.out, nullptr, nullptr, nullptr, nullptr, gw, NGW, lane, tid);
        } else if (k == 0 || k == 9) {
            const int f = (k == 0) ? 0 : 1;
            if (EN(1)) if (k == 0) { convert_layer(A, l, (LAS float*)(lds + wave * 16384), gw, NGW, lane); if (l == 0) rope_table(A, gw, NGW, lane); }
            if (l == 0 && k == 0) norm_phase<0, false>(A.x, A.norm_ffn + (size_t)(l * 2 + f) * DM, HN, nullptr, nullptr, nullptr, nullptr, nullptr, gw, NGW, lane, tid);
            else norm_phase<0, true>(H16, A.norm_ffn + (size_t)(l * 2 + f) * DM, HN, nullptr, nullptr, nullptr, nullptr, nullptr, gw, NGW, lane, tid);
        } else if (k == 1 || k == 10) {
            const int f = (k == 1) ? 0 : 1;
            pg8::Gemm g{HN, (const bf16_t*)(ws + WS_W + (f ? W_GU1 : W_GU0)), T, 2 * FF, DM}; pg8::StaticOrder S; S.init(T, 2 * FF, G, bx);
            pg8::EpiSwiglu E{R1, FF};
            if (EN(2)) pg8::gemm_phase<pg8::EpiSwiglu, pg8::StaticOrder, true, true>(lds, g, S, E);
        } else if (k == 4 && !even) {
            pg8::Gemm g{HN, (const bf16_t*)(ws + WS_W + W_MIN), T, 512, DM}; pg8::StaticOrder S; S.init(T, 512, G, bx);
            pg8::EpiMlaIn E{(bf16_t*)(ws + WS_R1 + R_CQN), (bf16_t*)(ws + WS_R1 + R_CKVN), (bf16_t*)(ws + WS_R1 + R_KR), A.mla_q_norm + (size_t)i * 256, A.mla_kv_norm + (size_t)i * 128, CS};
            pg8::gemm_phase<pg8::EpiMlaIn, pg8::StaticOrder, false, true>(lds, g, S, E);
        } else if (k == 2 || k == 11 || k == 8) {
            pg8::Gemm g; pg8::EpiResF32 E;
            if (k == 2 || k == 11) { const int f = (k == 2) ? 0 : 1; g = pg8::Gemm{R1, (const bf16_t*)(ws + WS_W + (f ? W_D1 : W_D0)), T, DM, FF};
                if (l == 0 && k == 2) E = pg8::EpiResF32{A.x, H16, DM, 0.5f, 1}; else E = pg8::EpiResF32{H16, H16, DM, 0.5f, 0}; }
            else if (k == 8) { g = pg8::Gemm{Yb, (const bf16_t*)(ws + WS_W + W_OUT), T, DM, DM}; E = pg8::EpiResF32{H16, H16, DM, 1.0f, 0}; }
            else { g = pg8::Gemm{Yb, (const bf16_t*)(ws + WS_W + W_OUT), T, DM, DM}; E = pg8::EpiResF32{H16, H16, DM, 1.0f, 0}; }
            pg8::StaticOrder S; S.init(g.M, g.N, G, bx);
            if (EN(3)) pg8::gemm_phase<pg8::EpiResF32, pg8::StaticOrder, true, true>(lds, g, S, E);
        } else if (k == 3) {
            if (even && bx == 0 && tid < 64) { ((unsigned*)(ws + WS_SM + SM_KQ))[tid] = 0u; if (tid == 0) *(unsigned*)(ws + WS_SM + SM_CTR) = 0u; }
            if (!EN(4)) {} else if (even) norm_phase<1, true>(H16, A.norm_mix + (size_t)l * DM, HN, nullptr, A.ab_w_in + (size_t)i * DM * 2056, A.ab_b_forget + (size_t)i * 8, LFb, (LAS float*)lds, gw, NGW, lane, tid);
            else norm_phase<0, true>(H16, A.norm_mix + (size_t)l * DM, HN, nullptr, nullptr, nullptr, nullptr, nullptr, gw, NGW, lane, tid);
        } else if ((k == 4 && even) || (k == 6 && !even)) {
            const int ng = even ? 2 : 3;
            for (int j = 0; j < ng; ++j) {
                pg8::Gemm g; pg8::EpiBf16S E;
                if (even) {
                    if (j == 0) { g = pg8::Gemm{HN, (const bf16_t*)(ws + WS_W + W_IN), T, 1536, DM}; E = pg8::EpiBf16S{R1, 1536, 512, 1024, 0.125f * LOG2E}; }
                    else { g = pg8::Gemm{(const bf16_t*)(ws + WS_W + W_V), HN, 512, T, DM}; E = pg8::EpiBf16S{VT, T, 0, 0, 1.0f}; }
                } else {
                    if (j == 0) { g = pg8::Gemm{(const bf16_t*)(ws + WS_R1 + R_CQN), (const bf16_t*)(ws + WS_W + W_QB), T, 1536, 256}; E = pg8::EpiBf16S{R1, 1536, 0, 1536, 0.10206207261596577f * LOG2E}; }
                    else if (j == 1) { g = pg8::Gemm{(const bf16_t*)(ws + WS_R1 + R_CKVN), (const bf16_t*)(ws + WS_W + W_KNW), T, 1024, 256}; E = pg8::EpiBf16S{KN, 1024, 0, 0, 1.0f}; }
                    else { g = pg8::Gemm{(const bf16_t*)(ws + WS_W + W_VVW), (const bf16_t*)(ws + WS_R1 + R_CKVN), 1024, T, 256}; E = pg8::EpiBf16S{VT, T, 0, 0, 1.0f}; }
                }
                pg8::StaticOrder S; S.init(g.M, g.N, G, bx);
                if (EN(5)) pg8::gemm_phase<pg8::EpiBf16S, pg8::StaticOrder, true, true>(lds, g, S, E);
                __syncthreads();
            }
        } else if (k == 5) {
            if (!EN(6)) {} else if (even) scan_pool(A, i, lds, gw, NGW, lane, tid, wave);
            else did = false;
        } else if (k == 7) {
            if (even) {
                unsigned* ctr = (unsigned*)(ws + WS_SM + SM_CTR); const unsigned* KQ = (const unsigned*)(ws + WS_SM + SM_KQ);
                LAS unsigned* qslot = (LAS unsigned*)(lds + 100000);
                for (;;) {
                    if (tid == 0) qslot[0] = atomicAdd(ctr, 1u);
                    LBAR(); const unsigned u = qslot[0]; LBAR();
                    if (u >= 1024u) break;
                    const int qb = 63 - (int)(u >> 4), bh = (int)(u & 15u), b = bh >> 3, h = bh & 7;
                    float mq_ = 0.f, mk_ = 0.f;
                    { const float* KQP = (const float*)(ws + WS_SM + SM_KQP) + (bh >> 3) * 16 + (bh & 7) * 2;
                      for (int x = lane; x < G; x += 64) { mq_ = fmaxf(mq_, KQP[(size_t)x * 32]); mk_ = fmaxf(mk_, KQP[(size_t)x * 32 + 1]); }
#pragma unroll
                      for (int o = 1; o < 64; o <<= 1) { mq_ = fmaxf(mq_, __shfl_xor(mq_, o)); mk_ = fmaxf(mk_, __shfl_xor(mk_, o)); } }
                    const float thr = 2.0f * sqrtf(mq_ * mk_) + 48.0f;
                    if (!attn_unit<64, true, false>(lds, R1 + (size_t)(b * SEQ) * 1536 + 512 + 64 * h, 1536, R1 + (size_t)(b * SEQ) * 1536 + 1024 + 64 * h, 1536, nullptr,
                                        VT + (size_t)(64 * h) * T + (size_t)b * SEQ, Fb + (size_t)bh * SEQ, nullptr, Yb + (size_t)(b * SEQ) * DM + 512 + 64 * h, qb * 256, tid, thr)) attn_unit<64, true, true>(lds, R1 + (size_t)(b * SEQ) * 1536 + 512 + 64 * h, 1536, R1 + (size_t)(b * SEQ) * 1536 + 1024 + 64 * h, 1536, nullptr,
                                        VT + (size_t)(64 * h) * T + (size_t)b * SEQ, Fb + (size_t)bh * SEQ, nullptr, Yb + (size_t)(b * SEQ) * DM + 512 + 64 * h, qb * 256, tid, thr);
                }
            } else {
                for (int p = vcu; p < 32 * 32; p += G) { const int bh = p >> 5, s = p & 31, b = bh >> 4, h = bh & 15;
                    for (int z = 0; z < 2; ++z) { const int qb = z ? s : 63 - s;
                        if (!attn_unit<96, false, false>(lds, R1 + (size_t)(b * SEQ) * 1536 + 96 * h, 1536, KN + (size_t)(b * SEQ) * 1024 + 64 * h, 1024, (const bf16_t*)(ws + WS_R1 + R_KR) + (size_t)(b * SEQ) * 32,
                                             VT + (size_t)(64 * h) * T + (size_t)b * SEQ, nullptr, CS + (size_t)(b * SEQ) * 32, Yb + (size_t)(b * SEQ) * DM + 64 * h, qb * 256, tid, 0.f)) attn_unit<96, false, true>(lds, R1 + (size_t)(b * SEQ) * 1536 + 96 * h, 1536, KN + (size_t)(b * SEQ) * 1024 + 64 * h, 1024, (const bf16_t*)(ws + WS_R1 + R_KR) + (size_t)(b * SEQ) * 32,
                                             VT + (size_t)(64 * h) * T + (size_t)b * SEQ, nullptr, CS + (size_t)(b * SEQ) * 32, Yb + (size_t)(b * SEQ) * DM + 64 * h, qb * 256, tid, 0.f); } }
            }
        } else did = false;
        if (did && ph + 1 < ph_hi) { if (do_sync) { if (first_sync) { cg::this_grid().sync(); first_sync = false; } else xcd_barrier(xbar); } }
#if PROBE_KMASK
        { const int kk_ = (ph == NPH - 1) ? 12 : (ph % 12); if ((PROBE_KMASK >> kk_) & 1) t_acc += __builtin_amdgcn_s_memrealtime() - t_ph0; }
        if (ph == NPH - 1 && blockIdx.x == 0 && (threadIdx.x >> 6) == 0) {
            const int M_ = (int)(t_acc / 200ull) > 8192 ? 8192 : (int)(t_acc / 200ull);
            for (int idx = threadIdx.x & 63; idx < M_; idx += 64) A.out[(size_t)(idx >> 10) * NGW * DM + (idx & 1023)] += 0.05f;
        }
#endif
    }
}

extern "C" void kernel_launch(void* const* d_in, const int* in_sizes, int n_in, void* d_out, int out_size, void* d_ws, size_t ws_size, hipStream_t stream) {
    static int grid = 0;
    if (grid == 0) {
        if (n_in != 19 || out_size != T * DM || ws_size < WS_END) { fprintf(stderr, "kernel_launch: unexpected shapes (n_in %d out %d ws %zu)\n", n_in, out_size, ws_size); grid = -1; return; }
        int dev = 0, cus = 0, per_cu = 0;
        hipGetDevice(&dev); hipDeviceGetAttribute(&cus, hipDeviceAttributeMultiprocessorCount, dev);
        if (hipFuncSetAttribute((const void*)fwd_mega, hipFuncAttributeMaxDynamicSharedMemorySize, LDS_BYTES) != hipSuccess) { fprintf(stderr, "kernel_launch: hipFuncSetAttribute failed\n"); grid = -1; return; }
        if (hipOccupancyMaxActiveBlocksPerMultiprocessor(&per_cu, (const void*)fwd_mega, 512, LDS_BYTES) != hipSuccess || per_cu < 1) { fprintf(stderr, "kernel_launch: occupancy query says %d\n", per_cu); per_cu = 1; }
        (void)hipGetLastError();
        grid = cus * 1;
    }
    if (grid < 0) return;
    Args a{};
    a.x = (const float*)d_in[0]; a.pos = (const int*)d_in[1]; a.norm_ffn = (const float*)d_in[2]; a.norm_mix = (const float*)d_in[3]; a.norm_final = (const float*)d_in[4];
    a.w_gate = (const float*)d_in[5]; a.w_up = (const float*)d_in[6]; a.w_down = (const float*)d_in[7];
    a.ab_w_in = (const float*)d_in[8]; a.ab_b_forget = (const float*)d_in[9]; a.pool_w = (const float*)d_in[10]; a.pool_scale = (const float*)d_in[11]; a.ab_w_out = (const float*)d_in[12];
    a.mla_w_in = (const float*)d_in[13]; a.mla_q_norm = (const float*)d_in[14]; a.mla_kv_norm = (const float*)d_in[15]; a.mla_w_q_b = (const float*)d_in[16]; a.mla_w_kv_b = (const float*)d_in[17]; a.mla_w_out = (const float*)d_in[18];
    a.out = (float*)d_out; a.ws = (unsigned char*)d_ws; a.pad = 0;
#if ONE_LAUNCH
    a.ph_lo = 0; a.ph_hi = NPH; a.do_sync = 1;
    if (hipMemsetAsync((char*)d_ws + WS_SM + SM_BAR, 0, XCD_BAR_WORDS * 4, stream) != hipSuccess) { fprintf(stderr, "kernel_launch: memset of the barrier words failed\n"); return; }
    void* args[] = {&a};
    hipError_t e = hipLaunchCooperativeKernel((const void*)fwd_mega, dim3(grid), dim3(512), args, LDS_BYTES, stream);
    if (e != hipSuccess) fprintf(stderr, "cooperative launch failed: %s (grid %d)\n", hipGetErrorString(e), grid);
#else
    for (int ph = 0; ph < NPH; ++ph) {
        const int l = ph / 12, k = ph % 12; if (ph != NPH - 1 && k == 6 && !(l & 1)) continue;
        a.ph_lo = ph; a.ph_hi = ph + 1; a.do_sync = 0;
        hipLaunchKernelGGL(fwd_mega, dim3(grid), dim3(512), LDS_BYTES, stream, a);
    }
#endif
}
```

```cpp
#include <hip/hip_runtime.h>
#include <hip/hip_cooperative_groups.h>
#include <cstdio>
#include <cstdint>
namespace cg = cooperative_groups;
#ifndef ONE_LAUNCH
#define ONE_LAUNCH 1
#endif
namespace pg8 {
#define PG8_LAS __attribute__((address_space(3)))
typedef unsigned short bf16_t;
typedef short bf16x8 __attribute__((ext_vector_type(8)));
typedef float f32x4 __attribute__((ext_vector_type(4)));
typedef unsigned u32x4 __attribute__((ext_vector_type(4)));
constexpr int BM = 256, BK = 64, HALF = 128, HTB = HALF * BK * 2  , STAGE_BYTES = 8 * HTB, NXCD = 8, WGM = 8;

__host__ __device__ __forceinline__ int lds_byte(int r, int c) { const int st = (r >> 4) * 2 + (c >> 5), rr = r & 15, cc = c & 31, ob = rr * 64 + cc * 2; return st * 1024 + (ob ^ (((ob >> 9) & 1) << 5)); }
__host__ __device__ __forceinline__ void stage_rc(int b, int& R, int& C) { const int st = b / 1024, sb = b % 1024, swz = sb ^ (((sb >> 9) & 1) << 5); R = (st >> 1) * 16 + swz / 64; C = (st & 1) * 32 + (swz % 64) / 2; }
__host__ __device__ __forceinline__ int perm32(int rho) { const int n = rho >> 4, i = rho & 15; return 8 * (i >> 2) + 4 * n + (i & 3); }

struct Unit { int pm, pn; };
struct Gemm { const bf16_t* A; const bf16_t* Bt; int M, N, K; };

struct StaticOrder {
    int nM, nN, nwg, G, c;
    __host__ __device__ void init(int M, int N, int G_, int c_) { nM = M / BM; nN = N / BM; nwg = nM * nN; G = G_; c = c_; }
    __host__ __device__ bool next(int i, Unit& u) const {
        const long L = (long)i * G + c; if (L >= nwg) return false;
        int wgid = (int)L; { const int q = nwg / NXCD, r = nwg % NXCD, xcd = wgid % NXCD, off = wgid / NXCD; wgid = (xcd < r ? xcd * (q + 1) : r * (q + 1) + (xcd - r) * q) + off; }
        const int nig = WGM * nN, gid = wgid / nig, fm = gid * WGM, gsz = (nM - fm) < WGM ? (nM - fm) : WGM;
        u.pm = fm + ((wgid % nig) % gsz); u.pn = (wgid % nig) / gsz; return true;
    }
    __device__ __forceinline__ void a_ready(const Unit&) const {}
    __device__ __forceinline__ void done(const Unit&) const {}
};
__device__ __forceinline__ unsigned cvt_pk_bf16(float lo, float hi) { unsigned r; asm volatile("v_cvt_pk_bf16_f32 %0, %1, %2" : "=v"(r) : "v"(lo), "v"(hi)); return r; }
typedef float f32x2 __attribute__((ext_vector_type(2)));
struct EpiBf16S {
    static constexpr bool PERM = true, AFTER_DRAIN = false;
    bf16_t* O; int ldc; int sc_lo, sc_hi; float scale;
    __device__ __forceinline__ void operator()(const f32x4 (&acc)[2][2][4][2], const Unit& u, int wr, int wc, int fr, int fq) const {
        const int row0 = u.pm * BM + wr * 64 + fr; const int colt = u.pn * BM;
        const float sc = (colt >= sc_lo && colt < sc_hi) ? scale : 1.f;
        const int col0 = colt + wc * 32 + 8 * fq;
#pragma unroll
        for (int ai = 0; ai < 2; ++ai)
#pragma unroll
            for (int m = 0; m < 4; ++m) { bf16_t* rowp = O + (size_t)(row0 + ai * HALF + m * 16) * ldc + col0;
#pragma unroll
                for (int bj = 0; bj < 2; ++bj) { const f32x4 v0 = acc[ai][bj][m][0] * sc, v1 = acc[ai][bj][m][1] * sc;
                    u32x4 w; w.x = cvt_pk_bf16(v0[0], v0[1]); w.y = cvt_pk_bf16(v0[2], v0[3]); w.z = cvt_pk_bf16(v1[0], v1[1]); w.w = cvt_pk_bf16(v1[2], v1[3]);
                    *(u32x4*)(rowp + bj * HALF) = w; } }
    }
};
struct EpiSwiglu {
    static constexpr bool PERM = true, AFTER_DRAIN = false;
    bf16_t* O; int ldc;
    __device__ __forceinline__ void operator()(const f32x4 (&acc)[2][2][4][2], const Unit& u, int wr, int wc, int fr, int fq) const {
        const int row0 = u.pm * BM + wr * 64 + fr; const int col0 = u.pn * HALF + wc * 32 + 8 * fq;
#pragma unroll
        for (int ai = 0; ai < 2; ++ai)
#pragma unroll
            for (int m = 0; m < 4; ++m) { bf16_t* rowp = O + (size_t)(row0 + ai * HALF + m * 16) * ldc + col0;
                float a[8];
#pragma unroll
                for (int n = 0; n < 2; ++n)
#pragma unroll
                    for (int e = 0; e < 4; ++e) { const float g = acc[ai][0][m][n][e], up = acc[ai][1][m][n][e];
                        const float sg = g * __builtin_amdgcn_rcpf(1.0f + __builtin_amdgcn_exp2f(-1.4426950408889634f * g)); a[n * 4 + e] = sg * up; }
                u32x4 w; w.x = cvt_pk_bf16(a[0], a[1]); w.y = cvt_pk_bf16(a[2], a[3]); w.z = cvt_pk_bf16(a[4], a[5]); w.w = cvt_pk_bf16(a[6], a[7]);
                *(u32x4*)rowp = w; }
    }
};
typedef _Float16 f16x4 __attribute__((ext_vector_type(4)));
typedef _Float16 f16x8 __attribute__((ext_vector_type(8)));
typedef float f32x8 __attribute__((ext_vector_type(8)));
struct EpiResF32 {
    static constexpr bool PERM = true, AFTER_DRAIN = false;
    const void* base; _Float16* out; int ldc; float alpha; int base32;
    __device__ __forceinline__ void operator()(const f32x4 (&acc)[2][2][4][2], const Unit& u, int wr, int wc, int fr, int fq) const {
        const int col0 = u.pn * BM + wc * 32 + 8 * fq;
#pragma unroll
        for (int ai = 0; ai < 2; ++ai) {
            f32x8 pre[4][2];
#pragma unroll
            for (int m = 0; m < 4; ++m) { const size_t off = (size_t)(u.pm * BM + ai * HALF + wr * 64 + m * 16 + fr) * ldc + col0;
#pragma unroll
                for (int bj = 0; bj < 2; ++bj) {
                    if (base32) { const f32x4 lo = *(const f32x4*)((const float*)base + off + bj * HALF), hi4 = *(const f32x4*)((const float*)base + off + bj * HALF + 4);
                        pre[m][bj] = (f32x8){lo[0], lo[1], lo[2], lo[3], hi4[0], hi4[1], hi4[2], hi4[3]}; }
                    else pre[m][bj] = __builtin_convertvector(*(const f16x8*)((const _Float16*)base + off + bj * HALF), f32x8); } }
            asm volatile("" ::: "memory");
#pragma unroll
            for (int m = 0; m < 4; ++m) { const size_t off = (size_t)(u.pm * BM + ai * HALF + wr * 64 + m * 16 + fr) * ldc + col0;
#pragma unroll
                for (int bj = 0; bj < 2; ++bj) { const f32x4 a0 = acc[ai][bj][m][0] * alpha, a1 = acc[ai][bj][m][1] * alpha; const f32x8 p = pre[m][bj];
                    const f32x8 o = {a0[0] + p[0], a0[1] + p[1], a0[2] + p[2], a0[3] + p[3], a1[0] + p[4], a1[1] + p[5], a1[2] + p[6], a1[3] + p[7]};
                    *(f16x8*)(out + off + bj * HALF) = __builtin_convertvector(o, f16x8); } }
            asm volatile("" ::: "memory");
        }
    }
};

struct EpiMlaIn {
    static constexpr bool PERM = false, AFTER_DRAIN = true;
    bf16_t* cqn; bf16_t* ckvn; bf16_t* kr; const float* qn; const float* kvn; const float* cs;
    __device__ __forceinline__ void fused(f32x4 (&acc)[2][2][4][2], const Unit& u, int wr, int wc, int fr, int fq, PG8_LAS unsigned char* lds, int wid, int lane) const {
        typedef unsigned u32x2_t __attribute__((ext_vector_type(2)));
        PG8_LAS float* P = (PG8_LAS float*)lds;
        const bool isq = (u.pn == 0);
#pragma unroll
        for (int ai = 0; ai < 2; ++ai)
#pragma unroll
            for (int m = 0; m < 4; ++m) { float s = 0.f;
#pragma unroll
                for (int n = 0; n < 2; ++n) { const f32x4 x = acc[ai][0][m][n]; s += (x[0] * x[0] + x[1] * x[1]) + (x[2] * x[2] + x[3] * x[3]); }
                if (isq) {
#pragma unroll
                    for (int n = 0; n < 2; ++n) { const f32x4 x = acc[ai][1][m][n]; s += (x[0] * x[0] + x[1] * x[1]) + (x[2] * x[2] + x[3] * x[3]); } }
                s += __shfl_xor(s, 16); s += __shfl_xor(s, 32);
                if (fq == 0) P[(ai * HALF + wr * 64 + m * 16 + fr) * 4 + wc] = s; }
        asm volatile("s_waitcnt lgkmcnt(0)" ::: "memory"); __builtin_amdgcn_s_barrier(); asm volatile("" ::: "memory");
#pragma unroll
        for (int ai = 0; ai < 2; ++ai)
#pragma unroll
            for (int m = 0; m < 4; ++m) { const int rl = ai * HALF + wr * 64 + m * 16 + fr; const size_t r = (size_t)u.pm * BM + rl;
                const f32x4 p4 = *(const PG8_LAS f32x4*)(P + rl * 4); const float ss = (p4[0] + p4[1]) + (p4[2] + p4[3]);
                if (isq) { const float rstd = 1.0f / sqrtf(ss * (1.0f / 256.0f) + 1e-6f);
#pragma unroll
                    for (int bj = 0; bj < 2; ++bj)
#pragma unroll
                        for (int n = 0; n < 2; ++n) { const int c = bj * HALF + wc * 32 + n * 16 + 4 * fq; const f32x4 g4 = *(const f32x4*)(qn + c); const f32x4 y = acc[ai][bj][m][n] * rstd * g4;
                            u32x2_t w; w.x = cvt_pk_bf16(y[0], y[1]); w.y = cvt_pk_bf16(y[2], y[3]); *(u32x2_t*)(cqn + r * 256 + c) = w; }
                } else { const float rstd = 1.0f / sqrtf(ss * (1.0f / 128.0f) + 1e-6f);
#pragma unroll
                    for (int n = 0; n < 2; ++n) { const int c = wc * 32 + n * 16 + 4 * fq; const f32x4 g4 = *(const f32x4*)(kvn + c); const f32x4 y = acc[ai][0][m][n] * rstd * g4;
                        u32x2_t w; w.x = cvt_pk_bf16(y[0], y[1]); w.y = cvt_pk_bf16(y[2], y[3]); *(u32x2_t*)(ckvn + r * 256 + c) = w;
                        u32x2_t z; z.x = 0u; z.y = 0u; *(u32x2_t*)(ckvn + r * 256 + HALF + c) = z; }
                    if (wc == 0) { const int i0 = 4 * fq; const f32x4 x1 = acc[ai][1][m][0], x2 = acc[ai][1][m][1];
                        const f32x4 c4 = *(const f32x4*)(cs + r * 32 + i0), s4 = *(const f32x4*)(cs + r * 32 + 16 + i0);
                        const f32x4 o1 = x1 * c4 - x2 * s4, o2 = x2 * c4 + x1 * s4;
                        u32x2_t w1, w2; w1.x = cvt_pk_bf16(o1[0], o1[1]); w1.y = cvt_pk_bf16(o1[2], o1[3]); w2.x = cvt_pk_bf16(o2[0], o2[1]); w2.y = cvt_pk_bf16(o2[2], o2[3]);
                        *(u32x2_t*)(kr + r * 32 + i0) = w1; *(u32x2_t*)(kr + r * 32 + 16 + i0) = w2; } } }
        asm volatile("s_waitcnt lgkmcnt(0)" ::: "memory"); __builtin_amdgcn_s_barrier(); asm volatile("" ::: "memory");
    }
};

template <class Epi, class Sched, bool ALIGN_EPI = false, bool SP2 = false>
__device__ __forceinline__ void gemm_phase(PG8_LAS unsigned char* lds, const Gemm g, const Sched& S, const Epi& E) {
    int tid_l = threadIdx.x; asm volatile("" : "+v"(tid_l));
    const int tid = tid_l, wid = __builtin_amdgcn_readfirstlane(tid >> 6), lane = tid & 63, wr = wid >> 2, wc = wid & 3, fr = lane & 15, fq = lane >> 4;
    const int K = g.K, nt = K / BK;
    unsigned voffA[2], voffB[2];
#pragma unroll
    for (int i = 0; i < 2; ++i) { int R, C; stage_rc(tid * 16 + i * 8192, R, C); const int Rb = Epi::PERM ? ((R & ~31) + perm32(R & 31)) : R;
        voffA[i] = (unsigned)(R * K + C) * 2u; voffB[i] = (unsigned)(Rb * K + C) * 2u; }
    const size_t kstep = (size_t)(BK * 2);
    const size_t hstep = (size_t)HALF * K * 2;
    const size_t tstep = 2 * hstep;
    const unsigned ldsw = (unsigned)wid * 1024u;
    const int aoff = lds_byte(wr * 64 + fr, fq * 8), boff = lds_byte(wc * 32 + fr, fq * 8);
#define PG8_SA(b, h) (((b) * 2 + (h)) * HTB)
#define PG8_SB(b, h) ((4 + (b) * 2 + (h)) * HTB)
#define PG8_STAGE(bufoff, gbase, voff) do { _Pragma("unroll") for (int _i = 0; _i < 2; ++_i) \
        __builtin_amdgcn_global_load_lds((const unsigned*)((const char*)(gbase) + (voff)[_i]), (PG8_LAS unsigned*)(lds + (bufoff) + ldsw + _i * 8192), 16, 0, 0); } while (0)
#define PG8_LDA(dst, b, h) do { _Pragma("unroll") for (int m = 0; m < 4; ++m) _Pragma("unroll") for (int k = 0; k < 2; ++k) dst[m][k] = *(const PG8_LAS bf16x8*)(lds + PG8_SA(b, h) + aoff + m * 2048 + k * 1024); } while (0)
#define PG8_LDB(dst, b, h) do { _Pragma("unroll") for (int n = 0; n < 2; ++n) _Pragma("unroll") for (int k = 0; k < 2; ++k) dst[n][k] = *(const PG8_LAS bf16x8*)(lds + PG8_SB(b, h) + boff + n * 2048 + k * 1024); } while (0)
#define PG8_MMA(ai, bj, At, Bt) do { __builtin_amdgcn_s_setprio(1); _Pragma("unroll") for (int m = 0; m < 4; ++m) _Pragma("unroll") for (int n = 0; n < 2; ++n) _Pragma("unroll") for (int k = 0; k < 2; ++k) \
        acc[ai][bj][m][n] = __builtin_amdgcn_mfma_f32_16x16x32_bf16(Bt[n][k], At[m][k], acc[ai][bj][m][n], 0, 0, 0); __builtin_amdgcn_s_setprio(0); } while (0)
#define PG8_WAIT_V(n) asm volatile("s_waitcnt vmcnt(" #n ")" ::: "memory")
#define PG8_WAIT_L(n) asm volatile("s_waitcnt lgkmcnt(" #n ")" ::: "memory")
#define PG8_BAR __builtin_amdgcn_s_barrier()
#define PG8_SCHED __builtin_amdgcn_sched_barrier(0)
    Unit cur, nxt; int ui = 0;
    if (!S.next(0, cur)) return;
    f32x4 acc[2][2][4][2];
#pragma unroll
    for (int a = 0; a < 2; ++a)
#pragma unroll
        for (int b = 0; b < 2; ++b)
#pragma unroll
            for (int m = 0; m < 4; ++m)
#pragma unroll
                for (int n = 0; n < 2; ++n) acc[a][b][m][n] = (f32x4){0.f, 0.f, 0.f, 0.f};
    bf16x8 At[4][2], B0[2][2], B1[2][2];
    const char* cA = (const char*)g.A + (size_t)cur.pm * tstep; const char* cB = (const char*)g.Bt + (size_t)cur.pn * tstep;
    S.a_ready(cur);
    if constexpr (SP2) {
        PG8_STAGE(PG8_SB(0, 0), cB, voffB); PG8_STAGE(PG8_SB(0, 1), cB + hstep, voffB); PG8_STAGE(PG8_SA(0, 0), cA, voffA); PG8_STAGE(PG8_SA(0, 1), cA + hstep, voffA);
        if (wr == 1) PG8_BAR;
        PG8_WAIT_V(2); PG8_BAR;
        PG8_STAGE(PG8_SB(1, 0), cB + kstep, voffB); PG8_STAGE(PG8_SA(1, 0), cA + kstep, voffA); PG8_STAGE(PG8_SB(1, 1), cB + hstep + kstep, voffB);
        PG8_WAIT_V(6); PG8_BAR;
    } else {
        PG8_STAGE(PG8_SB(0, 0), cB, voffB); PG8_STAGE(PG8_SA(0, 0), cA, voffA); PG8_STAGE(PG8_SB(0, 1), cB + hstep, voffB); PG8_STAGE(PG8_SA(0, 1), cA + hstep, voffA);
        if (wr == 1) PG8_BAR;
        PG8_WAIT_V(4); PG8_BAR;
        PG8_STAGE(PG8_SB(1, 0), cB + kstep, voffB); PG8_STAGE(PG8_SA(1, 0), cA + kstep, voffA); PG8_STAGE(PG8_SB(1, 1), cB + hstep + kstep, voffB);
        PG8_WAIT_V(6); PG8_BAR;
    }
    for (;;) {
        const bool has_next = S.next(ui + 1, nxt);
        const char* nA = has_next ? (const char*)g.A + (size_t)nxt.pm * tstep : cA; const char* nB = has_next ? (const char*)g.Bt + (size_t)nxt.pn * tstep : cB;
        for (int t = 0; t < nt; t += 2) {
            const bool last = (t == nt - 2);
            const char* a1 = cA + (size_t)(t + 1) * kstep;
            const char* a2 = last ? nA : cA + (size_t)(t + 2) * kstep; const char* b2 = last ? nB : cB + (size_t)(t + 2) * kstep;
            const char* a3 = a2 + kstep; const char* b3 = b2 + kstep;
            if (last && has_next) S.a_ready(nxt);
            if constexpr (SP2) {
            PG8_LDB(B0, 0, 0); PG8_LDB(B1, 0, 1); PG8_SCHED; PG8_LDA(At, 0, 0); PG8_STAGE(PG8_SA(1, 1), a1 + hstep, voffA);
            PG8_WAIT_V(8); PG8_WAIT_L(0); PG8_BAR; PG8_MMA(0, 0, At, B0); PG8_MMA(0, 1, At, B1); PG8_BAR; PG8_SCHED;
            PG8_LDA(At, 0, 1); PG8_STAGE(PG8_SB(0, 0), b2, voffB); PG8_STAGE(PG8_SB(0, 1), b2 + hstep, voffB); PG8_STAGE(PG8_SA(0, 0), a2, voffA);
            PG8_WAIT_V(8); PG8_WAIT_L(0); PG8_BAR; PG8_MMA(1, 0, At, B0); PG8_MMA(1, 1, At, B1); PG8_BAR; PG8_SCHED;
            PG8_LDB(B0, 1, 0); PG8_LDB(B1, 1, 1); PG8_SCHED; PG8_LDA(At, 1, 0); PG8_STAGE(PG8_SA(0, 1), a2 + hstep, voffA);
            PG8_WAIT_V(8); PG8_WAIT_L(0); PG8_BAR; PG8_MMA(0, 0, At, B0); PG8_MMA(0, 1, At, B1); PG8_BAR; PG8_SCHED;
            PG8_LDA(At, 1, 1); PG8_STAGE(PG8_SB(1, 0), b3, voffB); PG8_STAGE(PG8_SB(1, 1), b3 + hstep, voffB); PG8_STAGE(PG8_SA(1, 0), a3, voffA);
            PG8_WAIT_V(8); PG8_WAIT_L(0); PG8_BAR; PG8_MMA(1, 0, At, B0); PG8_MMA(1, 1, At, B1); PG8_BAR; PG8_SCHED;
            } else {
            PG8_LDB(B0, 0, 0); PG8_SCHED; PG8_LDA(At, 0, 0); PG8_STAGE(PG8_SA(1, 1), a1 + hstep, voffA);
            PG8_WAIT_L(8); PG8_BAR; PG8_WAIT_L(0); PG8_MMA(0, 0, At, B0); PG8_BAR; PG8_SCHED;
            PG8_LDB(B1, 0, 1); PG8_STAGE(PG8_SB(0, 0), b2, voffB);
            PG8_BAR; PG8_WAIT_L(0); PG8_MMA(0, 1, At, B1); PG8_BAR;
            PG8_LDA(At, 0, 1); PG8_STAGE(PG8_SA(0, 0), a2, voffA);
            PG8_BAR; PG8_WAIT_L(0); PG8_MMA(1, 0, At, B0); PG8_BAR; PG8_SCHED;
            PG8_STAGE(PG8_SB(0, 1), b2 + hstep, voffB);
            PG8_WAIT_V(6); PG8_BAR; PG8_MMA(1, 1, At, B1); PG8_BAR;
            PG8_LDB(B0, 1, 0); PG8_SCHED; PG8_LDA(At, 1, 0); PG8_STAGE(PG8_SA(0, 1), a2 + hstep, voffA);
            PG8_WAIT_L(8); PG8_BAR; PG8_WAIT_L(0); PG8_MMA(0, 0, At, B0); PG8_BAR; PG8_SCHED;
            PG8_LDB(B1, 1, 1); PG8_STAGE(PG8_SB(1, 0), b3, voffB);
            PG8_BAR; PG8_WAIT_L(0); PG8_MMA(0, 1, At, B1); PG8_BAR;
            PG8_LDA(At, 1, 1); PG8_STAGE(PG8_SA(1, 0), a3, voffA);
            PG8_BAR; PG8_WAIT_L(0); PG8_MMA(1, 0, At, B0); PG8_BAR; PG8_SCHED;
            PG8_STAGE(PG8_SB(1, 1), b3 + hstep, voffB);
            PG8_WAIT_V(6); PG8_BAR; PG8_MMA(1, 1, At, B1); PG8_BAR;
            }
        }
        if constexpr (ALIGN_EPI) { if (wr == 0) PG8_BAR; }
        if constexpr (!Epi::AFTER_DRAIN) { E(acc, cur, wr, wc, fr, fq); S.done(cur); }
        if (!has_next) break;
#pragma unroll
        for (int a = 0; a < 2; ++a)
#pragma unroll
            for (int b = 0; b < 2; ++b)
#pragma unroll
                for (int m = 0; m < 4; ++m)
#pragma unroll
                    for (int n = 0; n < 2; ++n) acc[a][b][m][n] = (f32x4){0.f, 0.f, 0.f, 0.f};
        cur = nxt; cA = nA; cB = nB; ++ui;
        if constexpr (ALIGN_EPI) { if (wr == 1) PG8_BAR; }
    }
    PG8_WAIT_V(0);
    if constexpr (!ALIGN_EPI) { if (wr == 0) PG8_BAR; }
    PG8_BAR;
    if constexpr (Epi::AFTER_DRAIN) { E.fused(acc, cur, wr, wc, fr, fq, lds, wid, lane); S.done(cur); }
#undef PG8_SA
#undef PG8_SB
#undef PG8_STAGE
#undef PG8_LDA
#undef PG8_LDB
#undef PG8_MMA
#undef PG8_WAIT_V
#undef PG8_WAIT_L
#undef PG8_BAR
#undef PG8_SCHED
}
}
#define LAS __attribute__((address_space(3)))
typedef unsigned short bf16_t;
typedef short bf16x8 __attribute__((ext_vector_type(8)));
typedef float f32x4 __attribute__((ext_vector_type(4)));
typedef float f32x16 __attribute__((ext_vector_type(16)));
typedef unsigned u32x4 __attribute__((ext_vector_type(4)));
typedef unsigned u32x2 __attribute__((ext_vector_type(2)));

constexpr int SEQ = 16384, NB = 2, T = NB * SEQ, DM = 1024, FF = 2816;
constexpr size_t MiB = 1u << 20;
constexpr size_t WS_W = 0, WS_HN = 48 * MiB, WS_Y = 112 * MiB, WS_R1 = 176 * MiB, WS_VT = 352 * MiB, WS_KN = WS_HN, WS_H16 = 416 * MiB, WS_SM = 480 * MiB, WS_END = 488 * MiB;
constexpr size_t W_GU0 = 0, W_D0 = 11 * MiB, W_GU1 = 17 * MiB, W_D1 = 28 * MiB, W_MIX = 34 * MiB;
constexpr size_t W_IN = W_MIX, W_V = W_MIX + 3 * MiB, W_OUT = W_MIX + 4 * MiB, W_P = W_MIX + 6 * MiB;
constexpr size_t W_MIN = W_MIX, W_QB = W_MIX + 1 * MiB, W_KNW = W_MIX + 2 * MiB, W_VVW = W_MIX + 2 * MiB + 512 * 1024;
constexpr size_t R_Q = 0, R_CQN = 96 * MiB, R_CKVN = 112 * MiB, R_KR = 128 * MiB;
constexpr size_t SM_LF = 0, SM_F = 1 * MiB, SM_KQ = 3 * MiB, SM_CTR = 3 * MiB + 1024, SM_BAR = 3 * MiB + 65536, SM_KQP = 3 * MiB + 131072, SM_CS = 4 * MiB;
constexpr int LDS_BYTES = 147456;
constexpr float LOG2E = 1.4426950408889634f;
constexpr int NPH = 49;
#ifndef PROBE_KMASK
#define PROBE_KMASK 0
#endif
#ifndef EN_MASK
#define EN_MASK 0xFFFF
#endif
#define EN(b) ((EN_MASK >> (b)) & 1)

struct Args {
    const float* x; const int* pos; const float* norm_ffn; const float* norm_mix; const float* norm_final;
    const float* w_gate; const float* w_up; const float* w_down;
    const float* ab_w_in; const float* ab_b_forget; const float* pool_w; const float* pool_scale; const float* ab_w_out;
    const float* mla_w_in; const float* mla_q_norm; const float* mla_kv_norm; const float* mla_w_q_b; const float* mla_w_kv_b; const float* mla_w_out;
    float* out; unsigned char* ws; int ph_lo, ph_hi; int do_sync, pad;
};

__device__ __forceinline__ float wave_sum(float v) {
#pragma unroll
    for (int o = 1; o < 64; o <<= 1) v += __shfl_xor(v, o);
    return v;
}
typedef float f32x2_t __attribute__((ext_vector_type(2))); typedef __bf16 bf16x2_t __attribute__((ext_vector_type(2)));
__device__ __forceinline__ unsigned pk2(float lo, float hi) { f32x2_t v = {lo, hi}; bf16x2_t b = __builtin_convertvector(v, bf16x2_t); return __builtin_bit_cast(unsigned, b); }
__device__ __forceinline__ float bflo(unsigned w) { return __uint_as_float(w << 16); }
__device__ __forceinline__ float bfhi(unsigned w) { return __uint_as_float(w & 0xffff0000u); }
__device__ __forceinline__ float max3f(float a, float b, float c) { float r; asm("v_max3_f32 %0, %1, %2, %3" : "=v"(r) : "v"(a), "v"(b), "v"(c)); return r; }
#define LDS_FENCE() asm volatile("s_waitcnt lgkmcnt(0)" ::: "memory")
#define LBAR() do { asm volatile("s_waitcnt lgkmcnt(0)" ::: "memory"); __builtin_amdgcn_s_barrier(); asm volatile("" ::: "memory"); } while (0)

__device__ __forceinline__ void transpose_item(const float* __restrict__ src, int ld, int k0, bf16_t* __restrict__ dst, int ldd, LAS float* scr, int lane) {
#pragma unroll 8
    for (int i = 0; i < 32; ++i) { const int kk = 2 * i + (lane >> 5); scr[kk * 33 + (lane & 31)] = src[(size_t)(k0 + kk) * ld + (lane & 31)]; }
    LDS_FENCE();
    const int c = lane & 7;
#pragma unroll
    for (int j = 0; j < 4; ++j) { const int n = (lane >> 3) + 8 * j; const LAS float* s = scr + (8 * c) * 33 + n;
        u32x4 o; o.x = pk2(s[0 * 33], s[1 * 33]); o.y = pk2(s[2 * 33], s[3 * 33]); o.z = pk2(s[4 * 33], s[5 * 33]); o.w = pk2(s[6 * 33], s[7 * 33]);
        *(u32x4*)(dst + (size_t)n * ldd + k0 + 8 * c) = o; }
    LDS_FENCE();
}

__device__ __forceinline__ void convert_layer(const Args& A, int l, LAS float* scr, int gw, int NGW, int lane) {
    const int i = l >> 1; const bool even = !(l & 1);
    constexpr int NF = 1408;
    unsigned char* W = A.ws + WS_W;
    const int total = 6 * NF + (even ? (768 + 256 + 512 + 32) : (208 + 192 + 128 + 512));
    for (int it = gw; it < total; it += NGW) {
        int r = it;
        if (r < 6 * NF) {
            const int f = r / (3 * NF), r2 = r % (3 * NF), kind = r2 / NF, q = r2 % NF;
            const size_t wo = (size_t)(l * 2 + f) * DM * FF;
            if (kind < 2) { const int kb = q / 88, nb = q % 88; const float* src = (kind == 0 ? A.w_gate : A.w_up) + wo + 32 * nb;
                bf16_t* dst = (bf16_t*)(W + (f ? W_GU1 : W_GU0)) + (size_t)((nb >> 2) * 256 + (nb & 3) * 32 + kind * 128) * DM;
                transpose_item(src, FF, 64 * kb, dst, DM, scr, lane); }
            else { const int kb = q / 32, nb = q % 32; const float* src = A.w_down + wo + 32 * nb;
                bf16_t* dst = (bf16_t*)(W + (f ? W_D1 : W_D0)) + (size_t)(32 * nb) * FF;
                transpose_item(src, DM, 64 * kb, dst, FF, scr, lane); }
            continue;
        }
        r -= 6 * NF;
        if (even) {
            const float* win = A.ab_w_in + (size_t)i * DM * 2056;
            if (r < 768) { const int kb = r / 48, nb = r % 48; transpose_item(win + 32 * nb, 2056, 64 * kb, (bf16_t*)(W + W_IN) + (size_t)(32 * nb) * DM, DM, scr, lane); continue; } r -= 768;
            if (r < 256) { const int kb = r / 16, nb = r % 16; transpose_item(win + 1536 + 32 * nb, 2056, 64 * kb, (bf16_t*)(W + W_V) + (size_t)(32 * nb) * DM, DM, scr, lane); continue; } r -= 256;
            if (r < 512) { const int kb = r / 32, nb = r % 32; transpose_item(A.ab_w_out + (size_t)i * DM * DM + 32 * nb, DM, 64 * kb, (bf16_t*)(W + W_OUT) + (size_t)(32 * nb) * DM, DM, scr, lane); continue; } r -= 512;
            { const int g = r >> 3, kb = (r & 7) >> 2, nb = r & 3; transpose_item(A.pool_w + (size_t)(i * 4 + g) * 16384 + 32 * nb, 128, 64 * kb, (bf16_t*)(W + W_P) + (size_t)g * 16384 + (size_t)(32 * nb) * 128, 128, scr, lane); }
        } else {
            if (r < 208) { const int kb = r / 13, nb = r % 13; transpose_item(A.mla_w_in + (size_t)i * DM * 416 + 32 * nb, 416, 64 * kb, (bf16_t*)(W + W_MIN) + (size_t)(32 * nb) * DM, DM, scr, lane); continue; } r -= 208;
            if (r < 192) { const int kb = r / 48, nb = r % 48; transpose_item(A.mla_w_q_b + (size_t)i * 256 * 1536 + 32 * nb, 1536, 64 * kb, (bf16_t*)(W + W_QB) + (size_t)(32 * nb) * 256, 256, scr, lane); continue; } r -= 192;
            if (r < 128) { const int kb = r / 64, nb = r % 64; const int col0 = 32 * nb, head = col0 >> 7, within = col0 & 127;
                bf16_t* dst = (within < 64) ? (bf16_t*)(W + W_KNW) + (size_t)(64 * head + within) * 256 : (bf16_t*)(W + W_VVW) + (size_t)(64 * head + within - 64) * 256;
                transpose_item(A.mla_w_kv_b + (size_t)i * 128 * 2048 + col0, 2048, 64 * kb, dst, 256, scr, lane); continue; } r -= 128;
            { const int kb = r / 32, nb = r % 32; transpose_item(A.mla_w_out + (size_t)i * DM * DM + 32 * nb, DM, 64 * kb, (bf16_t*)(W + W_OUT) + (size_t)(32 * nb) * DM, DM, scr, lane); }
        }
    }
    if (!even) {
        const int gt = gw * 64 + lane, NT_ = NGW * 64;
        for (int idx = gt; idx < 2048 * 16; idx += NT_) { const int row = idx >> 4, c = idx & 15;
            *(u32x4*)((bf16_t*)(W + W_KNW) + (size_t)row * 256 + 128 + 8 * c) = (u32x4){0u, 0u, 0u, 0u}; }
    }
}

__constant__ float ROPE_INVF[16] = {(float)1.0, (float)0.5623413251903491, (float)0.31622776601683794, (float)0.1778279410038923, (float)0.1, (float)0.05623413251903491, (float)0.031622776601683794, (float)0.01778279410038923,
    (float)0.01, (float)0.005623413251903491, (float)0.0031622776601683794, (float)0.001778279410038923, (float)0.001, (float)0.0005623413251903491, (float)0.00031622776601683794, (float)0.0001778279410038923};
__device__ __forceinline__ void rope_table(const Args& A, int gw, int NGW, int lane) {
    float* CS = (float*)(A.ws + WS_SM + SM_CS);
    const int gt = gw * 64 + lane, NT_ = NGW * 64;
    for (int idx = gt; idx < T * 16; idx += NT_) {
        const int t = idx >> 4, j = idx & 15;
        const float invf = ROPE_INVF[j];
        const float ang = (float)A.pos[t] * invf;
        const double rev = (double)ang * 0.15915494309189535;
        const float fr = (float)(rev - __builtin_rint(rev));
        CS[(size_t)t * 32 + j] = __builtin_amdgcn_cosf(fr);
        CS[(size_t)t * 32 + 16 + j] = __builtin_amdgcn_sinf(fr);
    }
}

typedef _Float16 h16x4 __attribute__((ext_vector_type(4)));
template <int MODE, bool SRC16>
__device__ __forceinline__ void norm_phase(const void* src, const float* __restrict__ g, bf16_t* dst16, float* dst32,
                                           const float* __restrict__ wfsrc, const float* __restrict__ bforget, float* LF, LAS float* wfT, int gw, int NGW, int lane, int tid) {
    if (MODE == 1) {
        for (int idx = tid; idx < 8192; idx += 512) { const int k = idx >> 3, f = idx & 7; wfT[f * 1024 + k] = wfsrc[(size_t)k * 2056 + 2048 + f]; }
        LDS_FENCE(); __syncthreads();
    }
    f32x4 gv[4];
#pragma unroll
    for (int j = 0; j < 4; ++j) gv[j] = *(const f32x4*)(g + 4 * lane + 256 * j);
    constexpr int NR = (MODE == 1) ? 2 : 4;
    for (int mb = gw * NR; mb < T; mb += NGW * NR) {
        f32x4 v[NR][4]; float ss[NR];
#pragma unroll
        for (int r = 0; r < NR; ++r) {
            if (SRC16) { const h16x4* xr = (const h16x4*)((const _Float16*)src + (size_t)(mb + r) * DM) + lane;
#pragma unroll
                for (int j = 0; j < 4; ++j) v[r][j] = __builtin_convertvector(xr[64 * j], f32x4); }
            else { const f32x4* xr = (const f32x4*)((const float*)src + (size_t)(mb + r) * DM) + lane;
#pragma unroll
                for (int j = 0; j < 4; ++j) v[r][j] = xr[64 * j]; } }
#pragma unroll
        for (int r = 0; r < NR; ++r) { float a = 0.f;
#pragma unroll
            for (int j = 0; j < 4; ++j) a += (v[r][j].x * v[r][j].x + v[r][j].y * v[r][j].y) + (v[r][j].z * v[r][j].z + v[r][j].w * v[r][j].w);
            ss[r] = a; }
#pragma unroll
        for (int o = 1; o < 64; o <<= 1) {
#pragma unroll
            for (int r = 0; r < NR; ++r) ss[r] += __shfl_xor(ss[r], o); }
#pragma unroll
        for (int r = 0; r < NR; ++r) {
            const int m = mb + r;
            const float rstd = 1.0f / sqrtf(ss[r] * (1.0f / DM) + 1e-6f);
#pragma unroll
            for (int j = 0; j < 4; ++j) v[r][j] = v[r][j] * rstd * gv[j];
            if (MODE == 2) {
                f32x4* o = (f32x4*)(dst32 + (size_t)m * DM) + lane;
#pragma unroll
                for (int j = 0; j < 4; ++j) o[64 * j] = v[r][j];
            } else {
                u32x2* o = (u32x2*)(dst16 + (size_t)m * DM) + lane;
#pragma unroll
                for (int j = 0; j < 4; ++j) { u32x2 w; w.x = pk2(v[r][j].x, v[r][j].y); w.y = pk2(v[r][j].z, v[r][j].w); o[64 * j] = w; }
            }
            if (MODE == 1) {
                float mine = 0.f;
#pragma unroll
                for (int f = 0; f < 8; ++f) { float a = 0.f;
#pragma unroll
                    for (int j = 0; j < 4; ++j) { const f32x4 w = *(const LAS f32x4*)(wfT + f * 1024 + 4 * lane + 256 * j); a += (v[r][j].x * w.x + v[r][j].y * w.y) + (v[r][j].z * w.z + v[r][j].w * w.w); }
                    a = wave_sum(a); mine = (lane == f) ? a : mine; }
                if (lane < 8) { const float xx = mine + bforget[lane];
                    const float ax = fabsf(xx); const float sp = __builtin_amdgcn_logf(1.0f + __builtin_amdgcn_exp2f(-ax * LOG2E)) * 0.6931471805599453f;
                    const float ls = (xx < 0.f ? xx : 0.f) - sp;
                    const int b = m / SEQ, t = m % SEQ; LF[(size_t)(b * 8 + lane) * SEQ + t] = ls; }
            }
        }
    }
}

__device__ __forceinline__ void mla_small(const Args& A, int i, int gw, int NGW, int lane) {
    const float* PROJ = (const float*)(A.ws + WS_Y);
    bf16_t* CQN = (bf16_t*)(A.ws + WS_R1 + R_CQN); bf16_t* CKVN = (bf16_t*)(A.ws + WS_R1 + R_CKVN); bf16_t* KR = (bf16_t*)(A.ws + WS_R1 + R_KR);
    const float* CS = (const float*)(A.ws + WS_SM + SM_CS);
    const f32x4 gq = *(const f32x4*)(A.mla_q_norm + (size_t)i * 256 + 4 * lane);
    const f32x4 gk = *(const f32x4*)(A.mla_kv_norm + (size_t)i * 128 + 4 * (lane & 31));
    for (int mb = gw * 4; mb < T; mb += NGW * 4) {
        f32x4 av[4], bv[4];
#pragma unroll
        for (int r = 0; r < 4; ++r) { const float* row = PROJ + (size_t)(mb + r) * 512; av[r] = *(const f32x4*)(row + 4 * lane); bv[r] = (f32x4){0.f, 0.f, 0.f, 0.f}; if (lane < 40) bv[r] = *(const f32x4*)(row + 256 + 4 * lane); }
#pragma unroll
        for (int r = 0; r < 4; ++r) {
            const int m = mb + r; const f32x4 a = av[r], b = bv[r];
            const float sq = wave_sum((a.x * a.x + a.y * a.y) + (a.z * a.z + a.w * a.w));
            const float skv = wave_sum(lane < 32 ? (b.x * b.x + b.y * b.y) + (b.z * b.z + b.w * b.w) : 0.f);
            const float rq = 1.0f / sqrtf(sq * (1.0f / 256.0f) + 1e-6f), rkv = 1.0f / sqrtf(skv * (1.0f / 128.0f) + 1e-6f);
            { const f32x4 y = a * rq * gq; u32x2 w; w.x = pk2(y.x, y.y); w.y = pk2(y.z, y.w); *(u32x2*)(CQN + (size_t)m * 256 + 4 * lane) = w; }
            { const f32x4 y = b * rkv * gk; u32x2 w; w.x = pk2(y.x, y.y); w.y = pk2(y.z, y.w); if (lane >= 32) { w.x = 0u; w.y = 0u; }
              *(u32x2*)(CKVN + (size_t)m * 256 + 4 * lane) = w; }
            f32x4 p; p.x = __shfl_xor(b.x, 4); p.y = __shfl_xor(b.y, 4); p.z = __shfl_xor(b.z, 4); p.w = __shfl_xor(b.w, 4);
            if (lane >= 32 && lane < 40) { const int i0 = 4 * ((lane - 32) & 3);
                const f32x4 c = *(const f32x4*)(CS + (size_t)m * 32 + i0), sn = *(const f32x4*)(CS + (size_t)m * 32 + 16 + i0);
                f32x4 o; if (lane < 36) o = b * c - p * sn; else o = b * c + p * sn;
                u32x2 w; w.x = pk2(o.x, o.y); w.y = pk2(o.z, o.w); *(u32x2*)(KR + (size_t)m * 32 + 4 * (lane - 32)) = w; }
        }
    }
}

template <int WND>
__device__ __forceinline__ void pool_unit(const bf16_t* __restrict__ P, bf16_t* __restrict__ Y, const bf16_t* __restrict__ WP, const float* __restrict__ psc, int g, int rb, int r32, int hi) {
    const int tg = 32 * rb + r32, t = tg & (SEQ - 1);
    const int cnt = (t + 1 < WND) ? (t + 1) : WND; const float inv = 1.0f / (float)cnt;
    const bf16_t* up = P + (size_t)tg * 1536 + 128 * g + 8 * hi;
    const bf16_t* wp = WP + (size_t)g * 16384 + (size_t)r32 * 128 + 8 * hi;
    f32x16 acc0 = {}, acc1 = {}, acc2 = {}, acc3 = {};
#pragma unroll 2
    for (int kk = 0; kk < 8; ++kk) {
        u32x4 w[WND];
#pragma unroll
        for (int j = 0; j < WND; ++j) { w[j] = (u32x4){0u, 0u, 0u, 0u}; if (j < cnt) w[j] = *(const u32x4*)(up - (size_t)j * 1536 + 16 * kk); }
        float s0 = 0.f, s1 = 0.f, s2 = 0.f, s3 = 0.f, s4 = 0.f, s5 = 0.f, s6 = 0.f, s7 = 0.f;
#pragma unroll
        for (int j = 0; j < WND; ++j) { s0 += bflo(w[j].x); s1 += bfhi(w[j].x); s2 += bflo(w[j].y); s3 += bfhi(w[j].y); s4 += bflo(w[j].z); s5 += bfhi(w[j].z); s6 += bflo(w[j].w); s7 += bfhi(w[j].w); }
        u32x4 o; o.x = pk2(s0 * inv - bflo(w[0].x), s1 * inv - bfhi(w[0].x)); o.y = pk2(s2 * inv - bflo(w[0].y), s3 * inv - bfhi(w[0].y));
        o.z = pk2(s4 * inv - bflo(w[0].z), s5 * inv - bfhi(w[0].z)); o.w = pk2(s6 * inv - bflo(w[0].w), s7 * inv - bfhi(w[0].w));
        const bf16x8 af = __builtin_bit_cast(bf16x8, o);
        acc0 = __builtin_amdgcn_mfma_f32_32x32x16_bf16(af, *(const bf16x8*)(wp + 16 * kk), acc0, 0, 0, 0);
        acc1 = __builtin_amdgcn_mfma_f32_32x32x16_bf16(af, *(const bf16x8*)(wp + 32 * 128 + 16 * kk), acc1, 0, 0, 0);
        acc2 = __builtin_amdgcn_mfma_f32_32x32x16_bf16(af, *(const bf16x8*)(wp + 64 * 128 + 16 * kk), acc2, 0, 0, 0);
        acc3 = __builtin_amdgcn_mfma_f32_32x32x16_bf16(af, *(const bf16x8*)(wp + 96 * 128 + 16 * kk), acc3, 0, 0, 0);
    }
    bf16_t* yb = Y + (size_t)(32 * rb + 4 * hi) * DM + 128 * g + r32;
    const float sc0 = psc[128 * g + r32], sc1 = psc[128 * g + 32 + r32], sc2 = psc[128 * g + 64 + r32], sc3 = psc[128 * g + 96 + r32];
#pragma unroll
    for (int r = 0; r < 16; ++r) { bf16_t* yr = yb + (size_t)((r & 3) + 8 * (r >> 2)) * DM;
        yr[0] = (bf16_t)(pk2(acc0[r] * sc0, 0.f) & 0xffffu); yr[32] = (bf16_t)(pk2(acc1[r] * sc1, 0.f) & 0xffffu);
        yr[64] = (bf16_t)(pk2(acc2[r] * sc2, 0.f) & 0xffffu); yr[96] = (bf16_t)(pk2(acc3[r] * sc3, 0.f) & 0xffffu); }
}

__device__ __forceinline__ void scan_pool(const Args& A, int i, LAS unsigned char* lds, int gw, int NGW, int lane, int tid, int wave) {
    for (int item = blockIdx.x; item < 256; item += gridDim.x) {
        const int bh = item >> 4, seg = item & 15;
        const float* lf = (const float*)(A.ws + WS_SM + SM_LF) + (size_t)bh * SEQ; double* Fo = (double*)(A.ws + WS_SM + SM_F) + (size_t)bh * SEQ + seg * 1024;
        LAS double* wt = (LAS double*)lds;
        double pre = 0.0;
        { f32x4 pv[8];
#pragma unroll
          for (int q = 0; q < 8; ++q) { const int c = q * 512 + tid; pv[q] = (f32x4){0.f, 0.f, 0.f, 0.f}; if (c < seg * 256) pv[q] = *(const f32x4*)(lf + 4 * c); }
#pragma unroll
          for (int q = 0; q < 8; ++q) pre += ((double)pv[q].x + (double)pv[q].y) + ((double)pv[q].z + (double)pv[q].w); }
#pragma unroll
        for (int o = 1; o < 64; o <<= 1) pre += __shfl_xor(pre, o);
        const float v0 = lf[seg * 1024 + 2 * tid], v1 = lf[seg * 1024 + 2 * tid + 1];
        const double tot = (double)v0 + (double)v1; double incl = tot;
#pragma unroll
        for (int o = 1; o < 64; o <<= 1) { const double n = __shfl_up(incl, o); if (lane >= o) incl += n; }
        if (lane == 63) { wt[wave] = pre; wt[8 + wave] = incl; }
        LDS_FENCE(); __syncthreads();
        double run = incl - tot;
#pragma unroll
        for (int j = 0; j < 8; ++j) { run += wt[j]; if (j < wave) run += wt[8 + j]; }
        const double o0 = run + (double)v0, o1 = o0 + (double)v1;
        Fo[2 * tid] = o0; Fo[2 * tid + 1] = o1;
        __syncthreads();
    }
    { const bf16_t* Pq = (const bf16_t*)(A.ws + WS_R1); float* KQP = (float*)(A.ws + WS_SM + SM_KQP);
      float mq0 = 0.f, mk0 = 0.f, mq1 = 0.f, mk1 = 0.f;
      for (int mb16 = gw * 16; mb16 < T; mb16 += NGW * 16) {
      float mq = 0.f, mk = 0.f;
#pragma unroll 4
      for (int j = 0; j < 16; ++j) { const size_t m = (size_t)mb16 + j;
          const u32x4 q = *(const u32x4*)(Pq + m * 1536 + 512 + 8 * lane), k = *(const u32x4*)(Pq + m * 1536 + 1024 + 8 * lane);
          float sq = bflo(q.x) * bflo(q.x) + bfhi(q.x) * bfhi(q.x) + bflo(q.y) * bflo(q.y) + bfhi(q.y) * bfhi(q.y) + bflo(q.z) * bflo(q.z) + bfhi(q.z) * bfhi(q.z) + bflo(q.w) * bflo(q.w) + bfhi(q.w) * bfhi(q.w);
          float sk = bflo(k.x) * bflo(k.x) + bfhi(k.x) * bfhi(k.x) + bflo(k.y) * bflo(k.y) + bfhi(k.y) * bfhi(k.y) + bflo(k.z) * bflo(k.z) + bfhi(k.z) * bfhi(k.z) + bflo(k.w) * bflo(k.w) + bfhi(k.w) * bfhi(k.w);
          sq += __shfl_xor(sq, 1); sq += __shfl_xor(sq, 2); sq += __shfl_xor(sq, 4); sk += __shfl_xor(sk, 1); sk += __shfl_xor(sk, 2); sk += __shfl_xor(sk, 4);
          mq = fmaxf(mq, sq); mk = fmaxf(mk, sk); }
      if (mb16 < SEQ) { mq0 = fmaxf(mq0, mq); mk0 = fmaxf(mk0, mk); } else { mq1 = fmaxf(mq1, mq); mk1 = fmaxf(mk1, mk); } }
      LAS float* wm = (LAS float*)lds + 64;
      if ((lane & 7) == 0) { const int h = lane >> 3; wm[wave * 32 + h * 2] = mq0; wm[wave * 32 + h * 2 + 1] = mk0; wm[wave * 32 + 16 + h * 2] = mq1; wm[wave * 32 + 16 + h * 2 + 1] = mk1; }
      LDS_FENCE(); __syncthreads();
      if (tid < 32) { float v = wm[tid];
#pragma unroll
          for (int wv = 1; wv < 8; ++wv) v = fmaxf(v, wm[wv * 32 + tid]);
          KQP[(size_t)blockIdx.x * 32 + tid] = v; }
      __syncthreads(); }
    const bf16_t* P = (const bf16_t*)(A.ws + WS_R1); bf16_t* Y = (bf16_t*)(A.ws + WS_Y); const bf16_t* WP = (const bf16_t*)(A.ws + WS_W + W_P);
    const float* psc = A.pool_scale + (size_t)i * 512;
    const int r32 = lane & 31, hi = lane >> 5;
    for (int u = gw; u < 4096; u += NGW) {
        const int g = (u + (u >> 11)) & 3, rb = u >> 2;
        if (g == 0) pool_unit<2>(P, Y, WP, psc, g, rb, r32, hi);
        else if (g == 1) pool_unit<4>(P, Y, WP, psc, g, rb, r32, hi);
        else if (g == 2) pool_unit<8>(P, Y, WP, psc, g, rb, r32, hi);
        else pool_unit<16>(P, Y, WP, psc, g, rb, r32, hi);
    }
}

template <int DK, bool FOX, bool TRACK>
__device__ __forceinline__ bool attn_unit(LAS unsigned char* lds, const bf16_t* __restrict__ Qp, int ldq, const bf16_t* __restrict__ Kp, int ldk, const bf16_t* __restrict__ Kr,
                                          const bf16_t* __restrict__ VTp, const double* __restrict__ F, const float* __restrict__ CS, bf16_t* Yp, int q0, int tid_in, float acp_thr) {
    int tid = tid_in;
    constexpr int KSTR = DK * 2 + 16, VSTR = 144, KBYTES = 64 * KSTR, VBYTES = 64 * VSTR;
    constexpr int OFF_K = 0, OFF_V = 3 * KBYTES, OFF_FK = OFF_V + 4 * VBYTES, OFF_WS = OFF_FK + 768;
    constexpr int ND = DK / 16;
    asm volatile("" : "+v"(tid));
    const int lane = tid & 63, r32 = lane & 31, hi = lane >> 5, w = __builtin_amdgcn_readfirstlane(tid >> 6);
    const int wrow0 = q0 + 32 * w, trow = wrow0 + r32;
    bf16x8 qf[ND];
#pragma unroll
    for (int d0 = 0; d0 < ND; ++d0) qf[d0] = *(const bf16x8*)(Qp + (size_t)trow * ldq + 16 * d0 + 8 * hi);
    if (!FOX) {
        const u32x4 a = __builtin_bit_cast(u32x4, qf[ND - 2]), b = __builtin_bit_cast(u32x4, qf[ND - 1]);
        const float* cs = CS + (size_t)trow * 32 + 8 * hi;
        const f32x4 c0 = *(const f32x4*)cs, c1 = *(const f32x4*)(cs + 4), s0 = *(const f32x4*)(cs + 16), s1 = *(const f32x4*)(cs + 20);
        const float x1[8] = {bflo(a.x), bfhi(a.x), bflo(a.y), bfhi(a.y), bflo(a.z), bfhi(a.z), bflo(a.w), bfhi(a.w)};
        const float x2[8] = {bflo(b.x), bfhi(b.x), bflo(b.y), bfhi(b.y), bflo(b.z), bfhi(b.z), bflo(b.w), bfhi(b.w)};
        const float cc[8] = {c0.x, c0.y, c0.z, c0.w, c1.x, c1.y, c1.z, c1.w}, sn[8] = {s0.x, s0.y, s0.z, s0.w, s1.x, s1.y, s1.z, s1.w};
        u32x4 oa, ob;
        oa.x = pk2(x1[0] * cc[0] - x2[0] * sn[0], x1[1] * cc[1] - x2[1] * sn[1]); oa.y = pk2(x1[2] * cc[2] - x2[2] * sn[2], x1[3] * cc[3] - x2[3] * sn[3]);
        oa.z = pk2(x1[4] * cc[4] - x2[4] * sn[4], x1[5] * cc[5] - x2[5] * sn[5]); oa.w = pk2(x1[6] * cc[6] - x2[6] * sn[6], x1[7] * cc[7] - x2[7] * sn[7]);
        ob.x = pk2(x2[0] * cc[0] + x1[0] * sn[0], x2[1] * cc[1] + x1[1] * sn[1]); ob.y = pk2(x2[2] * cc[2] + x1[2] * sn[2], x2[3] * cc[3] + x1[3] * sn[3]);
        ob.z = pk2(x2[4] * cc[4] + x1[4] * sn[4], x2[5] * cc[5] + x1[5] * sn[5]); ob.w = pk2(x2[6] * cc[6] + x1[6] * sn[6], x2[7] * cc[7] + x1[7] * sn[7]);
        qf[ND - 2] = __builtin_bit_cast(bf16x8, oa); qf[ND - 1] = __builtin_bit_cast(bf16x8, ob);
    }
    float fq2 = 0.f; double Fref = 0.0;
    if (FOX) { Fref = F[q0]; fq2 = (float)((F[trow] - Fref) * (double)LOG2E); }
    f32x16 o0 = {}, o1 = {}; float mrun = 0.f, lrun = 0.f;
    const int ktmax = (q0 >> 6) + 3, wkt = wrow0 >> 6;
    int kt_lo = 0;
    if (FOX) { const int nq = q0 >> 6; int cnt = 0;
#pragma unroll
        for (int j = 0; j < 4; ++j) { const int kk = lane + 64 * j; bool c = false; if (kk < nq) c = (Fref - F[64 * kk + 63]) * (double)LOG2E < -(double)acp_thr; cnt += __popcll(__ballot(c)); }
        kt_lo = __builtin_amdgcn_readfirstlane(cnt); }
    const int krow = tid >> 3, kch = tid & 7, rrow = (tid >> 2) & 63, rch = tid & 3;
    const unsigned koff = (unsigned)(krow * ldk + kch * 8) * 2u, voff = (unsigned)(krow * T + kch * 8) * 2u, roff = (unsigned)(rrow * 32 + rch * 8) * 2u;
    u32x4 kreg, vreg, rreg = {}, kregB, vregB, rregB = {}; float fkreg = 0.f, fkregB = 0.f;
#define AT_GLOAD_S(kt, KR, VR, RR, FK) do { KR = *(const u32x4*)((const char*)(Kp + (size_t)(kt) * 64 * ldk) + koff); VR = *(const u32x4*)((const char*)(VTp + (size_t)(kt) * 64) + voff); \
        if (!FOX && tid < 256) RR = *(const u32x4*)((const char*)(Kr + (size_t)(kt) * 64 * 32) + roff); \
        if (FOX && tid < 64) FK = -(float)((F[(kt) * 64 + tid] - Fref) * (double)LOG2E); } while (0)
#define AT_LWRITE_S(KT, KR, VR, RR, FK) do { *(LAS u32x4*)(lds + OFF_K + ((KT) % 3) * KBYTES + krow * KSTR + kch * 16) = KR; *(LAS u32x4*)(lds + OFF_V + ((KT) & 3) * VBYTES + krow * VSTR + kch * 16) = VR; \
        if (!FOX && tid < 256) *(LAS u32x4*)(lds + OFF_K + ((KT) % 3) * KBYTES + rrow * KSTR + 128 + rch * 16) = RR; \
        if (FOX && tid < 64) *(LAS float*)(lds + OFF_FK + ((KT) % 3) * 256 + tid * 4) = FK; } while (0)
#define AT_GLOAD(kt) AT_GLOAD_S(kt, kreg, vreg, rreg, fkreg)
#define AT_LWRITE(KT) AT_LWRITE_S(KT, kreg, vreg, rreg, fkreg)
#define AT_STAGE(KT) do { if ((KT) - 2 >= kt_lo) AT_LWRITE((KT) - 2); if ((KT) - 3 >= kt_lo) AT_GLOAD((KT) - 3); } while (0)
    LAS float* wsf = (LAS float*)(lds + OFF_WS) + w * 64;
    const int sig = (r32 & 0x13) | ((r32 & 4) << 1) | ((r32 & 8) >> 1);
#define AT_KFH(KT, H) _Pragma("unroll") for (int d0 = (H) * (ND / 2); d0 < ((H) + 1) * (ND / 2); ++d0) { kf[2 * d0] = *(const LAS bf16x8*)(kb_ + d0 * 32); kf[2 * d0 + 1] = *(const LAS bf16x8*)(kb_ + 32 * KSTR + d0 * 32); }
#define AT_KB(KT) const LAS unsigned char* kb_ = lds + OFF_K + ((KT) % 3) * KBYTES + sig * KSTR + hi * 16; bf16x8 kf[2 * ND];
#define AT_VF(SLOT) const LAS unsigned char* vb_ = lds + OFF_V + (SLOT) * VBYTES + r32 * VSTR + hi * 16; bf16x8 vf[8]; \
    _Pragma("unroll") for (int c = 0; c < 4; ++c) { vf[2 * c] = *(const LAS bf16x8*)(vb_ + 32 * c); vf[2 * c + 1] = *(const LAS bf16x8*)(vb_ + 32 * VSTR + 32 * c); }
#define AT_CINIT(SC0, SC1, KT) do { if (FOX) { const LAS float* fk = (const LAS float*)(lds + OFF_FK + ((KT) % 3) * 256) + 8 * hi; const float cq = fq2 - mrun; \
        const f32x4 a0 = *(const LAS f32x4*)(fk), a1 = *(const LAS f32x4*)(fk + 4), a2 = *(const LAS f32x4*)(fk + 16), a3 = *(const LAS f32x4*)(fk + 20); \
        const f32x4 b0 = *(const LAS f32x4*)(fk + 32), b1 = *(const LAS f32x4*)(fk + 36), b2 = *(const LAS f32x4*)(fk + 48), b3 = *(const LAS f32x4*)(fk + 52); \
        _Pragma("unroll") for (int e = 0; e < 4; ++e) { SC0[e] = a0[e] + cq; SC0[4 + e] = a1[e] + cq; SC0[8 + e] = a2[e] + cq; SC0[12 + e] = a3[e] + cq; \
                                                      SC1[e] = b0[e] + cq; SC1[4 + e] = b1[e] + cq; SC1[8 + e] = b2[e] + cq; SC1[12 + e] = b3[e] + cq; } \
    } else { SC0 = (f32x16){}; SC1 = (f32x16){}; } } while (0)
#define AT_QKH(SC0, SC1, H) do { _Pragma("unroll") for (int d0 = (H) * (ND / 2); d0 < ((H) + 1) * (ND / 2); ++d0) { \
        SC0 = __builtin_amdgcn_mfma_f32_32x32x16_bf16(kf[2 * d0], qf[d0], SC0, 0, 0, 0); SC1 = __builtin_amdgcn_mfma_f32_32x32x16_bf16(kf[2 * d0 + 1], qf[d0], SC1, 0, 0, 0); } } while (0)
#define AT_EXPH(SP) _Pragma("unroll") for (int r = 0; r < 16; ++r) { SP[r] = __builtin_amdgcn_exp2f(SP[r]); ls_ += SP[r]; }
#define AT_PACK(SP0, SP1) u32x4 p0, p1, p2, p3; \
    p0.x = pk2(SP0[0], SP0[1]); p0.y = pk2(SP0[2], SP0[3]); p0.z = pk2(SP0[4], SP0[5]); p0.w = pk2(SP0[6], SP0[7]); \
    p1.x = pk2(SP0[8], SP0[9]); p1.y = pk2(SP0[10], SP0[11]); p1.z = pk2(SP0[12], SP0[13]); p1.w = pk2(SP0[14], SP0[15]); \
    p2.x = pk2(SP1[0], SP1[1]); p2.y = pk2(SP1[2], SP1[3]); p2.z = pk2(SP1[4], SP1[5]); p2.w = pk2(SP1[6], SP1[7]); \
    p3.x = pk2(SP1[8], SP1[9]); p3.y = pk2(SP1[10], SP1[11]); p3.z = pk2(SP1[12], SP1[13]); p3.w = pk2(SP1[14], SP1[15]); \

#define AT_PV() do { const bf16x8 pa0 = __builtin_bit_cast(bf16x8, p0), pa1 = __builtin_bit_cast(bf16x8, p1), pa2 = __builtin_bit_cast(bf16x8, p2), pa3 = __builtin_bit_cast(bf16x8, p3); \
    o0 = __builtin_amdgcn_mfma_f32_32x32x16_bf16(pa0, vf[0], o0, 0, 0, 0); o1 = __builtin_amdgcn_mfma_f32_32x32x16_bf16(pa0, vf[1], o1, 0, 0, 0); \
    o0 = __builtin_amdgcn_mfma_f32_32x32x16_bf16(pa1, vf[2], o0, 0, 0, 0); o1 = __builtin_amdgcn_mfma_f32_32x32x16_bf16(pa1, vf[3], o1, 0, 0, 0); \
    o0 = __builtin_amdgcn_mfma_f32_32x32x16_bf16(pa2, vf[4], o0, 0, 0, 0); o1 = __builtin_amdgcn_mfma_f32_32x32x16_bf16(pa2, vf[5], o1, 0, 0, 0); \
    o0 = __builtin_amdgcn_mfma_f32_32x32x16_bf16(pa3, vf[6], o0, 0, 0, 0); o1 = __builtin_amdgcn_mfma_f32_32x32x16_bf16(pa3, vf[7], o1, 0, 0, 0); } while (0)
#define AT_REL(SC0, SC1) do { if (TRACK && !FOX) { if (__any(mrun != 0.f)) { _Pragma("unroll") for (int r = 0; r < 16; ++r) { SC0[r] -= mrun; SC1[r] -= mrun; } } } } while (0)
#define AT_MAX(SC0, SC1) float mloc; { float ma = max3f(SC0[0], SC0[1], SC1[0]), mb = max3f(SC0[2], SC0[3], SC1[1]); ma = max3f(ma, SC1[2], SC1[3]); \
        _Pragma("unroll") for (int r = 4; r < 16; r += 4) { ma = max3f(ma, SC0[r], SC0[r + 1]); mb = max3f(mb, SC0[r + 2], SC0[r + 3]); ma = max3f(ma, SC1[r], SC1[r + 1]); mb = max3f(mb, SC1[r + 2], SC1[r + 3]); } \
        mloc = max3f(ma, mb, mb); mloc = max3f(mloc, __shfl_xor(mloc, 32), mloc); }
#define AT_DEC(SC0, SC1) do { if (__any(mloc > 12.0f)) { \
        const float dl = fmaxf(mloc, 0.f); mrun += dl; const float alpha = __builtin_amdgcn_exp2f(-dl); lrun *= alpha; \
        _Pragma("unroll") for (int r = 0; r < 16; ++r) { SC0[r] -= dl; SC1[r] -= dl; } \
        if (hi == 0) wsf[r32] = alpha; \
        LDS_FENCE(); \
        _Pragma("unroll") for (int r4 = 0; r4 < 4; ++r4) { const f32x4 al = *(const LAS f32x4*)(wsf + 8 * r4 + 4 * hi); \
            _Pragma("unroll") for (int e = 0; e < 4; ++e) { o0[4 * r4 + e] *= al[e]; o1[4 * r4 + e] *= al[e]; } } \
        LDS_FENCE(); } } while (0)
#define AT_FIRST(SC0, SC1, KT) do { AT_KB(KT); AT_KFH(KT, 0); AT_KFH(KT, 1); AT_CINIT(SC0, SC1, KT); __builtin_amdgcn_sched_barrier(0); AT_QKH(SC0, SC1, 0); AT_QKH(SC0, SC1, 1); __builtin_amdgcn_sched_barrier(0); AT_STAGE(KT); __builtin_amdgcn_sched_barrier(0); \
        AT_REL(SC0, SC1); \
        if (FOX) { const int kv0 = 64 * (KT) + 8 * hi; \
            _Pragma("unroll") for (int r = 0; r < 16; ++r) { const int kv = kv0 + 16 * (r >> 3) + (r & 7); if (kv > trow) SC0[r] = -INFINITY; if (kv + 32 > trow) SC1[r] = -INFINITY; } } \
        if (TRACK) { AT_MAX(SC0, SC1); AT_DEC(SC0, SC1); } } while (0)
#define AT_STEADY(SC0, SC1, SP0, SP1, KT) do { AT_KB(KT); AT_KFH(KT, 0); AT_CINIT(SC0, SC1, KT); float ls_ = 0.f; __builtin_amdgcn_sched_barrier(0); \
        AT_QKH(SC0, SC1, 0); AT_KFH(KT, 1); AT_EXPH(SP0); asm volatile("" : "+v"(SP0), "+v"(ls_)); AT_SGB_QK(); __builtin_amdgcn_sched_barrier(0); AT_STAGE(KT); __builtin_amdgcn_sched_barrier(0); \
        AT_QKH(SC0, SC1, 1); AT_VF(((KT) + 1) & 3); AT_EXPH(SP1); lrun += ls_; AT_PACK(SP0, SP1); asm volatile("" : "+v"(p0), "+v"(p1), "+v"(p2), "+v"(p3), "+v"(lrun)); AT_SGB_QK(); __builtin_amdgcn_sched_barrier(0); \
        AT_REL(SC0, SC1); \
        if (TRACK) { AT_PV(); AT_MAX(SC0, SC1); AT_SGB_PV(); __builtin_amdgcn_sched_barrier(0); AT_DEC(SC0, SC1); } else { AT_PV(); } } while (0)
#define AT_DRAIN(SP0, SP1) do { AT_VF(kt_lo & 3); float ls_ = 0.f; AT_EXPH(SP0); AT_EXPH(SP1); lrun += ls_; AT_PACK(SP0, SP1); AT_PV(); } while (0)
#ifndef AT_HINTS
#define AT_HINTS 1
#endif
#if AT_HINTS
#define AT_SGB_QK() do { _Pragma("unroll") for (int i_ = 0; i_ < ND; ++i_) { __builtin_amdgcn_sched_group_barrier(0x008, 1, 0); __builtin_amdgcn_sched_group_barrier(0x002, (DK == 96 ? 7 : 10), 0); } } while (0)
#define AT_SGB_PV() do { _Pragma("unroll") for (int i_ = 0; i_ < 8; ++i_) { __builtin_amdgcn_sched_group_barrier(0x008, 1, 0); __builtin_amdgcn_sched_group_barrier(0x002, 2, 0); } } while (0)
#else
#define AT_SGB_QK() do {} while (0)
#define AT_SGB_PV() do {} while (0)
#endif
#define AT_STEP_STEADY(SC0, SC1, SP0, SP1, KT) do { const int kt_ = (KT); AT_STEADY(SC0, SC1, SP0, SP1, kt_); LBAR(); } while (0)
    f32x16 sA0 = {}, sA1 = {}, sB0 = {}, sB1 = {};
    LAS unsigned* uflag = (LAS unsigned*)(lds + 100016);
    if (!TRACK && tid == 0) *uflag = 0u;
    AT_GLOAD(ktmax); AT_GLOAD_S(ktmax - 1, kregB, vregB, rregB, fkregB); AT_LWRITE(ktmax); AT_LWRITE_S(ktmax - 1, kregB, vregB, rregB, fkregB); AT_GLOAD(ktmax - 2); LBAR();
    for (int kt = ktmax; kt > wkt; --kt) { AT_STAGE(kt); LBAR(); }
    { AT_FIRST(sA0, sA1, wkt); LBAR(); }
    int kt = wkt - 1;
    for (; kt >= kt_lo + 1; kt -= 2) {
        AT_STEP_STEADY(sB0, sB1, sA0, sA1, kt);
        AT_STEP_STEADY(sA0, sA1, sB0, sB1, kt - 1);
    }
    if (kt == kt_lo) { AT_STEP_STEADY(sB0, sB1, sA0, sA1, kt_lo); AT_DRAIN(sB0, sB1); LBAR(); }
    else { AT_DRAIN(sA0, sA1); LBAR(); }
#undef AT_GLOAD
#undef AT_LWRITE
#undef AT_GLOAD_S
#undef AT_LWRITE_S
#undef AT_STAGE
#undef AT_KFH
#undef AT_KB
#undef AT_QKH
#undef AT_EXPH
#undef AT_PACK
#undef AT_REL
#undef AT_STEP_STEADY
#undef AT_VF
#undef AT_CINIT
#undef AT_QK
#undef AT_SOFT
#undef AT_PV
#undef AT_MAX
#undef AT_DEC
#undef AT_FIRST
#undef AT_STEADY
#undef AT_DRAIN
#undef AT_STEP
    lrun += __shfl_xor(lrun, 32);
    if (hi == 0) wsf[32 + r32] = lrun;
    LDS_FENCE();
#pragma unroll
    for (int r4 = 0; r4 < 4; ++r4) { const f32x4 lv = *(const LAS f32x4*)(wsf + 32 + 8 * r4 + 4 * hi);
#pragma unroll
        for (int e = 0; e < 4; ++e) { const float inv = 1.0f / lv[e]; const int row = wrow0 + e + 8 * r4 + 4 * hi;
            Yp[(size_t)row * DM + r32] = (bf16_t)(pk2(o0[4 * r4 + e] * inv, 0.f) & 0xffffu);
            Yp[(size_t)row * DM + 32 + r32] = (bf16_t)(pk2(o1[4 * r4 + e] * inv, 0.f) & 0xffffu); } }
    LDS_FENCE();
    if (!TRACK) {
        const bool bad = !(lrun > 1e-30f && lrun < 1e30f);
        if (__any(bad)) { if (lane == 0) atomicOr((unsigned*)uflag, 1u); }
        LBAR(); const unsigned f_ = *uflag; LBAR();
        return f_ == 0u;
    }
    return true;
}

#define XB_TMO      128
#define XB_XCNT(j)  (256  + 64 * (j))
#define XB_XSUB(j)  (1280 + 64 * (j))
#define XB_XGEN(j)  (2304 + 64 * (j))
#define XB_TOP      3328
#define XB_TOPGEN   3392
#define XCD_BAR_WORDS 3456
#define XB_SPIN_CAP (1u << 18)

__device__ __forceinline__ unsigned xb_ld(unsigned* p)              { return __hip_atomic_load(p, __ATOMIC_RELAXED, __HIP_MEMORY_SCOPE_AGENT); }
__device__ __forceinline__ unsigned xb_add(unsigned* p, unsigned v) { return __hip_atomic_fetch_add(p, v, __ATOMIC_RELAXED, __HIP_MEMORY_SCOPE_AGENT); }
__device__ __forceinline__ unsigned xb_xcc_id() { return (unsigned)__builtin_amdgcn_s_getreg((3 << 11) | 20) & 0xFu; }
#define XB_SPIN(cond, bar) do { unsigned _sp = 0; while (cond) { __builtin_amdgcn_s_sleep(1); \
    if ((++_sp & 255u) == 0u) { if (xb_ld(&(bar)[XB_TMO])) break; if (_sp > XB_SPIN_CAP) { atomicAdd(&(bar)[XB_TMO], 1u); break; } } } } while (0)

struct XcdBarrier {
    unsigned* bar; unsigned x;
    volatile LAS unsigned* st;
};

__device__ __forceinline__ XcdBarrier xcd_barrier_post(unsigned* bar, volatile LAS unsigned* st) {
    XcdBarrier b; b.bar = bar; b.x = xb_xcc_id(); b.st = st;
    if (threadIdx.x == 0) (void)xb_add(&bar[XB_XCNT(b.x)], 1u);
    return b;
}
__device__ __forceinline__ void xcd_barrier_complete(unsigned* bar, unsigned x, unsigned& nloc, unsigned& nx) {
    const unsigned G = gridDim.x * gridDim.y * gridDim.z;
    unsigned sum, cnt, mine, sp = 0u;
    for (;;) {
        sum = 0u; cnt = 0u; mine = 0u;
#pragma unroll
        for (unsigned j = 0; j < 16; ++j) { const unsigned c = xb_ld(&bar[XB_XCNT(j)]); sum += c; cnt += (c > 0u) ? 1u : 0u; mine = (j == x) ? c : mine; }
        if (sum == G) break;
        __builtin_amdgcn_s_sleep(1);
        if ((++sp & 255u) == 0u) { if (xb_ld(&bar[XB_TMO])) break; if (sp > XB_SPIN_CAP) { atomicAdd(&bar[XB_TMO], 1u); break; } }
    }
    nloc = mine > 0u ? mine : 1u; nx = cnt > 0u ? cnt : 1u;
}

__device__ __forceinline__ void xcd_barrier(const XcdBarrier& b) {
    asm volatile("s_waitcnt vmcnt(0)" ::: "memory");
    __syncthreads();
    if (threadIdx.x == 0) {
        unsigned* bar = b.bar;
        __builtin_amdgcn_s_waitcnt(0);
        unsigned nloc = b.st[0], nx = b.st[1];
        if (nloc == 0u) { xcd_barrier_complete(bar, b.x, nloc, nx); b.st[0] = nloc; b.st[1] = nx; }
        const unsigned old = xb_add(&bar[XB_XSUB(b.x)], 1u);
        const unsigned gen = old / nloc;
        if (old + 1u == (gen + 1u) * nloc) {
            __builtin_amdgcn_fence(__ATOMIC_RELEASE, "agent");
            asm volatile("s_waitcnt vmcnt(0)" ::: "memory");
            const unsigned og = xb_add(&bar[XB_TOP], 1u);
            const unsigned tg = og / nx;
            if (og + 1u == (tg + 1u) * nx) xb_add(&bar[XB_TOPGEN], 1u);
            else XB_SPIN(xb_ld(&bar[XB_TOPGEN]) == tg, bar);
            __builtin_amdgcn_fence(__ATOMIC_ACQUIRE, "agent");
            xb_add(&bar[XB_XGEN(b.x)], 1u);
            asm volatile("s_waitcnt vmcnt(0)" ::: "memory");
        } else {
            XB_SPIN(xb_ld(&bar[XB_XGEN(b.x)]) == gen, bar);
            __builtin_amdgcn_fence(__ATOMIC_ACQUIRE, "agent");
            asm volatile("s_waitcnt vmcnt(0)" ::: "memory");
        }
    }
    __syncthreads();
}

__global__ void __launch_bounds__(512, 2) fwd_mega(Args Akern) {
    extern __shared__ __attribute__((aligned(16))) unsigned char lds_raw[];
    LAS unsigned char* lds = (LAS unsigned char*)lds_raw;
    const int G = gridDim.x, bx = blockIdx.x;
    const int vcu = (G % 8 == 0) ? (bx % 8) * (G / 8) + bx / 8 : bx;
    const int NGW = G * 8;
    const int ph_lo = Akern.ph_lo, ph_hi = Akern.ph_hi, do_sync = Akern.do_sync;
    volatile LAS unsigned* bar_st = (volatile LAS unsigned*)(lds + 140000);
    if (threadIdx.x < 2) bar_st[threadIdx.x] = 0u;
    __syncthreads();
    XcdBarrier xbar; xbar.bar = (unsigned*)(Akern.ws + WS_SM + SM_BAR); xbar.x = 0; xbar.st = nullptr;
    if (do_sync) xbar = xcd_barrier_post((unsigned*)(Akern.ws + WS_SM + SM_BAR), bar_st);
    bool first_sync = true;
#if defined(__HIP_DEVICE_COMPILE__)
    const __attribute__((address_space(4))) Args* Ak = (const __attribute__((address_space(4))) Args*)__builtin_amdgcn_kernarg_segment_ptr();
#else
    const Args* Ak = &Akern;
#endif

#if PROBE_KMASK
    unsigned long long t_acc = 0ull;
#endif
    for (int ph = ph_lo; ph < ph_hi; ++ph) {
#if PROBE_KMASK
        const unsigned long long t_ph0 = __builtin_amdgcn_s_memrealtime();
#endif
        asm volatile("" : "+s"(Ak));
        const Args A = *Ak;
        int tid = threadIdx.x; asm volatile("" : "+v"(tid));
        const int lane = tid & 63, wave = __builtin_amdgcn_readfirstlane(tid >> 6), gw = vcu * 8 + wave;
        unsigned char* ws = A.ws;
        bf16_t* HN = (bf16_t*)(ws + WS_HN); bf16_t* Yb = (bf16_t*)(ws + WS_Y); bf16_t* R1 = (bf16_t*)(ws + WS_R1); bf16_t* VT = (bf16_t*)(ws + WS_VT); bf16_t* KN = (bf16_t*)(ws + WS_KN); _Float16* H16 = (_Float16*)(ws + WS_H16);
        float* LFb = (float*)(ws + WS_SM + SM_LF); const double* Fb = (const double*)(ws + WS_SM + SM_F); const float* CS = (const float*)(ws + WS_SM + SM_CS);
        const int l = ph / 12, k = ph % 12, i = l >> 1; const bool even = !(l & 1);
        bool did = true;
        if (ph == NPH - 1) {
            if (EN(0)) norm_phase<2, true>(H16, A.norm_final, nullptr, A.out, nullptr, nullptr, nullptr, nullptr, gw, NGW, lane, tid);
        } else if (k == 0 || k == 9) {
            const int f = (k == 0) ? 0 : 1;
            if (EN(1)) if (k == 0) { convert_layer(A, l, (LAS float*)(lds + wave * 16384), gw, NGW, lane); if (l == 0) rope_table(A, gw, NGW, lane); }
            if (l == 0 && k == 0) norm_phase<0, false>(A.x, A.norm_ffn + (size_t)(l * 2 + f) * DM, HN, nullptr, nullptr, nullptr, nullptr, nullptr, gw, NGW, lane, tid);
            else norm_phase<0, true>(H16, A.norm_ffn + (size_t)(l * 2 + f) * DM, HN, nullptr, nullptr, nullptr, nullptr, nullptr, gw, NGW, lane, tid);
        } else if (k == 1 || k == 10) {
            const int f = (k == 1) ? 0 : 1;
            pg8::Gemm g{HN, (const bf16_t*)(ws + WS_W + (f ? W_GU1 : W_GU0)), T, 2 * FF, DM}; pg8::StaticOrder S; S.init(T, 2 * FF, G, bx);
            pg8::EpiSwiglu E{R1, FF};
            if (EN(2)) pg8::gemm_phase<pg8::EpiSwiglu, pg8::StaticOrder, true, true>(lds, g, S, E);
        } else if (k == 4 && !even) {
            pg8::Gemm g{HN, (const bf16_t*)(ws + WS_W + W_MIN), T, 512, DM}; pg8::StaticOrder S; S.init(T, 512, G, bx);
            pg8::EpiMlaIn E{(bf16_t*)(ws + WS_R1 + R_CQN), (bf16_t*)(ws + WS_R1 + R_CKVN), (bf16_t*)(ws + WS_R1 + R_KR), A.mla_q_norm + (size_t)i * 256, A.mla_kv_norm + (size_t)i * 128, CS};
            pg8::gemm_phase<pg8::EpiMlaIn, pg8::StaticOrder, false, true>(lds, g, S, E);
        } else if (k == 2 || k == 11 || k == 8) {
            pg8::Gemm g; pg8::EpiResF32 E;
            if (k == 2 || k == 11) { const int f = (k == 2) ? 0 : 1; g = pg8::Gemm{R1, (const bf16_t*)(ws + WS_W + (f ? W_D1 : W_D0)), T, DM, FF};
                if (l == 0 && k == 2) E = pg8::EpiResF32{A.x, H16, DM, 0.5f, 1}; else E = pg8::EpiResF32{H16, H16, DM, 0.5f, 0}; }
            else if (k == 8) { g = pg8::Gemm{Yb, (const bf16_t*)(ws + WS_W + W_OUT), T, DM, DM}; E = pg8::EpiResF32{H16, H16, DM, 1.0f, 0}; }
            else { g = pg8::Gemm{Yb, (const bf16_t*)(ws + WS_W + W_OUT), T, DM, DM}; E = pg8::EpiResF32{H16, H16, DM, 1.0f, 0}; }
            pg8::StaticOrder S; S.init(g.M, g.N, G, bx);
            if (EN(3)) pg8::gemm_phase<pg8::EpiResF32, pg8::StaticOrder, true, true>(lds, g, S, E);
        } else if (k == 3) {
            if (even && bx == 0 && tid < 64) { ((unsigned*)(ws + WS_SM + SM_KQ))[tid] = 0u; if (tid == 0) *(unsigned*)(ws + WS_SM + SM_CTR) = 0u; }
            if (!even && bx == 0 && tid < 8) ((unsigned*)(ws + WS_SM + SM_CTR + 256))[tid * 16] = 0u;
            if (!EN(4)) {} else if (even) norm_phase<1, true>(H16, A.norm_mix + (size_t)l * DM, HN, nullptr, A.ab_w_in + (size_t)i * DM * 2056, A.ab_b_forget + (size_t)i * 8, LFb, (LAS float*)lds, gw, NGW, lane, tid);
            else norm_phase<0, true>(H16, A.norm_mix + (size_t)l * DM, HN, nullptr, nullptr, nullptr, nullptr, nullptr, gw, NGW, lane, tid);
        } else if ((k == 4 && even) || (k == 6 && !even)) {
            const int ng = even ? 2 : 3;
            for (int j = 0; j < ng; ++j) {
                pg8::Gemm g; pg8::EpiBf16S E;
                if (even) {
                    if (j == 0) { g = pg8::Gemm{HN, (const bf16_t*)(ws + WS_W + W_IN), T, 1536, DM}; E = pg8::EpiBf16S{R1, 1536, 512, 1024, 0.125f * LOG2E}; }
                    else { g = pg8::Gemm{(const bf16_t*)(ws + WS_W + W_V), HN, 512, T, DM}; E = pg8::EpiBf16S{VT, T, 0, 0, 1.0f}; }
                } else {
                    if (j == 0) { g = pg8::Gemm{(const bf16_t*)(ws + WS_R1 + R_CQN), (const bf16_t*)(ws + WS_W + W_QB), T, 1536, 256}; E = pg8::EpiBf16S{R1, 1536, 0, 1536, 0.10206207261596577f * LOG2E}; }
                    else if (j == 1) { g = pg8::Gemm{(const bf16_t*)(ws + WS_R1 + R_CKVN), (const bf16_t*)(ws + WS_W + W_KNW), T, 1024, 256}; E = pg8::EpiBf16S{KN, 1024, 0, 0, 1.0f}; }
                    else { g = pg8::Gemm{(const bf16_t*)(ws + WS_W + W_VVW), (const bf16_t*)(ws + WS_R1 + R_CKVN), 1024, T, 256}; E = pg8::EpiBf16S{VT, T, 0, 0, 1.0f}; }
                }
                pg8::StaticOrder S; S.init(g.M, g.N, G, bx);
                if (EN(5)) pg8::gemm_phase<pg8::EpiBf16S, pg8::StaticOrder, true, true>(lds, g, S, E);
                __syncthreads();
            }
        } else if (k == 5) {
            if (!EN(6)) {} else if (even) scan_pool(A, i, lds, gw, NGW, lane, tid, wave);
            else did = false;
        } else if (k == 7) {
            if (even) {
                unsigned* ctr = (unsigned*)(ws + WS_SM + SM_CTR); const unsigned* KQ = (const unsigned*)(ws + WS_SM + SM_KQ);
                LAS unsigned* qslot = (LAS unsigned*)(lds + 100000);
                for (;;) {
                    if (tid == 0) qslot[0] = atomicAdd(ctr, 1u);
                    LBAR(); const unsigned u = qslot[0]; LBAR();
                    if (u >= 1024u) break;
                    const int qb = 63 - (int)(u >> 4), bh = (int)(u & 15u), b = bh >> 3, h = bh & 7;
                    float mq_ = 0.f, mk_ = 0.f;
                    { const float* KQP = (const float*)(ws + WS_SM + SM_KQP) + (bh >> 3) * 16 + (bh & 7) * 2;
                      for (int x = lane; x < G; x += 64) { mq_ = fmaxf(mq_, KQP[(size_t)x * 32]); mk_ = fmaxf(mk_, KQP[(size_t)x * 32 + 1]); }
#pragma unroll
                      for (int o = 1; o < 64; o <<= 1) { mq_ = fmaxf(mq_, __shfl_xor(mq_, o)); mk_ = fmaxf(mk_, __shfl_xor(mk_, o)); } }
                    const float thr = 2.0f * sqrtf(mq_ * mk_) + 48.0f;
                    if (!attn_unit<64, true, false>(lds, R1 + (size_t)(b * SEQ) * 1536 + 512 + 64 * h, 1536, R1 + (size_t)(b * SEQ) * 1536 + 1024 + 64 * h, 1536, nullptr,
                                        VT + (size_t)(64 * h) * T + (size_t)b * SEQ, Fb + (size_t)bh * SEQ, nullptr, Yb + (size_t)(b * SEQ) * DM + 512 + 64 * h, qb * 256, tid, thr)) attn_unit<64, true, true>(lds, R1 + (size_t)(b * SEQ) * 1536 + 512 + 64 * h, 1536, R1 + (size_t)(b * SEQ) * 1536 + 1024 + 64 * h, 1536, nullptr,
                                        VT + (size_t)(64 * h) * T + (size_t)b * SEQ, Fb + (size_t)bh * SEQ, nullptr, Yb + (size_t)(b * SEQ) * DM + 512 + 64 * h, qb * 256, tid, thr);
                }
            } else {
                if (G == 256) {
                    unsigned* ctr = (unsigned*)(ws + WS_SM + SM_CTR + 256) + (vcu >> 5) * 16; LAS unsigned* qslot = (LAS unsigned*)(lds + 100000);
                    for (;;) {
                        if (tid == 0) qslot[0] = atomicAdd(ctr, 1u);
                        LBAR(); const unsigned u = qslot[0]; LBAR();
                        if (u >= 256u) break;
                        const int bh = (vcu >> 5) + 8 * (int)(u >> 6), qb = 63 - (int)(u & 63u), b = bh >> 4, h = bh & 15;
                        if (!attn_unit<96, false, false>(lds, R1 + (size_t)(b * SEQ) * 1536 + 96 * h, 1536, KN + (size_t)(b * SEQ) * 1024 + 64 * h, 1024, (const bf16_t*)(ws + WS_R1 + R_KR) + (size_t)(b * SEQ) * 32,
                                             VT + (size_t)(64 * h) * T + (size_t)b * SEQ, nullptr, CS + (size_t)(b * SEQ) * 32, Yb + (size_t)(b * SEQ) * DM + 64 * h, qb * 256, tid, 0.f)) attn_unit<96, false, true>(lds, R1 + (size_t)(b * SEQ) * 1536 + 96 * h, 1536, KN + (size_t)(b * SEQ) * 1024 + 64 * h, 1024, (const bf16_t*)(ws + WS_R1 + R_KR) + (size_t)(b * SEQ) * 32,
                                             VT + (size_t)(64 * h) * T + (size_t)b * SEQ, nullptr, CS + (size_t)(b * SEQ) * 32, Yb + (size_t)(b * SEQ) * DM + 64 * h, qb * 256, tid, 0.f);
                    }
                } else {
                for (int p = vcu; p < 32 * 32; p += G) { const int bh = p >> 5, s = p & 31, b = bh >> 4, h = bh & 15;
                    for (int z = 0; z < 2; ++z) { const int qb = z ? s : 63 - s;
                        if (!attn_unit<96, false, false>(lds, R1 + (size_t)(b * SEQ) * 1536 + 96 * h, 1536, KN + (size_t)(b * SEQ) * 1024 + 64 * h, 1024, (const bf16_t*)(ws + WS_R1 + R_KR) + (size_t)(b * SEQ) * 32,
                                             VT + (size_t)(64 * h) * T + (size_t)b * SEQ, nullptr, CS + (size_t)(b * SEQ) * 32, Yb + (size_t)(b * SEQ) * DM + 64 * h, qb * 256, tid, 0.f)) attn_unit<96, false, true>(lds, R1 + (size_t)(b * SEQ) * 1536 + 96 * h, 1536, KN + (size_t)(b * SEQ) * 1024 + 64 * h, 1024, (const bf16_t*)(ws + WS_R1 + R_KR) + (size_t)(b * SEQ) * 32,
                                             VT + (size_t)(64 * h) * T + (size_t)b * SEQ, nullptr, CS + (size_t)(b * SEQ) * 32, Yb + (size_t)(b * SEQ) * DM + 64 * h, qb * 256, tid, 0.f); } }
                }
            }
        } else did = false;
        if (did && ph + 1 < ph_hi) { if (do_sync) { if (first_sync) { cg::this_grid().sync(); first_sync = false; } else xcd_barrier(xbar); } }
#if PROBE_KMASK
        { const int kk_ = (ph == NPH - 1) ? 12 : (ph % 12); if ((PROBE_KMASK >> kk_) & 1) t_acc += __builtin_amdgcn_s_memrealtime() - t_ph0; }
        if (ph == NPH - 1 && blockIdx.x == 0 && (threadIdx.x >> 6) == 0) {
            const int M_ = (int)(t_acc / 200ull) > 8192 ? 8192 : (int)(t_acc / 200ull);
            for (int idx = threadIdx.x & 63; idx < M_; idx += 64) A.out[(size_t)(idx >> 10) * NGW * DM + (idx & 1023)] += 0.05f;
        }
#endif
    }
}

extern "C" void kernel_launch(void* const* d_in, const int* in_sizes, int n_in, void* d_out, int out_size, void* d_ws, size_t ws_size, hipStream_t stream) {
    static int grid = 0;
    if (grid == 0) {
        if (n_in != 19 || out_size != T * DM || ws_size < WS_END) { fprintf(stderr, "kernel_launch: unexpected shapes (n_in %d out %d ws %zu)\n", n_in, out_size, ws_size); grid = -1; return; }
        int dev = 0, cus = 0, per_cu = 0;
        hipGetDevice(&dev); hipDeviceGetAttribute(&cus, hipDeviceAttributeMultiprocessorCount, dev);
        if (hipFuncSetAttribute((const void*)fwd_mega, hipFuncAttributeMaxDynamicSharedMemorySize, LDS_BYTES) != hipSuccess) { fprintf(stderr, "kernel_launch: hipFuncSetAttribute failed\n"); grid = -1; return; }
        if (hipOccupancyMaxActiveBlocksPerMultiprocessor(&per_cu, (const void*)fwd_mega, 512, LDS_BYTES) != hipSuccess || per_cu < 1) { fprintf(stderr, "kernel_launch: occupancy query says %d\n", per_cu); per_cu = 1; }
        (void)hipGetLastError();
        grid = cus * 1;
    }
    if (grid < 0) return;
    Args a{};
    a.x = (const float*)d_in[0]; a.pos = (const int*)d_in[1]; a.norm_ffn = (const float*)d_in[2]; a.norm_mix = (const float*)d_in[3]; a.norm_final = (const float*)d_in[4];
    a.w_gate = (const float*)d_in[5]; a.w_up = (const float*)d_in[6]; a.w_down = (const float*)d_in[7];
    a.ab_w_in = (const float*)d_in[8]; a.ab_b_forget = (const float*)d_in[9]; a.pool_w = (const float*)d_in[10]; a.pool_scale = (const float*)d_in[11]; a.ab_w_out = (const float*)d_in[12];
    a.mla_w_in = (const float*)d_in[13]; a.mla_q_norm = (const float*)d_in[14]; a.mla_kv_norm = (const float*)d_in[15]; a.mla_w_q_b = (const float*)d_in[16]; a.mla_w_kv_b = (const float*)d_in[17]; a.mla_w_out = (const float*)d_in[18];
    a.out = (float*)d_out; a.ws = (unsigned char*)d_ws; a.pad = 0;
#if ONE_LAUNCH
    a.ph_lo = 0; a.ph_hi = NPH; a.do_sync = 1;
    if (hipMemsetAsync((char*)d_ws + WS_SM + SM_BAR, 0, XCD_BAR_WORDS * 4, stream) != hipSuccess) { fprintf(stderr, "kernel_launch: memset of the barrier words failed\n"); return; }
    void* args[] = {&a};
    hipError_t e = hipLaunchCooperativeKernel((const void*)fwd_mega, dim3(grid), dim3(512), args, LDS_BYTES, stream);
    if (e != hipSuccess) fprintf(stderr, "cooperative launch failed: %s (grid %d)\n", hipGetErrorString(e), grid);
#else
    for (int ph = 0; ph < NPH; ++ph) {
        const int l = ph / 12, k = ph % 12; if (ph != NPH - 1 && k == 6 && !(l & 1)) continue;
        a.ph_lo = ph; a.ph_hi = ph + 1; a.do_sync = 0;
        hipLaunchKernelGGL(fwd_mega, dim3(grid), dim3(512), LDS_BYTES, stream, a);
    }
#endif
}
```
